# Optimizing an MI355X kernel written in HIP

```python
import math
import jax, jax.numpy as jnp
from jax import lax
import numpy as np

D_MODEL = 1024
BATCH = 2
SEQ = 8192
DEPTH = 2

MOBA_HEADS = 8
MOBA_HEAD_DIM = 64
MOBA_WIDTH = MOBA_HEADS * MOBA_HEAD_DIM
MOBA_BLOCK = 256
MOBA_TOPK = 3
ROPE_THETA = 10000.0
RET_HEADS = 4
RET_QK_DIM = 128
RET_V_DIM = 256
RET_QK_WIDTH = RET_HEADS * RET_QK_DIM
RET_V_WIDTH = RET_HEADS * RET_V_DIM
RET_CHUNK = 256
PEER_N_KEYS = 128
PEER_N_EXPERTS = PEER_N_KEYS * PEER_N_KEYS
PEER_HEADS = 8
PEER_KEY_DIM = 256
PEER_TOPK = 16
PEER_TOKEN_CHUNK = 128
DN_ALPHA = (2.0 * DEPTH) ** 0.25
DN_BETA = (8.0 * DEPTH) ** -0.25
LN_EPS = 1e-5
NEG = -1e30

IN_SIZES = (MOBA_WIDTH, MOBA_WIDTH, MOBA_WIDTH, RET_QK_WIDTH, RET_QK_WIDTH, RET_V_WIDTH, RET_V_WIDTH, D_MODEL, D_MODEL)
IN_WIDTH = sum(IN_SIZES)
SPLIT_POINTS = tuple(int(v) for v in np.cumsum(IN_SIZES)[:-1])

kernel_name = 'hybrid_moba_retnet_peer_deepnorm'


def layer_norm(x, g, b):
    xf = x.astype(jnp.float32)
    mu = xf.mean(-1, keepdims=True)
    var = jnp.square(xf - mu).mean(-1, keepdims=True)
    return ((xf - mu) * lax.rsqrt(var + LN_EPS) * g.astype(jnp.float32) + b.astype(jnp.float32)).astype(x.dtype)


def group_norm(y):
    yf = y.astype(jnp.float32)
    mu = yf.mean(-1, keepdims=True)
    var = jnp.square(yf - mu).mean(-1, keepdims=True)
    return ((yf - mu) * lax.rsqrt(var + LN_EPS)).astype(y.dtype)


def rope_half(x, pos):
    d = x.shape[-1]
    inv = ROPE_THETA ** (-jnp.arange(0, d, 2, dtype=jnp.float32) / d)
    ang = pos[:, None] * inv[None, :]
    cos, sin = jnp.cos(ang), jnp.sin(ang)
    x1, x2 = x[..., : d // 2], x[..., d // 2:]
    return jnp.concatenate([x1 * cos - x2 * sin, x2 * cos + x1 * sin], axis=-1).astype(x.dtype)


def rotate_retnet(x, pos):
    d = x.shape[-1]
    inv = 1.0 / (ROPE_THETA ** jnp.linspace(0.0, 1.0, d // 2, dtype=jnp.float32))
    ang = pos[:, None] * inv[None, :]
    cos, sin = jnp.cos(ang), jnp.sin(ang)
    x1, x2 = x[..., 0::2], x[..., 1::2]
    return jnp.stack([x1 * cos - x2 * sin, x2 * cos + x1 * sin], axis=-1).reshape(x.shape).astype(x.dtype)


def moba_attention(q, k, v):
    B, H, S, d = q.shape
    nb = S // MOBA_BLOCK
    scale = d ** -0.5
    kb = k.reshape(B, H, nb, MOBA_BLOCK, d)
    vb = v.reshape(B, H, nb, MOBA_BLOCK, d)
    qb = jnp.moveaxis(q.reshape(B, H, nb, MOBA_BLOCK, d), 2, 0)
    k_mean = kb.astype(jnp.float32).mean(axis=3)
    n_sel = min(MOBA_TOPK, nb)
    causal = jnp.tril(jnp.ones((MOBA_BLOCK, MOBA_BLOCK), dtype=bool))
    b_ix = jnp.arange(B)[:, None, None, None]
    h_ix = jnp.arange(H)[None, :, None, None]
    blk_ids = jnp.arange(nb)
    slot_ids = jnp.arange(n_sel)

    def one_block(args):
        i, q_i = args
        gate = jnp.einsum('bhld,bhnd->bhln', q_i.astype(jnp.float32), k_mean)
        gate = jnp.where(blk_ids < i, gate, NEG)
        _, top_idx = lax.top_k(gate, n_sel)
        valid = slot_ids < i
        k_sel = kb[b_ix, h_ix, top_idx]
        v_sel = vb[b_ix, h_ix, top_idx]
        s_sel = jnp.einsum('bhld,bhlrkd->bhlrk', q_i, k_sel).astype(jnp.float32) * scale
        s_sel = jnp.where(valid[:, None], s_sel, NEG).reshape(B, H, MOBA_BLOCK, n_sel * MOBA_BLOCK)
        k_own = lax.dynamic_index_in_dim(kb, i, axis=2, keepdims=False)
        v_own = lax.dynamic_index_in_dim(vb, i, axis=2, keepdims=False)
        s_own = jnp.einsum('bhld,bhkd->bhlk', q_i, k_own).astype(jnp.float32) * scale
        s_own = jnp.where(causal, s_own, NEG)
        p = jax.nn.softmax(jnp.concatenate([s_sel, s_own], axis=-1), axis=-1).astype(v.dtype)
        p_sel = p[..., : n_sel * MOBA_BLOCK].reshape(B, H, MOBA_BLOCK, n_sel, MOBA_BLOCK)
        p_own = p[..., n_sel * MOBA_BLOCK:]
        return (jnp.einsum('bhlrk,bhlrkd->bhld', p_sel, v_sel)
                + jnp.einsum('bhlk,bhkd->bhld', p_own, v_own))

    out = lax.map(one_block, (blk_ids, qb))
    return jnp.moveaxis(out, 0, 2).reshape(B, H, S, d)


def retention(q, k, v):
    B, H, S, dk = q.shape
    dv = v.shape[-1]
    C = RET_CHUNK
    nc = S // C
    log_g = jnp.log(1.0 - 2.0 ** (-5.0 - jnp.arange(H, dtype=jnp.float32)))
    k = k * (dk ** -0.5)
    qc = q.reshape(B, H, nc, C, dk)
    kc = k.reshape(B, H, nc, C, dk)
    vc = v.reshape(B, H, nc, C, dv)
    pos = jnp.arange(C, dtype=jnp.float32)
    diff = pos[:, None] - pos[None, :]
    decay = jnp.where(diff >= 0, jnp.exp(log_g[:, None, None] * jnp.maximum(diff, 0.0)), 0.0)
    scores = jnp.einsum('bhncd,bhnmd->bhncm', qc, kc) * decay[None, :, None]
    y_inner = jnp.einsum('bhncm,bhnme->bhnce', scores, vc)
    k_decay = jnp.exp(log_g[:, None] * (C - 1.0 - pos))
    q_decay = jnp.exp(log_g[:, None] * (pos + 1.0))
    chunk_decay = jnp.exp(log_g * C)
    kv = jnp.einsum('bhncd,bhnce->nbhde', kc * k_decay[None, :, None, :, None], vc)

    def step(state, kv_n):
        return state * chunk_decay[None, :, None, None] + kv_n, state

    _, prev = lax.scan(step, jnp.zeros((B, H, dk, dv), kv.dtype), kv)
    y_cross = jnp.einsum('bhncd,nbhde->bhnce', qc, prev) * q_decay[None, :, None, :, None]
    return (y_inner + y_cross).reshape(B, H, S, dv)


def token_mixer(x, w_in, w_moba_out, w_ret_out, w_out):
    B, S, _ = x.shape
    pad = (-S) % MOBA_BLOCK
    Sp = S + pad
    proj = jnp.einsum('bsd,de->bse', x, w_in)
    q_a, k_a, v_a, q_r, k_r, v_r, g_r, gate_a, gate_r = jnp.split(proj, SPLIT_POINTS, axis=-1)

    def to_heads(t, n_heads):
        t = jnp.pad(t, ((0, 0), (0, pad), (0, 0)))
        return t.reshape(B, Sp, n_heads, -1).transpose(0, 2, 1, 3)

    pos = jnp.arange(Sp, dtype=jnp.float32)
    qa = rope_half(to_heads(q_a, MOBA_HEADS), pos)
    ka = rope_half(to_heads(k_a, MOBA_HEADS), pos)
    va = to_heads(v_a, MOBA_HEADS)
    y_a = moba_attention(qa, ka, va)[:, :, :S]
    y_a = y_a.transpose(0, 2, 1, 3).reshape(B, S, MOBA_WIDTH)

    qr = rotate_retnet(to_heads(q_r, RET_HEADS), pos)
    kr = rotate_retnet(to_heads(k_r, RET_HEADS), pos)
    vr = to_heads(v_r, RET_HEADS)
    y_r = group_norm(retention(qr, kr, vr)[:, :, :S])
    y_r = y_r.transpose(0, 2, 1, 3).reshape(B, S, RET_V_WIDTH)
    y_r = jax.nn.silu(g_r) * y_r

    branch_a = jnp.einsum('bse,ed->bsd', y_a, w_moba_out)
    branch_r = jnp.einsum('bse,ed->bsd', y_r, w_ret_out)
    merged = jax.nn.sigmoid(gate_a) * branch_a + jax.nn.sigmoid(gate_r) * branch_r
    return jnp.einsum('bsd,de->bse', merged, w_out)


def peer_ffn(x, w_query, sub_keys, expert_u, expert_v):
    B, S, D = x.shape
    L = PEER_TOKEN_CHUNK
    xt = x.reshape((B * S) // L, L, D)

    def one_chunk(xc):
        q = jnp.einsum('ld,de->le', xc, w_query).reshape(L, PEER_HEADS, 2, PEER_KEY_DIM // 2)
        s = jnp.einsum('lhpd,pkd->lhpk', q, sub_keys).astype(jnp.float32)
        s_top, i_top = lax.top_k(s, PEER_TOPK)
        cand_s = (s_top[:, :, 0, :, None] + s_top[:, :, 1, None, :]).reshape(L, PEER_HEADS, PEER_TOPK * PEER_TOPK)
        cand_i = (i_top[:, :, 0, :, None] * PEER_N_KEYS + i_top[:, :, 1, None, :]).reshape(L, PEER_HEADS, PEER_TOPK * PEER_TOPK)
        fin_s, fin_pos = lax.top_k(cand_s, PEER_TOPK)
        fin_i = jnp.take_along_axis(cand_i, fin_pos, axis=-1)
        g = jax.nn.softmax(fin_s, axis=-1).astype(xc.dtype)
        u = expert_u[fin_i]
        h = jax.nn.gelu(jnp.einsum('ld,lhkd->lhk', xc, u))
        v = expert_v[fin_i]
        return jnp.einsum('lhk,lhkd->ld', g * h, v)

    return lax.map(one_chunk, xt).reshape(B, S, D)


def setup_inputs(seed: int = 0) -> dict:
    key = jax.random.key(seed)
    ks = jax.random.split(key, 14)
    f32 = jnp.float32
    offsets = np.concatenate([[0], np.cumsum(IN_SIZES)])
    col_scale = np.ones((IN_WIDTH,), np.float32)
    col_scale[offsets[2]:offsets[3]] = DN_BETA
    col_scale[offsets[5]:offsets[6]] = DN_BETA
    x = jax.random.normal(ks[0], (BATCH, SEQ, D_MODEL), f32)
    w_in = jax.random.normal(ks[1], (DEPTH, D_MODEL, IN_WIDTH), f32) * (D_MODEL ** -0.5) * jnp.asarray(col_scale)
    w_moba_out = jax.random.normal(ks[2], (DEPTH, MOBA_WIDTH, D_MODEL), f32) * (MOBA_WIDTH ** -0.5) * DN_BETA
    w_ret_out = jax.random.normal(ks[3], (DEPTH, RET_V_WIDTH, D_MODEL), f32) * (RET_V_WIDTH ** -0.5) * DN_BETA
    w_out = jax.random.normal(ks[4], (DEPTH, D_MODEL, D_MODEL), f32) * (D_MODEL ** -0.5) * DN_BETA
    ln1_g = 1.0 + 0.02 * jax.random.normal(ks[5], (DEPTH, D_MODEL), f32)
    ln1_b = 0.02 * jax.random.normal(ks[6], (DEPTH, D_MODEL), f32)
    peer_w_query = jax.random.normal(ks[7], (DEPTH, D_MODEL, PEER_HEADS * PEER_KEY_DIM), f32) * (D_MODEL ** -0.5)
    peer_sub_keys = jax.random.normal(ks[8], (DEPTH, 2, PEER_N_KEYS, PEER_KEY_DIM // 2), f32) * ((PEER_KEY_DIM // 2) ** -0.5)
    peer_u = jax.random.normal(ks[9], (DEPTH, PEER_N_EXPERTS, D_MODEL), f32) * (D_MODEL ** -0.5)
    peer_v = jax.random.normal(ks[10], (DEPTH, PEER_N_EXPERTS, D_MODEL), f32) * DN_BETA
    ln2_g = 1.0 + 0.02 * jax.random.normal(ks[11], (DEPTH, D_MODEL), f32)
    ln2_b = 0.02 * jax.random.normal(ks[12], (DEPTH, D_MODEL), f32)
    return {'x': x, 'w_in': w_in, 'w_moba_out': w_moba_out, 'w_ret_out': w_ret_out, 'w_out': w_out,
            'ln1_g': ln1_g, 'ln1_b': ln1_b, 'peer_w_query': peer_w_query, 'peer_sub_keys': peer_sub_keys,
            'peer_u': peer_u, 'peer_v': peer_v, 'ln2_g': ln2_g, 'ln2_b': ln2_b}


def reference(x, w_in, w_moba_out, w_ret_out, w_out, ln1_g, ln1_b, peer_w_query, peer_sub_keys,
              peer_u, peer_v, ln2_g, ln2_b):
    for l in range(DEPTH):
        mix = token_mixer(x, w_in[l], w_moba_out[l], w_ret_out[l], w_out[l])
        x = layer_norm(DN_ALPHA * x + mix, ln1_g[l], ln1_b[l])
        ffn = peer_ffn(x, peer_w_query[l], peer_sub_keys[l], peer_u[l], peer_v[l])
        x = layer_norm(DN_ALPHA * x + ffn, ln2_g[l], ln2_b[l])
    return x
```

```cpp
#include <hip/hip_runtime.h>
#include <cstdint>
#include <cstdio>

constexpr int D = 1024, NB = 2, S = 8192;
constexpr int INW = 6656;
constexpr int OFF_QA = 0, OFF_KA = 512, OFF_VA = 1024, OFF_QR = 1536, OFF_KR = 2048, OFF_VR = 2560,
              OFF_GR = 3584, OFF_GA = 4608, OFF_GRT = 5632;
constexpr int MH = 8, MD = 64, MBLK = 256, MNB = S / MBLK;
constexpr int RH = 4, RDK = 128, RDV = 256, RC = 256, RNC = S / RC;
constexpr int PH = 8, PK = 16, PNK = 128, PKD = 128;
constexpr float LN_EPS = 1e-5f;
constexpr float DN_ALPHA = 1.4142135623730951f;
constexpr float NEGF = -1e30f;

__device__ __forceinline__ float wave_sum(float v) {
#pragma unroll
    for (int o = 32; o >= 1; o >>= 1) v += __shfl_xor(v, o);
    return v;
}
__device__ __forceinline__ float ret_logg(int h) { return (float)log(1.0 - exp2(-5.0 - (double)h)); }

__global__ __launch_bounds__(256) void k_gemm_f32(const float* __restrict__ A, int lda, const float* __restrict__ Bm, int ldb,
                                                  float* __restrict__ C, int ldc, int M, int N, int K) {
    __shared__ float As[16][68];
    __shared__ float Bs[16][68];
    const int tx = threadIdx.x % 16, ty = threadIdx.x / 16;
    const int nTn = N / 64, nT = (M / 64) * nTn;
    for (int t = blockIdx.x; t < nT; t += gridDim.x) {
        const int m0 = (t / nTn) * 64, n0 = (t % nTn) * 64;
        float acc[4][4];
#pragma unroll
        for (int i = 0; i < 4; ++i)
#pragma unroll
            for (int j = 0; j < 4; ++j) acc[i][j] = 0.f;
        for (int k0 = 0; k0 < K; k0 += 16) {
            {
                const int r = threadIdx.x / 4, kk = (threadIdx.x % 4) * 4;
                const float4 v = *(const float4*)(A + (size_t)(m0 + r) * lda + k0 + kk);
                As[kk + 0][r] = v.x; As[kk + 1][r] = v.y; As[kk + 2][r] = v.z; As[kk + 3][r] = v.w;
            }
            {
                const int kk = threadIdx.x / 16, c = (threadIdx.x % 16) * 4;
                const float4 v = *(const float4*)(Bm + (size_t)(k0 + kk) * ldb + n0 + c);
                Bs[kk][c + 0] = v.x; Bs[kk][c + 1] = v.y; Bs[kk][c + 2] = v.z; Bs[kk][c + 3] = v.w;
            }
            __syncthreads();
#pragma unroll
            for (int kk = 0; kk < 16; ++kk) {
                float a0 = As[kk][ty * 4 + 0], a1 = As[kk][ty * 4 + 1], a2 = As[kk][ty * 4 + 2], a3 = As[kk][ty * 4 + 3];
                float b0 = Bs[kk][tx * 4 + 0], b1 = Bs[kk][tx * 4 + 1], b2 = Bs[kk][tx * 4 + 2], b3 = Bs[kk][tx * 4 + 3];
                acc[0][0] += a0 * b0; acc[0][1] += a0 * b1; acc[0][2] += a0 * b2; acc[0][3] += a0 * b3;
                acc[1][0] += a1 * b0; acc[1][1] += a1 * b1; acc[1][2] += a1 * b2; acc[1][3] += a1 * b3;
                acc[2][0] += a2 * b0; acc[2][1] += a2 * b1; acc[2][2] += a2 * b2; acc[2][3] += a2 * b3;
                acc[3][0] += a3 * b0; acc[3][1] += a3 * b1; acc[3][2] += a3 * b2; acc[3][3] += a3 * b3;
            }
            __syncthreads();
        }
#pragma unroll
        for (int i = 0; i < 4; ++i) {
            float4 v; v.x = acc[i][0]; v.y = acc[i][1]; v.z = acc[i][2]; v.w = acc[i][3];
            *(float4*)(C + (size_t)(m0 + ty * 4 + i) * ldc + n0 + tx * 4) = v;
        }
    }
}

__global__ void k_rope(float* __restrict__ proj) {
    const size_t n = (size_t)S * 1024;
    for (size_t idx = (size_t)blockIdx.x * blockDim.x + threadIdx.x; idx < n; idx += (size_t)gridDim.x * blockDim.x) {
        const int s = (int)(idx >> 10), r = (int)(idx & 1023);
        float* row = proj + (size_t)s * INW;
        if (r < 512) {
            const int which = r >> 8, h = (r >> 5) & 7, j = r & 31;
            const float inv = (float)pow(10000.0, -(double)j / 32.0);
            const float ang = (float)s * inv;
            const float c = (float)cos((double)ang), sn = (float)sin((double)ang);
            float* p = row + (which ? OFF_KA : OFF_QA) + h * 64;
            const float x1 = p[j], x2 = p[j + 32];
            p[j] = x1 * c - x2 * sn;
            p[j + 32] = x2 * c + x1 * sn;
        } else {
            const int rr = r - 512;
            const int which = rr >> 8, h = (rr >> 6) & 3, j = rr & 63;
            const float inv = (float)(1.0 / pow(10000.0, (double)j / 63.0));
            const float ang = (float)s * inv;
            const float c = (float)cos((double)ang), sn = (float)sin((double)ang);
            float* p = row + (which ? OFF_KR : OFF_QR) + h * 128;
            const float x1 = p[2 * j], x2 = p[2 * j + 1];
            float o1 = x1 * c - x2 * sn, o2 = x2 * c + x1 * sn;
            if (which) { const float sc = 0.08838834764831845f; o1 *= sc; o2 *= sc; }
            p[2 * j] = o1;
            p[2 * j + 1] = o2;
        }
    }
}

__global__ void k_kmean(const float* __restrict__ proj, float* __restrict__ kmean) {
    const int n = MH * MNB * MD;
    for (int idx = blockIdx.x * blockDim.x + threadIdx.x; idx < n; idx += gridDim.x * blockDim.x) {
        const int d = idx % MD, nb = (idx / MD) % MNB, h = idx / (MD * MNB);
        float sum = 0.f;
        for (int c = 0; c < MBLK; ++c) sum += proj[(size_t)(nb * MBLK + c) * INW + OFF_KA + h * MD + d];
        kmean[idx] = sum * (1.0f / MBLK);
    }
}
__global__ void k_moba_select(const float* __restrict__ proj, const float* __restrict__ kmean, int* __restrict__ sel) {
    const int n = S * MH;
    for (int idx = blockIdx.x * blockDim.x + threadIdx.x; idx < n; idx += gridDim.x * blockDim.x) {
        const int h = idx % MH, s = idx / MH, i = s / MBLK;
        const float* q = proj + (size_t)s * INW + OFF_QA + h * MD;
        float v0 = NEGF, v1 = NEGF, v2 = NEGF; int i0 = -1, i1 = -1, i2 = -1;
        for (int nb = 0; nb < i; ++nb) {
            const float* km = kmean + (size_t)(h * MNB + nb) * MD;
            float g = 0.f;
            for (int d = 0; d < MD; ++d) g += q[d] * km[d];
            if (g > v0) { v2 = v1; i2 = i1; v1 = v0; i1 = i0; v0 = g; i0 = nb; }
            else if (g > v1) { v2 = v1; i2 = i1; v1 = g; i1 = nb; }
            else if (g > v2) { v2 = g; i2 = nb; }
        }
        sel[(size_t)idx * 3 + 0] = i0; sel[(size_t)idx * 3 + 1] = i1; sel[(size_t)idx * 3 + 2] = i2;
    }
}
__global__ __launch_bounds__(256) void k_moba_attn(const float* __restrict__ proj, const int* __restrict__ sel, float* __restrict__ ya) {
    const int lane = threadIdx.x & 63;
    const int wpb = blockDim.x >> 6;
    const int nw = S * MH;
    for (int w = blockIdx.x * wpb + (threadIdx.x >> 6); w < nw; w += gridDim.x * wpb) {
        const int h = w % MH, s = w / MH, i = s / MBLK;
        const float q = proj[(size_t)s * INW + OFF_QA + h * MD + lane];
        float m = NEGF, l = 0.f, acc = 0.f;
        for (int r = 0; r < 4; ++r) {
            int blk, nkeys;
            if (r < 3) { blk = sel[(size_t)w * 3 + r]; nkeys = MBLK; if (blk < 0) continue; }
            else { blk = i; nkeys = s - i * MBLK + 1; }
            for (int c = 0; c < nkeys; ++c) {
                const float* kr = proj + (size_t)(blk * MBLK + c) * INW;
                float sc = wave_sum(q * kr[OFF_KA + h * MD + lane]) * 0.125f;
                const float mn = fmaxf(m, sc);
                const float a = expf(m - mn), p = expf(sc - mn);
                l = l * a + p;
                acc = acc * a + p * kr[OFF_VA + h * MD + lane];
                m = mn;
            }
        }
        ya[(size_t)s * 512 + h * MD + lane] = acc / l;
    }
}

__global__ void k_ret_kv(const float* __restrict__ proj, float* __restrict__ kv) {
    const size_t n = (size_t)RH * RNC * RDK * RDV;
    for (size_t idx = (size_t)blockIdx.x * blockDim.x + threadIdx.x; idx < n; idx += (size_t)gridDim.x * blockDim.x) {
        const int e = (int)(idx % RDV), d = (int)((idx / RDV) % RDK), nc = (int)((idx / ((size_t)RDV * RDK)) % RNC), h = (int)(idx / ((size_t)RDV * RDK * RNC));
        const float lg = ret_logg(h);
        float sum = 0.f;
        for (int c = 0; c < RC; ++c) {
            const float* row = proj + (size_t)(nc * RC + c) * INW;
            sum += row[OFF_KR + h * RDK + d] * expf(lg * (float)(RC - 1 - c)) * row[OFF_VR + h * RDV + e];
        }
        kv[idx] = sum;
    }
}
__global__ void k_ret_scan(const float* __restrict__ kv, float* __restrict__ prev) {
    const int n = RH * RDK * RDV;
    for (int idx = blockIdx.x * blockDim.x + threadIdx.x; idx < n; idx += gridDim.x * blockDim.x) {
        const int de = idx % (RDK * RDV), h = idx / (RDK * RDV);
        const float cd = expf(ret_logg(h) * (float)RC);
        float st = 0.f;
        for (int nc = 0; nc < RNC; ++nc) {
            const size_t o = ((size_t)(h * RNC + nc)) * RDK * RDV + de;
            prev[o] = st;
            st = st * cd + kv[o];
        }
    }
}
__global__ void k_ret_scores(const float* __restrict__ proj, float* __restrict__ sc) {
    const size_t n = (size_t)RH * RNC * RC * RC;
    for (size_t idx = (size_t)blockIdx.x * blockDim.x + threadIdx.x; idx < n; idx += (size_t)gridDim.x * blockDim.x) {
        const int m = (int)(idx % RC), c = (int)((idx / RC) % RC), nc = (int)((idx / ((size_t)RC * RC)) % RNC), h = (int)(idx / ((size_t)RC * RC * RNC));
        float v = 0.f;
        if (m <= c) {
            const float* qr = proj + (size_t)(nc * RC + c) * INW + OFF_QR + h * RDK;
            const float* kr = proj + (size_t)(nc * RC + m) * INW + OFF_KR + h * RDK;
            float sum = 0.f;
            for (int d = 0; d < RDK; ++d) sum += qr[d] * kr[d];
            v = sum * expf(ret_logg(h) * (float)(c - m));
        }
        sc[idx] = v;
    }
}
__global__ void k_ret_y(const float* __restrict__ proj, const float* __restrict__ sc, const float* __restrict__ prev, float* __restrict__ yr) {
    const size_t n = (size_t)S * RH * RDV;
    for (size_t idx = (size_t)blockIdx.x * blockDim.x + threadIdx.x; idx < n; idx += (size_t)gridDim.x * blockDim.x) {
        const int e = (int)(idx % RDV), h = (int)((idx / RDV) % RH), s = (int)(idx / ((size_t)RDV * RH));
        const int nc = s / RC, c = s % RC;
        const float* scr = sc + (((size_t)(h * RNC + nc)) * RC + c) * RC;
        float inner = 0.f;
        for (int m = 0; m <= c; ++m) inner += scr[m] * proj[(size_t)(nc * RC + m) * INW + OFF_VR + h * RDV + e];
        const float* qr = proj + (size_t)s * INW + OFF_QR + h * RDK;
        const float* pv = prev + ((size_t)(h * RNC + nc)) * RDK * RDV + e;
        float cross = 0.f;
        for (int d = 0; d < RDK; ++d) cross += qr[d] * pv[(size_t)d * RDV];
        yr[idx] = inner + cross * expf(ret_logg(h) * (float)(c + 1));
    }
}
__global__ __launch_bounds__(256) void k_ret_gn(const float* __restrict__ proj, float* __restrict__ yr) {
    const int lane = threadIdx.x & 63, wpb = blockDim.x >> 6;
    const int nw = S * RH;
    for (int w = blockIdx.x * wpb + (threadIdx.x >> 6); w < nw; w += gridDim.x * wpb) {
        const int h = w % RH, s = w / RH;
        float* y = yr + (size_t)s * 1024 + h * RDV;
        const float v0 = y[lane], v1 = y[lane + 64], v2 = y[lane + 128], v3 = y[lane + 192];
        const float mu = wave_sum(v0 + v1 + v2 + v3) * (1.0f / RDV);
        const float d0 = v0 - mu, d1 = v1 - mu, d2 = v2 - mu, d3 = v3 - mu;
        const float var = wave_sum(d0 * d0 + d1 * d1 + d2 * d2 + d3 * d3) * (1.0f / RDV);
        const float rs = 1.0f / sqrtf(var + LN_EPS);
        const float* g = proj + (size_t)s * INW + OFF_GR + h * RDV;
        const float g0 = g[lane], g1 = g[lane + 64], g2 = g[lane + 128], g3 = g[lane + 192];
        y[lane] = d0 * rs * (g0 / (1.0f + expf(-g0)));
        y[lane + 64] = d1 * rs * (g1 / (1.0f + expf(-g1)));
        y[lane + 128] = d2 * rs * (g2 / (1.0f + expf(-g2)));
        y[lane + 192] = d3 * rs * (g3 / (1.0f + expf(-g3)));
    }
}

__global__ void k_merge(const float* __restrict__ proj, float* __restrict__ ba, const float* __restrict__ br) {
    const size_t n = (size_t)S * D;
    for (size_t idx = (size_t)blockIdx.x * blockDim.x + threadIdx.x; idx < n; idx += (size_t)gridDim.x * blockDim.x) {
        const int d = (int)(idx % D), s = (int)(idx / D);
        const float ga = proj[(size_t)s * INW + OFF_GA + d], gr = proj[(size_t)s * INW + OFF_GRT + d];
        ba[idx] = ba[idx] / (1.0f + expf(-ga)) + br[idx] / (1.0f + expf(-gr));
    }
}
__global__ __launch_bounds__(256) void k_ln(const float* __restrict__ x, const float* __restrict__ y, const float* __restrict__ g, const float* __restrict__ b, float* __restrict__ out) {
    const int lane = threadIdx.x & 63, wpb = blockDim.x >> 6;
    for (int s = blockIdx.x * wpb + (threadIdx.x >> 6); s < S; s += gridDim.x * wpb) {
        float v[16];
        float sum = 0.f;
#pragma unroll
        for (int i = 0; i < 16; ++i) { v[i] = DN_ALPHA * x[(size_t)s * D + i * 64 + lane] + y[(size_t)s * D + i * 64 + lane]; sum += v[i]; }
        const float mu = wave_sum(sum) * (1.0f / D);
        float sq = 0.f;
#pragma unroll
        for (int i = 0; i < 16; ++i) { v[i] -= mu; sq += v[i] * v[i]; }
        const float rs = 1.0f / sqrtf(wave_sum(sq) * (1.0f / D) + LN_EPS);
#pragma unroll
        for (int i = 0; i < 16; ++i) out[(size_t)s * D + i * 64 + lane] = v[i] * rs * g[i * 64 + lane] + b[i * 64 + lane];
    }
}

__global__ void k_peer_scores(const float* __restrict__ pq, const float* __restrict__ keys, float* __restrict__ ps) {
    const size_t n = (size_t)S * PH * 2 * PNK;
    for (size_t idx = (size_t)blockIdx.x * blockDim.x + threadIdx.x; idx < n; idx += (size_t)gridDim.x * blockDim.x) {
        const int k = (int)(idx % PNK), p = (int)((idx / PNK) % 2), h = (int)((idx / (PNK * 2)) % PH), s = (int)(idx / ((size_t)PNK * 2 * PH));
        const float* q = pq + (size_t)s * 2048 + h * 256 + p * 128;
        const float* kk = keys + ((size_t)p * PNK + k) * PKD;
        float sum = 0.f;
        for (int d = 0; d < PKD; ++d) sum += q[d] * kk[d];
        ps[idx] = sum;
    }
}
__global__ void k_peer_top1(const float* __restrict__ ps, float* __restrict__ st, int* __restrict__ it) {
    const int n = S * PH * 2;
    for (int idx = blockIdx.x * blockDim.x + threadIdx.x; idx < n; idx += gridDim.x * blockDim.x) {
        const float* v = ps + (size_t)idx * PNK;
        float pv = 0.f; int pi = -1;
        for (int r = 0; r < PK; ++r) {
            float bv = 0.f; int bi = -1;
            for (int k = 0; k < PNK; ++k) {
                const float x = v[k];
                const bool elig = (pi < 0) || (x < pv) || (x == pv && k > pi);
                if (elig && (bi < 0 || x > bv)) { bv = x; bi = k; }
            }
            st[(size_t)idx * PK + r] = bv; it[(size_t)idx * PK + r] = bi;
            pv = bv; pi = bi;
        }
    }
}
__global__ void k_peer_top2(const float* __restrict__ st, const int* __restrict__ it, int* __restrict__ fi, float* __restrict__ fg) {
    const int n = S * PH;
    for (int idx = blockIdx.x * blockDim.x + threadIdx.x; idx < n; idx += gridDim.x * blockDim.x) {
        const float* s0 = st + (size_t)(idx * 2 + 0) * PK; const float* s1 = st + (size_t)(idx * 2 + 1) * PK;
        const int* i0 = it + (size_t)(idx * 2 + 0) * PK; const int* i1 = it + (size_t)(idx * 2 + 1) * PK;
        float pv = 0.f; int pi = -1;
        float mx = 0.f;
        for (int r = 0; r < PK; ++r) {
            float bv = 0.f; int bi = -1;
            for (int c = 0; c < PK * PK; ++c) {
                const float x = s0[c >> 4] + s1[c & 15];
                const bool elig = (pi < 0) || (x < pv) || (x == pv && c > pi);
                if (elig && (bi < 0 || x > bv)) { bv = x; bi = c; }
            }
            if (r == 0) mx = bv;
            fi[(size_t)idx * PK + r] = i0[bi >> 4] * PNK + i1[bi & 15];
            fg[(size_t)idx * PK + r] = bv;
            pv = bv; pi = bi;
        }
        float sum = 0.f;
        for (int r = 0; r < PK; ++r) sum += expf(fg[(size_t)idx * PK + r] - mx);
        for (int r = 0; r < PK; ++r) fg[(size_t)idx * PK + r] = expf(fg[(size_t)idx * PK + r] - mx) / sum;
    }
}
__device__ __forceinline__ float gelu_tanh(float x) {
    return 0.5f * x * (1.0f + tanhf(0.7978845608028654f * (x + 0.044715f * x * x * x)));
}
__global__ __launch_bounds__(256) void k_peer_ffn_ln(const float* __restrict__ x, const int* __restrict__ fi, const float* __restrict__ fg,
                                                     const float* __restrict__ U, const float* __restrict__ V,
                                                     const float* __restrict__ g, const float* __restrict__ b, float* __restrict__ out) {
    const int lane = threadIdx.x & 63, wpb = blockDim.x >> 6;
    for (int s = blockIdx.x * wpb + (threadIdx.x >> 6); s < S; s += gridDim.x * wpb) {
        float xv[16], acc[16];
#pragma unroll
        for (int i = 0; i < 16; ++i) { xv[i] = x[(size_t)s * D + i * 64 + lane]; acc[i] = 0.f; }
        for (int j = 0; j < PH * PK; ++j) {
            const int e = fi[(size_t)s * (PH * PK) + j];
            const float gw = fg[(size_t)s * (PH * PK) + j];
            const float* u = U + (size_t)e * D;
            const float* vv = V + (size_t)e * D;
            float dot = 0.f;
#pragma unroll
            for (int i = 0; i < 16; ++i) dot += xv[i] * u[i * 64 + lane];
            dot = wave_sum(dot);
            const float w = gw * gelu_tanh(dot);
#pragma unroll
            for (int i = 0; i < 16; ++i) acc[i] += w * vv[i * 64 + lane];
        }
        float sum = 0.f;
#pragma unroll
        for (int i = 0; i < 16; ++i) { acc[i] = DN_ALPHA * xv[i] + acc[i]; sum += acc[i]; }
        const float mu = wave_sum(sum) * (1.0f / D);
        float sq = 0.f;
#pragma unroll
        for (int i = 0; i < 16; ++i) { acc[i] -= mu; sq += acc[i] * acc[i]; }
        const float rs = 1.0f / sqrtf(wave_sum(sq) * (1.0f / D) + LN_EPS);
#pragma unroll
        for (int i = 0; i < 16; ++i) out[(size_t)s * D + i * 64 + lane] = acc[i] * rs * g[i * 64 + lane] + b[i * 64 + lane];
    }
}

extern "C" void kernel_launch(void* const* d_in, const int* in_sizes, int n_in, void* d_out, int out_size, void* d_ws, size_t ws_size,
                              hipStream_t stream) {
    const float* x_in = (const float*)d_in[0];
    const float* w_in = (const float*)d_in[1];
    const float* w_mo = (const float*)d_in[2];
    const float* w_ro = (const float*)d_in[3];
    const float* w_o = (const float*)d_in[4];
    const float* ln1g = (const float*)d_in[5];
    const float* ln1b = (const float*)d_in[6];
    const float* pwq = (const float*)d_in[7];
    const float* pkeys = (const float*)d_in[8];
    const float* pu = (const float*)d_in[9];
    const float* pv = (const float*)d_in[10];
    const float* ln2g = (const float*)d_in[11];
    const float* ln2b = (const float*)d_in[12];
    float* out = (float*)d_out;

    float* ws = (float*)d_ws;
    size_t o = 0;
    auto take = [&](size_t n) { float* p = ws + o; o += (n + 63) & ~(size_t)63; return p; };
    float* proj = take((size_t)S * INW);
    float* ya = take((size_t)S * 512);
    float* kv = take((size_t)RH * RNC * RDK * RDV);
    float* prev = take((size_t)RH * RNC * RDK * RDV);
    float* scb = take((size_t)RH * RNC * RC * RC);
    float* yr = take((size_t)S * 1024);
    float* brr = take((size_t)S * 1024);
    float* mix = take((size_t)S * 1024);
    float* x1 = take((size_t)S * 1024);
    float* xl = take((size_t)S * 1024);
    float* kmean = take((size_t)MH * MNB * MD);
    int* sel = (int*)take((size_t)S * MH * 3);
    if (o * sizeof(float) > ws_size) { fprintf(stderr, "workspace too small: need %zu have %zu\n", o * sizeof(float), ws_size); return; }
    float* pq = proj;
    float* ps = pq + (size_t)S * 2048;
    float* st = ps + (size_t)S * 2048;
    int* it = (int*)(st + (size_t)S * PH * 2 * PK);
    int* fi = (int*)(st + 2 * (size_t)S * PH * 2 * PK);
    float* fg = st + 2 * (size_t)S * PH * 2 * PK + (size_t)S * PH * PK;
    float* bra = scb;

    const int G = 2048, TB = 256;
    for (int b = 0; b < NB; ++b) {
        const float* xcur = x_in + (size_t)b * S * D;
        for (int l = 0; l < 2; ++l) {
            float* xnext = (l == 0) ? xl : out + (size_t)b * S * D;
            k_gemm_f32<<<G, 256, 0, stream>>>(xcur, D, w_in + (size_t)l * D * INW, INW, proj, INW, S, INW, D);
            k_rope<<<G, TB, 0, stream>>>(proj);
            k_kmean<<<64, TB, 0, stream>>>(proj, kmean);
            k_moba_select<<<256, TB, 0, stream>>>(proj, kmean, sel);
            k_moba_attn<<<G, 256, 0, stream>>>(proj, sel, ya);
            k_ret_kv<<<G, TB, 0, stream>>>(proj, kv);
            k_ret_scan<<<512, TB, 0, stream>>>(kv, prev);
            k_ret_scores<<<G, TB, 0, stream>>>(proj, scb);
            k_ret_y<<<G, TB, 0, stream>>>(proj, scb, prev, yr);
            k_ret_gn<<<G, 256, 0, stream>>>(proj, yr);
            k_gemm_f32<<<G, 256, 0, stream>>>(ya, 512, w_mo + (size_t)l * 512 * D, D, bra, D, S, D, 512);
            k_gemm_f32<<<G, 256, 0, stream>>>(yr, 1024, w_ro + (size_t)l * 1024 * D, D, brr, D, S, D, 1024);
            k_merge<<<G, TB, 0, stream>>>(proj, bra, brr);
            k_gemm_f32<<<G, 256, 0, stream>>>(bra, D, w_o + (size_t)l * D * D, D, mix, D, S, D, D);
            k_ln<<<G, 256, 0, stream>>>(xcur, mix, ln1g + l * D, ln1b + l * D, x1);
            k_gemm_f32<<<G, 256, 0, stream>>>(x1, D, pwq + (size_t)l * D * 2048, 2048, pq, 2048, S, 2048, D);
            k_peer_scores<<<G, TB, 0, stream>>>(pq, pkeys + (size_t)l * 2 * PNK * PKD, ps);
            k_peer_top1<<<512, TB, 0, stream>>>(ps, st, it);
            k_peer_top2<<<256, TB, 0, stream>>>(st, it, fi, fg);
            k_peer_ffn_ln<<<G, 256, 0, stream>>>(x1, fi, fg, pu + (size_t)l * 16384 * D, pv + (size_t)l * 16384 * D, ln2g + l * D, ln2b + l * D, xnext);
            xcur = xnext;
        }
    }
}
```

```cpp
#include <hip/hip_runtime.h>
#include <cstdint>
#include <cstdio>

constexpr int D = 1024, NB = 2, S = 8192, T = NB * S;
constexpr int INW = 6656;
constexpr int OFF_QA = 0, OFF_KA = 512, OFF_VA = 1024, OFF_QR = 1536, OFF_KR = 2048, OFF_VR = 2560,
              OFF_GR = 3584, OFF_GA = 4608, OFF_GRT = 5632;
constexpr int MH = 8, MD = 64, MBLK = 256, MNB = S / MBLK;
constexpr int RH = 4, RDK = 128, RDV = 256, RC = 256, RNC = S / RC;
constexpr int PH = 8, PK = 16, PNK = 128, PKD = 128;
constexpr int NEXP = 16384;
constexpr float LN_EPS = 1e-5f;
constexpr float DN_ALPHA = 1.4142135623730951f;
constexpr float NEGF = -1e30f;
constexpr int WIN_ROWS = 7168, WIN_NROWS = 5120, WIN_SROWS = 2048;

#define LAS __attribute__((address_space(3)))
typedef unsigned short bf16_t;
typedef float f32x4 __attribute__((ext_vector_type(4)));
typedef unsigned u32x4 __attribute__((ext_vector_type(4)));
typedef unsigned u32x2 __attribute__((ext_vector_type(2)));

constexpr size_t MiB = 1u << 20;
constexpr size_t WS_CTL = 0, CTL_BYTES = 65536;
constexpr size_t WS_WIN = 1 * MiB, WIN_LSTRIDE = (size_t)WIN_ROWS * D * 2;
constexpr size_t WS_WMO = 29 * MiB, WS_WRO = 31 * MiB, WS_WO = 35 * MiB, WS_WQ = 39 * MiB;
constexpr size_t WS_KEYS = 47 * MiB, WS_TBL = 48 * MiB, WS_ROPEA = 49 * MiB, WS_ROPER = 51 * MiB, WS_ROPERT = 55 * MiB, WS_KMP = 59 * MiB;
constexpr size_t WS_XB = 60 * MiB;
constexpr size_t WS_QA = 92 * MiB, WS_KA = 108 * MiB, WS_VAT = 124 * MiB, WS_QR = 140 * MiB, WS_PQ = WS_QA;
constexpr size_t WS_KR = 156 * MiB, WS_KRT = 172 * MiB;
constexpr size_t WS_VRT = 188 * MiB, WS_MERGED = WS_VRT;
constexpr size_t WS_GR = 220 * MiB, WS_GA = 252 * MiB, WS_GRT = 284 * MiB;
constexpr size_t WS_KVT = 316 * MiB, WS_YR = WS_KVT, WS_PIDX = WS_KVT, WS_PW = WS_KVT + 8 * MiB;
constexpr size_t WS_PREVT = 348 * MiB;
constexpr size_t WS_X1 = 364 * MiB;
constexpr size_t WS_MPART = WS_X1, WS_MOWNO = 428 * MiB, WS_MOWNML = 444 * MiB, WS_MSEL = 446 * MiB;
constexpr size_t WS_TABU = 428 * MiB, WS_TABV = 444 * MiB, WS_SINV = 460 * MiB;
constexpr size_t WS_STAT = 462 * MiB;
constexpr size_t WS_END = 464 * MiB;
constexpr size_t TB_CSUM = 16384, TB_BQ = 32768, TB_KC = 49152, TB_KB = 65536, TB_RS = 131072, TB_PARTC = 524288, TB_PARTB = 786432;

__device__ __forceinline__ float bf2f(bf16_t b) { return __uint_as_float(((unsigned)b) << 16); }
__device__ __forceinline__ unsigned f2bf(float f) { const unsigned u = __float_as_uint(f); return (u + 0x7fffu + ((u >> 16) & 1u)) >> 16; }
__device__ __forceinline__ unsigned pk2(float lo, float hi) { return f2bf(lo) | (f2bf(hi) << 16); }
__device__ __forceinline__ float wave_sum(float v) {
#pragma unroll
    for (int o = 32; o >= 1; o >>= 1) v += __shfl_xor(v, o);
    return v;
}
__device__ __forceinline__ float ret_logg(int h) { return (float)log(1.0 - exp2(-5.0 - (double)h)); }
__device__ __forceinline__ float gelu_tanh(float x) { return 0.5f * x * (1.0f + tanhf(0.7978845608028654f * (x + 0.044715f * x * x * x))); }
__device__ __forceinline__ float sigmoidf_(float x) { return __builtin_amdgcn_rcpf(1.0f + __expf(-x)); }
__device__ __forceinline__ unsigned tidx() { unsigned t = threadIdx.x; asm volatile("" : "+v"(t)); return t; }
__device__ __forceinline__ unsigned bidx() { unsigned t = blockIdx.x; asm volatile("" : "+s"(t)); return t; }
__device__ __forceinline__ unsigned gdim() { unsigned t = gridDim.x; asm volatile("" : "+s"(t)); return t; }
namespace pg8 {
#define PG8_LAS __attribute__((address_space(3)))
typedef unsigned short bf16_t;
typedef short bf16x8 __attribute__((ext_vector_type(8)));
typedef float f32x4 __attribute__((ext_vector_type(4)));
typedef unsigned u32x4 __attribute__((ext_vector_type(4)));
constexpr int BM = 256, BK = 64, HALF = 128, HTB = HALF * BK * 2  , STAGE_BYTES = 8 * HTB, NXCD = 8, WGM = 8;

__host__ __device__ __forceinline__ int lds_byte(int r, int c) { const int st = (r >> 4) * 2 + (c >> 5), rr = r & 15, cc = c & 31, ob = rr * 64 + cc * 2; return st * 1024 + (ob ^ (((ob >> 9) & 1) << 5)); }
__host__ __device__ __forceinline__ void stage_rc(int b, int& R, int& C) { const int st = b / 1024, sb = b % 1024, swz = sb ^ (((sb >> 9) & 1) << 5); R = (st >> 1) * 16 + swz / 64; C = (st & 1) * 32 + (swz % 64) / 2; }
__host__ __device__ __forceinline__ int perm32(int rho) { const int n = rho >> 4, i = rho & 15; return 8 * (i >> 2) + 4 * n + (i & 3); }

struct Unit { int pm, pn; };
struct Gemm { const bf16_t* A; const bf16_t* Bt; int M, N, K; };

struct StaticOrder {
    int nM, nN, nwg, G, c;
    __host__ __device__ void init(int M, int N, int G_, int c_) { nM = M / BM; nN = N / BM; nwg = nM * nN; G = G_; c = c_; }
    __host__ __device__ bool next(int i, Unit& u) const {
        const long L = (long)i * G + c; if (L >= nwg) return false;
        int wgid = (int)L; { const int q = nwg / NXCD, r = nwg % NXCD, xcd = wgid % NXCD, off = wgid / NXCD; wgid = (xcd < r ? xcd * (q + 1) : r * (q + 1) + (xcd - r) * q) + off; }
        const int nig = WGM * nN, gid = wgid / nig, fm = gid * WGM, gsz = (nM - fm) < WGM ? (nM - fm) : WGM;
        u.pm = fm + ((wgid % nig) % gsz); u.pn = (wgid % nig) / gsz; return true;
    }
    __device__ __forceinline__ void a_ready(const Unit&) const {}
    __device__ __forceinline__ void done(const Unit&) const {}
};

__device__ __forceinline__ unsigned cvt_pk_bf16(float lo, float hi) { unsigned r; asm volatile("v_cvt_pk_bf16_f32 %0, %1, %2" : "=v"(r) : "v"(lo), "v"(hi)); return r; }
typedef float f32x2 __attribute__((ext_vector_type(2)));
template <class Epi, class Sched, bool ALIGN_EPI = false, bool SP2 = false>
__device__ __forceinline__ void gemm_phase(PG8_LAS unsigned char* lds, const Gemm g, const Sched& S, const Epi& E) {
    int tid_ = threadIdx.x; asm volatile("" : "+v"(tid_));
    const int tid = tid_, wid = __builtin_amdgcn_readfirstlane(tid >> 6), lane = tid & 63, wr = wid >> 2, wc = wid & 3, fr = lane & 15, fq = lane >> 4;
    const int K = g.K, nt = K / BK;
    unsigned voffA[2], voffB[2];
#pragma unroll
    for (int i = 0; i < 2; ++i) { int R, C; stage_rc(tid * 16 + i * 8192, R, C); const int Rb = Epi::PERM ? ((R & ~31) + perm32(R & 31)) : R;
        voffA[i] = (unsigned)(R * K + C) * 2u; voffB[i] = (unsigned)(Rb * K + C) * 2u; }
    const size_t kstep = (size_t)(BK * 2);
    const size_t hstep = (size_t)HALF * K * 2;
    const size_t tstep = 2 * hstep;
    const unsigned ldsw = (unsigned)wid * 1024u;
    const int aoff = lds_byte(wr * 64 + fr, fq * 8), boff = lds_byte(wc * 32 + fr, fq * 8);
#define PG8_SA(b, h) (((b) * 2 + (h)) * HTB)
#define PG8_SB(b, h) ((4 + (b) * 2 + (h)) * HTB)
#define PG8_STAGE(bufoff, gbase, voff) do { _Pragma("unroll") for (int _i = 0; _i < 2; ++_i) \
        __builtin_amdgcn_global_load_lds((const unsigned*)((const char*)(gbase) + (voff)[_i]), (PG8_LAS unsigned*)(lds + (bufoff) + ldsw + _i * 8192), 16, 0, 0); } while (0)
#define PG8_LDA(dst, b, h) do { _Pragma("unroll") for (int m = 0; m < 4; ++m) _Pragma("unroll") for (int k = 0; k < 2; ++k) dst[m][k] = *(const PG8_LAS bf16x8*)(lds + PG8_SA(b, h) + aoff + m * 2048 + k * 1024); } while (0)
#define PG8_LDB(dst, b, h) do { _Pragma("unroll") for (int n = 0; n < 2; ++n) _Pragma("unroll") for (int k = 0; k < 2; ++k) dst[n][k] = *(const PG8_LAS bf16x8*)(lds + PG8_SB(b, h) + boff + n * 2048 + k * 1024); } while (0)
#define PG8_MMA(ai, bj, At, Bt) do { __builtin_amdgcn_s_setprio(1); _Pragma("unroll") for (int m = 0; m < 4; ++m) _Pragma("unroll") for (int n = 0; n < 2; ++n) _Pragma("unroll") for (int k = 0; k < 2; ++k) \
        acc[ai][bj][m][n] = __builtin_amdgcn_mfma_f32_16x16x32_bf16(Bt[n][k], At[m][k], acc[ai][bj][m][n], 0, 0, 0); __builtin_amdgcn_s_setprio(0); } while (0)
#define PG8_WAIT_V(n) asm volatile("s_waitcnt vmcnt(" #n ")" ::: "memory")
#define PG8_WAIT_L(n) asm volatile("s_waitcnt lgkmcnt(" #n ")" ::: "memory")
#define PG8_BAR __builtin_amdgcn_s_barrier()
#define PG8_SCHED __builtin_amdgcn_sched_barrier(0)
    Unit cur, nxt; int ui = 0;
    if (!S.next(0, cur)) return;
    f32x4 acc[2][2][4][2];
#pragma unroll
    for (int a = 0; a < 2; ++a)
#pragma unroll
        for (int b = 0; b < 2; ++b)
#pragma unroll
            for (int m = 0; m < 4; ++m)
#pragma unroll
                for (int n = 0; n < 2; ++n) acc[a][b][m][n] = (f32x4){0.f, 0.f, 0.f, 0.f};
    bf16x8 At[4][2], B0[2][2], B1[2][2];
    const char* cA = (const char*)g.A + (size_t)cur.pm * tstep; const char* cB = (const char*)g.Bt + (size_t)cur.pn * tstep;
    S.a_ready(cur);
    if constexpr (SP2) {
        PG8_STAGE(PG8_SB(0, 0), cB, voffB); PG8_STAGE(PG8_SB(0, 1), cB + hstep, voffB); PG8_STAGE(PG8_SA(0, 0), cA, voffA); PG8_STAGE(PG8_SA(0, 1), cA + hstep, voffA);
        if (wr == 1) PG8_BAR;
        PG8_WAIT_V(2); PG8_BAR;
        PG8_STAGE(PG8_SB(1, 0), cB + kstep, voffB); PG8_STAGE(PG8_SA(1, 0), cA + kstep, voffA); PG8_STAGE(PG8_SB(1, 1), cB + hstep + kstep, voffB);
        PG8_WAIT_V(6); PG8_BAR;
    } else {
        PG8_STAGE(PG8_SB(0, 0), cB, voffB); PG8_STAGE(PG8_SA(0, 0), cA, voffA); PG8_STAGE(PG8_SB(0, 1), cB + hstep, voffB); PG8_STAGE(PG8_SA(0, 1), cA + hstep, voffA);
        if (wr == 1) PG8_BAR;
        PG8_WAIT_V(4); PG8_BAR;
        PG8_STAGE(PG8_SB(1, 0), cB + kstep, voffB); PG8_STAGE(PG8_SA(1, 0), cA + kstep, voffA); PG8_STAGE(PG8_SB(1, 1), cB + hstep + kstep, voffB);
        PG8_WAIT_V(6); PG8_BAR;
    }
    for (;;) {
        const bool has_next = S.next(ui + 1, nxt);
        const char* nA = has_next ? (const char*)g.A + (size_t)nxt.pm * tstep : cA; const char* nB = has_next ? (const char*)g.Bt + (size_t)nxt.pn * tstep : cB;
        for (int t = 0; t < nt; t += 2) {
            const bool last = (t == nt - 2);
            const char* a1 = cA + (size_t)(t + 1) * kstep;
            const char* a2 = last ? nA : cA + (size_t)(t + 2) * kstep; const char* b2 = last ? nB : cB + (size_t)(t + 2) * kstep;
            const char* a3 = a2 + kstep; const char* b3 = b2 + kstep;
            if (last && has_next) S.a_ready(nxt);
            if constexpr (SP2) {
            PG8_LDB(B0, 0, 0); PG8_LDB(B1, 0, 1); PG8_SCHED; PG8_LDA(At, 0, 0); PG8_STAGE(PG8_SA(1, 1), a1 + hstep, voffA);
            PG8_WAIT_V(8); PG8_WAIT_L(0); PG8_BAR; PG8_MMA(0, 0, At, B0); PG8_MMA(0, 1, At, B1); PG8_BAR; PG8_SCHED;
            PG8_LDA(At, 0, 1); PG8_STAGE(PG8_SB(0, 0), b2, voffB); PG8_STAGE(PG8_SB(0, 1), b2 + hstep, voffB); PG8_STAGE(PG8_SA(0, 0), a2, voffA);
            PG8_WAIT_V(8); PG8_WAIT_L(0); PG8_BAR; PG8_MMA(1, 0, At, B0); PG8_MMA(1, 1, At, B1); PG8_BAR; PG8_SCHED;
            PG8_LDB(B0, 1, 0); PG8_LDB(B1, 1, 1); PG8_SCHED; PG8_LDA(At, 1, 0); PG8_STAGE(PG8_SA(0, 1), a2 + hstep, voffA);
            PG8_WAIT_V(8); PG8_WAIT_L(0); PG8_BAR; PG8_MMA(0, 0, At, B0); PG8_MMA(0, 1, At, B1); PG8_BAR; PG8_SCHED;
            PG8_LDA(At, 1, 1); PG8_STAGE(PG8_SB(1, 0), b3, voffB); PG8_STAGE(PG8_SB(1, 1), b3 + hstep, voffB); PG8_STAGE(PG8_SA(1, 0), a3, voffA);
            PG8_WAIT_V(8); PG8_WAIT_L(0); PG8_BAR; PG8_MMA(1, 0, At, B0); PG8_MMA(1, 1, At, B1); PG8_BAR; PG8_SCHED;
            } else {
            PG8_LDB(B0, 0, 0); PG8_SCHED; PG8_LDA(At, 0, 0); PG8_STAGE(PG8_SA(1, 1), a1 + hstep, voffA);
            PG8_WAIT_L(8); PG8_BAR; PG8_WAIT_L(0); PG8_MMA(0, 0, At, B0); PG8_BAR; PG8_SCHED;
            PG8_LDB(B1, 0, 1); PG8_STAGE(PG8_SB(0, 0), b2, voffB);
            PG8_BAR; PG8_WAIT_L(0); PG8_MMA(0, 1, At, B1); PG8_BAR;
            PG8_LDA(At, 0, 1); PG8_STAGE(PG8_SA(0, 0), a2, voffA);
            PG8_BAR; PG8_WAIT_L(0); PG8_MMA(1, 0, At, B0); PG8_BAR; PG8_SCHED;
            PG8_STAGE(PG8_SB(0, 1), b2 + hstep, voffB);
            PG8_WAIT_V(6); PG8_BAR; PG8_MMA(1, 1, At, B1); PG8_BAR;
            PG8_LDB(B0, 1, 0); PG8_SCHED; PG8_LDA(At, 1, 0); PG8_STAGE(PG8_SA(0, 1), a2 + hstep, voffA);
            PG8_WAIT_L(8); PG8_BAR; PG8_WAIT_L(0); PG8_MMA(0, 0, At, B0); PG8_BAR; PG8_SCHED;
            PG8_LDB(B1, 1, 1); PG8_STAGE(PG8_SB(1, 0), b3, voffB);
            PG8_BAR; PG8_WAIT_L(0); PG8_MMA(0, 1, At, B1); PG8_BAR;
            PG8_LDA(At, 1, 1); PG8_STAGE(PG8_SA(1, 0), a3, voffA);
            PG8_BAR; PG8_WAIT_L(0); PG8_MMA(1, 0, At, B0); PG8_BAR; PG8_SCHED;
            PG8_STAGE(PG8_SB(1, 1), b3 + hstep, voffB);
            PG8_WAIT_V(6); PG8_BAR; PG8_MMA(1, 1, At, B1); PG8_BAR;
            }
        }
        if constexpr (ALIGN_EPI) { if (wr == 0) PG8_BAR; }
        if constexpr (!Epi::AFTER_DRAIN) { E(acc, cur, wr, wc, fr, fq); S.done(cur); }
        if (!has_next) break;
#pragma unroll
        for (int a = 0; a < 2; ++a)
#pragma unroll
            for (int b = 0; b < 2; ++b)
#pragma unroll
                for (int m = 0; m < 4; ++m)
#pragma unroll
                    for (int n = 0; n < 2; ++n) acc[a][b][m][n] = (f32x4){0.f, 0.f, 0.f, 0.f};
        cur = nxt; cA = nA; cB = nB; ++ui;
        if constexpr (ALIGN_EPI) { if (wr == 1) PG8_BAR; }
    }
    PG8_WAIT_V(0);
    if constexpr (!ALIGN_EPI) { if (wr == 0) PG8_BAR; }
    PG8_BAR;
    if constexpr (Epi::AFTER_DRAIN) { E.fused(acc, cur, wr, wc, fr, fq, lds, wid, lane); S.done(cur); }
#undef PG8_SA
#undef PG8_SB
#undef PG8_STAGE
#undef PG8_LDA
#undef PG8_LDB
#undef PG8_MMA
#undef PG8_WAIT_V
#undef PG8_WAIT_L
#undef PG8_BAR
#undef PG8_SCHED
}
}
using pg8::Unit;
typedef float f32x2_t __attribute__((ext_vector_type(2))); typedef __bf16 bf16x2_t __attribute__((ext_vector_type(2)));
__device__ __forceinline__ unsigned cvtpk(float lo, float hi) { f32x2_t v = {lo, hi}; bf16x2_t b = __builtin_convertvector(v, bf16x2_t); return __builtin_bit_cast(unsigned, b); }
typedef pg8::f32x4 af4;
__device__ __forceinline__ void st8bf(bf16_t* p, const float (&o)[8]) {
    u32x4 w; w.x = cvtpk(o[0], o[1]); w.y = cvtpk(o[2], o[3]); w.z = cvtpk(o[4], o[5]); w.w = cvtpk(o[6], o[7]);
    *(u32x4*)p = w;
}
__device__ __forceinline__ void rot8(const af4& v0, const af4& v1, const float4& r0, const float4& r1, float (&o)[8]) {
    o[0] = v0[0] * r0.x - v0[1] * r0.y; o[1] = v0[1] * r0.x + v0[0] * r0.y;
    o[2] = v0[2] * r0.z - v0[3] * r0.w; o[3] = v0[3] * r0.z + v0[2] * r0.w;
    o[4] = v1[0] * r1.x - v1[1] * r1.y; o[5] = v1[1] * r1.x + v1[0] * r1.y;
    o[6] = v1[2] * r1.z - v1[3] * r1.w; o[7] = v1[3] * r1.z + v1[2] * r1.w;
}

__device__ __forceinline__ void st8v(bf16_t* p, const af4& a, const af4& b) {
    u32x4 w; w.x = cvtpk(a[0], a[1]); w.y = cvtpk(a[2], a[3]); w.z = cvtpk(b[0], b[1]); w.w = cvtpk(b[2], b[3]);
    *(u32x4*)p = w;
}
__device__ __forceinline__ af4 rot4(const af4& v, const float4& r) {
    af4 o; o[0] = v[0] * r.x - v[1] * r.y; o[1] = v[1] * r.x + v[0] * r.y; o[2] = v[2] * r.z - v[3] * r.w; o[3] = v[3] * r.z + v[2] * r.w; return o;
}
__device__ __forceinline__ af4 red16(af4 v) {
#pragma unroll
    for (int e = 0; e < 4; ++e) { float x = v[e]; x += __shfl_xor(x, 1); x += __shfl_xor(x, 2); x += __shfl_xor(x, 4); x += __shfl_xor(x, 8); v[e] = x; }
    return v;
}
struct EpiMobaQK {
    static constexpr bool PERM = true, AFTER_DRAIN = false;
    unsigned char* ws;
    __device__ __forceinline__ void operator()(const af4 (&acc)[2][2][4][2], const Unit& u, int wr, int wc, int fr, int fq) const {
        const float* const ropeA = (const float*)(ws + WS_ROPEA);
        const int pn = u.pn;
        const int row0 = u.pm * 256 + wr * 64 + fr;
        const int c0 = (pn & 1) * 256 + wc * 32 + 8 * fq;
        const float* rbase = ropeA + ((c0 & 63) >> 1) * 2;
        if (pn < 2) {
            bf16_t* const QA = (bf16_t*)(ws + WS_QA);
            float4 rr[2][2];
            { const float4* rp = (const float4*)(rbase + (size_t)(row0 & (S - 1)) * 64); rr[0][0] = rp[0]; rr[0][1] = rp[1]; }
#pragma unroll
            for (int it = 0; it < 8; ++it) {
                const int ai = it >> 2, m = it & 3;
                const int row = row0 + ai * 128 + m * 16;
                if (it < 7) { const int nrow = row0 + ((it + 1) >> 2) * 128 + ((it + 1) & 3) * 16; const float4* rp = (const float4*)(rbase + (size_t)(nrow & (S - 1)) * 64); rr[(it + 1) & 1][0] = rp[0]; rr[(it + 1) & 1][1] = rp[1]; }
                asm volatile("" ::: "memory");
                const float4 r0 = rr[it & 1][0], r1 = rr[it & 1][1];
#pragma unroll
                for (int bj = 0; bj < 2; ++bj) {
                    const af4 o0 = rot4(acc[ai][bj][m][0], r0) * 0.125f, o1 = rot4(acc[ai][bj][m][1], r1) * 0.125f;
                    st8v(QA + (size_t)row * 512 + c0 + bj * 128, o0, o1);
                }
            }
        } else {
            bf16_t* const KA = (bf16_t*)(ws + WS_KA);
            af4 k00 = {0.f, 0.f, 0.f, 0.f}, k01 = k00, k10 = k00, k11 = k00;
#pragma unroll
            for (int it = 0; it < 8; ++it) {
                const int ai = it >> 2, m = it & 3;
                const int row = row0 + ai * 128 + m * 16;
                asm volatile("" ::: "memory");
                const float4* rp = (const float4*)(rbase + (size_t)(row & (S - 1)) * 64);
                const float4 r0 = rp[0], r1 = rp[1];
                const af4 a0 = rot4(acc[ai][0][m][0], r0), a1 = rot4(acc[ai][0][m][1], r1);
                const af4 b0 = rot4(acc[ai][1][m][0], r0), b1 = rot4(acc[ai][1][m][1], r1);
                k00 += a0; k01 += a1; k10 += b0; k11 += b1;
                st8v(KA + (size_t)row * 512 + c0, a0, a1);
                st8v(KA + (size_t)row * 512 + c0 + 128, b0, b1);
            }
            k00 = red16(k00); k01 = red16(k01); k10 = red16(k10); k11 = red16(k11);
            if (fr == 0) {
                float* kp = (float*)(ws + WS_KMP) + ((size_t)(u.pm * 2 + wr)) * 512 + c0;
                *(af4*)kp = k00; *(af4*)(kp + 4) = k01; *(af4*)(kp + 128) = k10; *(af4*)(kp + 132) = k11;
            }
        }
    }
};
struct EpiRetQK {
    static constexpr bool PERM = true, AFTER_DRAIN = false;
    unsigned char* ws;
    __device__ __forceinline__ void operator()(const af4 (&acc)[2][2][4][2], const Unit& u, int wr, int wc, int fr, int fq) const {
        const float* const ropeR = (const float*)(ws + WS_ROPER);
        const int pn = u.pn;
        const bool isK = pn >= 2;
        bf16_t* const dst = (bf16_t*)(ws + (isK ? WS_KR : WS_QR));
        const float* const tab = (const float*)(ws + WS_TBL) + (isK ? 1024 : 0);
        const int row0 = u.pm * 256 + wr * 64 + fr;
        const int c0 = (pn & 1) * 256 + wc * 32 + 8 * fq;
        const int h0 = c0 >> 7;
        const float* rbase = ropeR + ((c0 & 127) >> 1) * 2;
        float4 rr[2][2]; float dd[2][2];
        { const int s = row0 & (S - 1); const float4* rp = (const float4*)(rbase + (size_t)s * 128); rr[0][0] = rp[0]; rr[0][1] = rp[1]; dd[0][0] = tab[h0 * 256 + (s & 255)]; dd[0][1] = tab[(h0 + 1) * 256 + (s & 255)]; }
#pragma unroll
        for (int it = 0; it < 8; ++it) {
            const int ai = it >> 2, m = it & 3;
            const int row = row0 + ai * 128 + m * 16;
            if (it < 7) {
                const int s = (row0 + ((it + 1) >> 2) * 128 + ((it + 1) & 3) * 16) & (S - 1);
                const float4* rp = (const float4*)(rbase + (size_t)s * 128);
                rr[(it + 1) & 1][0] = rp[0]; rr[(it + 1) & 1][1] = rp[1]; dd[(it + 1) & 1][0] = tab[h0 * 256 + (s & 255)]; dd[(it + 1) & 1][1] = tab[(h0 + 1) * 256 + (s & 255)];
            }
            asm volatile("" ::: "memory");
            const float4 r0 = rr[it & 1][0], r1 = rr[it & 1][1];
#pragma unroll
            for (int bj = 0; bj < 2; ++bj) {
                const float dec = dd[it & 1][bj];
                const af4 o0 = rot4(acc[ai][bj][m][0], r0) * dec, o1 = rot4(acc[ai][bj][m][1], r1) * dec;
                st8v(dst + (size_t)row * 512 + c0 + bj * 128, o0, o1);
            }
        }
    }
};
struct EpiGates {
    static constexpr bool PERM = true, AFTER_DRAIN = false;
    unsigned char* ws;
    __device__ __forceinline__ void operator()(const af4 (&acc)[2][2][4][2], const Unit& u, int wr, int wc, int fr, int fq) const {
        const int pn = u.pn, seg = pn >> 2;
        bf16_t* const dst = (bf16_t*)(ws + (seg == 0 ? WS_GR : (seg == 1 ? WS_GA : WS_GRT)));
        const int row0 = u.pm * 256 + wr * 64 + fr;
        const int c0 = (pn & 3) * 256 + wc * 32 + 8 * fq;
#pragma unroll
        for (int ai = 0; ai < 2; ++ai)
#pragma unroll
            for (int m = 0; m < 4; ++m) {
                asm volatile("" ::: "memory");
                const int row = row0 + ai * 128 + m * 16;
#pragma unroll
                for (int bj = 0; bj < 2; ++bj) {
                    af4 o0 = acc[ai][bj][m][0], o1 = acc[ai][bj][m][1];
#pragma unroll
                    for (int e = 0; e < 4; ++e) {
                        const float s0 = sigmoidf_(o0[e]), s1 = sigmoidf_(o1[e]);
                        o0[e] = seg == 0 ? o0[e] * s0 : s0; o1[e] = seg == 0 ? o1[e] * s1 : s1;
                    }
                    if (seg == 0) st8v(dst + (size_t)row * 1024 + c0 + bj * 128, o0, o1);
                    else {
                        u32x2 w;
                        w.x = (unsigned)(o0[0] * 255.0f + 0.5f) | ((unsigned)(o0[1] * 255.0f + 0.5f) << 8) | ((unsigned)(o0[2] * 255.0f + 0.5f) << 16) | ((unsigned)(o0[3] * 255.0f + 0.5f) << 24);
                        w.y = (unsigned)(o1[0] * 255.0f + 0.5f) | ((unsigned)(o1[1] * 255.0f + 0.5f) << 8) | ((unsigned)(o1[2] * 255.0f + 0.5f) << 16) | ((unsigned)(o1[3] * 255.0f + 0.5f) << 24);
                        *(u32x2*)((unsigned char*)dst + (size_t)row * 1024 + c0 + bj * 128) = w;
                    }
                }
            }
    }
};

struct EpiProjAll {
    static constexpr bool PERM = true, AFTER_DRAIN = false;
    unsigned char* ws;
    __device__ __forceinline__ void operator()(const af4 (&acc)[2][2][4][2], const Unit& u, int wr, int wc, int fr, int fq) const {
        if (u.pn < 4) { const Unit v{u.pm, u.pn}; EpiMobaQK{ws}(acc, v, wr, wc, fr, fq); }
        else if (u.pn < 8) { const Unit v{u.pm, u.pn - 4}; EpiRetQK{ws}(acc, v, wr, wc, fr, fq); }
        else { const Unit v{u.pm, u.pn - 8}; EpiGates{ws}(acc, v, wr, wc, fr, fq); }
    }
};
struct EpiProjS {
    static constexpr bool PERM = true, AFTER_DRAIN = false;
    unsigned char* ws;
    __device__ __forceinline__ void operator()(const af4 (&acc)[2][2][4][2], const Unit& u, int wr, int wc, int fr, int fq) const {
        bf16_t* const VAT = (bf16_t*)(ws + WS_VAT); bf16_t* const VRT = (bf16_t*)(ws + WS_VRT); bf16_t* const KRT = (bf16_t*)(ws + WS_KRT);
        const float* const ropeRT = (const float*)(ws + WS_ROPERT); const float* const kdec = (const float*)(ws + WS_TBL) + 1024;
        const int pm = u.pm;
        const int f0 = pm * 256 + wr * 64 + fr;
        const int t00 = u.pn * 256 + wc * 32 + 8 * fq;
#pragma unroll
        for (int ai = 0; ai < 2; ++ai)
#pragma unroll
            for (int m = 0; m < 4; ++m) {
                asm volatile("" ::: "memory");
                const int f = f0 + ai * 128 + m * 16;
#pragma unroll
                for (int bj = 0; bj < 2; ++bj) {
                    const int t0 = t00 + bj * 128, b = t0 >> 13, s0 = t0 & (S - 1);
                    float o[8];
#pragma unroll
                    for (int e = 0; e < 4; ++e) { o[e] = acc[ai][bj][m][0][e]; o[4 + e] = acc[ai][bj][m][1][e]; }
                    if (pm < 2) {
                        const int h = f >> 6, d = f & 63;
                        st8bf(VAT + ((((size_t)(b * 8 + h) * 128 + (s0 >> 6)) * 64 + d) * 64 + (s0 & 63)), o);
                    } else if (pm < 6) {
                        const int fe = f - 512, h = fe >> 8, e2 = fe & 255;
                        st8bf(VRT + (((size_t)(b * 4 + h) * 256 + e2) * S + s0), o);
                    } else {
                        const int fk = f - 1536, h = fk >> 7, d = fk & 127, j = d >> 1;
                        const float sgn = (d & 1) ? 1.0f : -1.0f;
                        const float4* rp = (const float4*)(ropeRT + ((size_t)j * S + s0) * 2);
                        const float4* dp = (const float4*)(kdec + h * 256 + (s0 & 255));
                        const float4 r0 = rp[0], r1 = rp[1], r2 = rp[2], r3 = rp[3], d0 = dp[0], d1 = dp[1];
                        const float cs[8] = {r0.x, r0.z, r1.x, r1.z, r2.x, r2.z, r3.x, r3.z};
                        const float sn[8] = {r0.y, r0.w, r1.y, r1.w, r2.y, r2.w, r3.y, r3.w};
                        const float dc[8] = {d0.x, d0.y, d0.z, d0.w, d1.x, d1.y, d1.z, d1.w};
#pragma unroll
                        for (int e = 0; e < 8; ++e) {
                            const float part = __shfl_xor(o[e], 1);
                            o[e] = (o[e] * cs[e] + sgn * part * sn[e]) * dc[e];
                        }
                        st8bf(KRT + (((size_t)(b * 4 + h) * 128 + d) * S + s0), o);
                    }
                }
            }
    }
};

struct EpiBranchA {
    static constexpr bool PERM = true, AFTER_DRAIN = false;
    const bf16_t* GA; bf16_t* MG;
    __device__ __forceinline__ void operator()(const af4 (&acc)[2][2][4][2], const Unit& u, int wr, int wc, int fr, int fq) const {
        const int row0 = u.pm * 256 + wr * 64 + fr, col0 = u.pn * 256 + wc * 32 + 8 * fq;
#pragma unroll
        for (int ai = 0; ai < 2; ++ai)
#pragma unroll
            for (int m = 0; m < 4; ++m)
#pragma unroll
                for (int bj = 0; bj < 2; ++bj) {
                    const size_t off = (size_t)(row0 + ai * 128 + m * 16) * 1024 + col0 + bj * 128;
                    const u32x2 g = *(const u32x2*)((const unsigned char*)GA + off);
                    float o[8];
#pragma unroll
                    for (int e = 0; e < 4; ++e) { o[e] = acc[ai][bj][m][0][e]; o[4 + e] = acc[ai][bj][m][1][e]; }
#pragma unroll
                    for (int e = 0; e < 4; ++e) { o[e] *= (float)((g.x >> (8 * e)) & 255u) * (1.0f / 255.0f); o[4 + e] *= (float)((g.y >> (8 * e)) & 255u) * (1.0f / 255.0f); }
                    st8bf(MG + off, o);
                }
    }
};
struct EpiBranchR {
    static constexpr bool PERM = true, AFTER_DRAIN = false;
    const bf16_t* GRT; bf16_t* MG;
    __device__ __forceinline__ void operator()(const af4 (&acc)[2][2][4][2], const Unit& u, int wr, int wc, int fr, int fq) const {
        const int row0 = u.pm * 256 + wr * 64 + fr, col0 = u.pn * 256 + wc * 32 + 8 * fq;
#pragma unroll
        for (int ai = 0; ai < 2; ++ai)
#pragma unroll
            for (int m = 0; m < 4; ++m)
#pragma unroll
                for (int bj = 0; bj < 2; ++bj) {
                    const size_t off = (size_t)(row0 + ai * 128 + m * 16) * 1024 + col0 + bj * 128;
                    const u32x2 g = *(const u32x2*)((const unsigned char*)GRT + off);
                    const u32x4 t = *(const u32x4*)(MG + off);
                    float o[8];
#pragma unroll
                    for (int e = 0; e < 4; ++e) { o[e] = acc[ai][bj][m][0][e]; o[4 + e] = acc[ai][bj][m][1][e]; }
                    const unsigned tw[4] = {t.x, t.y, t.z, t.w};
#pragma unroll
                    for (int e = 0; e < 8; ++e) {
                        const float gv = (float)(((e < 4 ? g.x : g.y) >> (8 * (e & 3))) & 255u) * (1.0f / 255.0f);
                        const float tv = (e & 1) ? __uint_as_float(tw[e >> 1] & 0xffff0000u) : __uint_as_float(tw[e >> 1] << 16);
                        o[e] = o[e] * gv + tv;
                    }
                    st8bf(MG + off, o);
                }
    }
};
struct EpiMix {
    static constexpr bool PERM = true, AFTER_DRAIN = false;
    const float* X; float* X1; bf16_t* XBo; float* STAT;
    __device__ __forceinline__ void operator()(const af4 (&acc)[2][2][4][2], const Unit& u, int wr, int wc, int fr, int fq) const {
        const int row0 = u.pm * 256 + wr * 64 + fr, col0 = u.pn * 256 + wc * 32 + 8 * fq;
#pragma unroll
        for (int ai = 0; ai < 2; ++ai)
#pragma unroll
            for (int m = 0; m < 4; ++m) {
                const int row = row0 + ai * 128 + m * 16;
                float s1 = 0.f, s2 = 0.f;
#pragma unroll
                for (int bj = 0; bj < 2; ++bj) {
                    const size_t off = (size_t)row * 1024 + col0 + bj * 128;
                    const u32x4 xw = *(const u32x4*)(XBo + off);
                    const f32x4 x0 = (f32x4){__uint_as_float(xw.x << 16), __uint_as_float(xw.x & 0xffff0000u), __uint_as_float(xw.y << 16), __uint_as_float(xw.y & 0xffff0000u)};
                    const f32x4 x1 = (f32x4){__uint_as_float(xw.z << 16), __uint_as_float(xw.z & 0xffff0000u), __uint_as_float(xw.w << 16), __uint_as_float(xw.w & 0xffff0000u)};
                    const af4 p0 = x0 * DN_ALPHA + acc[ai][bj][m][0], p1 = x1 * DN_ALPHA + acc[ai][bj][m][1];
                    st8v(XBo + off, p0, p1);
                    s1 += (p0[0] + p0[1]) + (p0[2] + p0[3]) + (p1[0] + p1[1]) + (p1[2] + p1[3]);
                    s2 += (p0[0] * p0[0] + p0[1] * p0[1]) + (p0[2] * p0[2] + p0[3] * p0[3]) + (p1[0] * p1[0] + p1[1] * p1[1]) + (p1[2] * p1[2] + p1[3] * p1[3]);
                }
                s1 += __shfl_xor(s1, 16); s1 += __shfl_xor(s1, 32); s2 += __shfl_xor(s2, 16); s2 += __shfl_xor(s2, 32);
                if (fq == 0) *(float2*)(STAT + ((size_t)row * 16 + u.pn * 4 + wc) * 2) = make_float2(s1, s2);
            }
    }
};
struct EpiPlain {
    static constexpr bool PERM = true, AFTER_DRAIN = false;
    bf16_t* O; int ldc;
    __device__ __forceinline__ void operator()(const af4 (&acc)[2][2][4][2], const Unit& u, int wr, int wc, int fr, int fq) const {
        const int row0 = u.pm * 256 + wr * 64 + fr, col0 = u.pn * 256 + wc * 32 + 8 * fq;
#pragma unroll
        for (int ai = 0; ai < 2; ++ai)
#pragma unroll
            for (int m = 0; m < 4; ++m)
#pragma unroll
                for (int bj = 0; bj < 2; ++bj) {
                    float o[8];
#pragma unroll
                    for (int e = 0; e < 4; ++e) { o[e] = acc[ai][bj][m][0][e]; o[4 + e] = acc[ai][bj][m][1][e]; }
                    st8bf(O + (size_t)(row0 + ai * 128 + m * 16) * ldc + col0 + bj * 128, o);
                }
    }
};
__device__ __forceinline__ int win_dest_row(int n) {
    if (n < 1024) { const int seg = n >> 9, r = n & 511, h = r >> 6, d = r & 63; const int pd = d < 32 ? 2 * d : 2 * (d - 32) + 1; return seg * 512 + h * 64 + pd; }
    if (n < 1536) return WIN_NROWS + (n - 1024);
    if (n < 2048) return 1024 + (n - 1536);
    if (n < 2560) return 1536 + (n - 2048);
    if (n < 3584) return WIN_NROWS + 512 + (n - 2560);
    return 2048 + (n - 3584);
}
template <bool WIN>
__device__ __forceinline__ void p0_transpose_item(const float* W, int K, int N, bf16_t* WT, LAS float* scr, int item, int lane, const float* rowscale = nullptr) {
    const int nblk = N / 32, kb = item / nblk, nb = item % nblk, k0 = 64 * kb, n0 = 32 * nb;
    float tv[32];
#pragma unroll
    for (int i = 0; i < 32; ++i) tv[i] = W[(size_t)(k0 + 2 * i + (lane >> 5)) * N + n0 + (lane & 31)];
#pragma unroll
    for (int i = 0; i < 32; ++i) { const int kk = 2 * i + (lane >> 5); scr[kk * 33 + (lane & 31)] = rowscale ? tv[i] * rowscale[k0 + kk] : tv[i]; }
    asm volatile("s_waitcnt lgkmcnt(0)" ::: "memory");
    const int c = lane & 7;
#pragma unroll
    for (int j = 0; j < 4; ++j) {
        const int n = (lane >> 3) + 8 * j; const LAS float* s = scr + (8 * c) * 33 + n;
        u32x4 o; o.x = pk2(s[0 * 33], s[1 * 33]); o.y = pk2(s[2 * 33], s[3 * 33]); o.z = pk2(s[4 * 33], s[5 * 33]); o.w = pk2(s[6 * 33], s[7 * 33]);
        const int nl = n0 + n;
        const int row = WIN ? win_dest_row(nl) : nl;
        *(u32x4*)(WT + (size_t)row * K + k0 + 8 * c) = o;
        if (WIN && nl >= OFF_KR && nl < OFF_VR) *(u32x4*)(WT + (size_t)(WIN_NROWS + 1536 + (nl - OFF_KR)) * K + k0 + 8 * c) = o;
    }
    asm volatile("s_waitcnt lgkmcnt(0)" ::: "memory");
}
__device__ __forceinline__ void cvt_copy(const float* src, bf16_t* dst, size_t n, size_t gtid, size_t gthreads) {
    size_t i = gtid * 8;
    for (; i + 3 * gthreads * 8 < n; i += 4 * gthreads * 8) {
        f32x4 a[4], b[4];
#pragma unroll
        for (int q = 0; q < 4; ++q) { a[q] = *(const f32x4*)(src + i + q * gthreads * 8); b[q] = *(const f32x4*)(src + i + q * gthreads * 8 + 4); }
#pragma unroll
        for (int q = 0; q < 4; ++q) {
            u32x4 w; w.x = pk2(a[q][0], a[q][1]); w.y = pk2(a[q][2], a[q][3]); w.z = pk2(b[q][0], b[q][1]); w.w = pk2(b[q][2], b[q][3]);
            *(u32x4*)(dst + i + q * gthreads * 8) = w;
        }
    }
    for (; i < n; i += gthreads * 8) {
        const f32x4 a = *(const f32x4*)(src + i), b = *(const f32x4*)(src + i + 4);
        u32x4 w; w.x = pk2(a[0], a[1]); w.y = pk2(a[2], a[3]); w.z = pk2(b[0], b[1]); w.w = pk2(b[2], b[3]);
        *(u32x4*)(dst + i) = w;
    }
}
struct Tables { float* ropeA; float* ropeR; float* ropeRT; float* qdec; float* kdec; };
__device__ __forceinline__ void p0_tables(const Tables& tb, size_t gtid, size_t gthreads, LAS float* invL) {
    const int t_ = (int)tidx();
    if (t_ < 32) invL[t_] = (float)pow(10000.0, -(double)t_ / 32.0);
    else if (t_ < 96) invL[t_] = (float)(1.0 / pow(10000.0, (double)(t_ - 32) / 63.0));
    __syncthreads();
    for (size_t i = gtid; i < (size_t)S * 32; i += gthreads) {
        const int s = (int)(i >> 5), j = (int)(i & 31);
        const float ang = (float)s * invL[j];
        float sn, c; sincosf(ang, &sn, &c);
        tb.ropeA[i * 2] = c; tb.ropeA[i * 2 + 1] = sn;
    }
    for (size_t i = gtid; i < (size_t)S * 64; i += gthreads) {
        const int s = (int)(i >> 6), j = (int)(i & 63);
        const float ang = (float)s * invL[32 + j];
        float sn, c; sincosf(ang, &sn, &c);
        tb.ropeR[i * 2] = c; tb.ropeR[i * 2 + 1] = sn;
        tb.ropeRT[((size_t)j * S + s) * 2] = c; tb.ropeRT[((size_t)j * S + s) * 2 + 1] = sn;
    }
    for (size_t i = gtid; i < 4 * 256; i += gthreads) {
        const int h = (int)(i >> 8), c = (int)(i & 255);
        const float lg = ret_logg(h);
        tb.qdec[i] = expf(lg * (float)c);
        tb.kdec[i] = 0.08838834764831845f * expf(-lg * (float)c);
    }
    __syncthreads();
}

__device__ __forceinline__ void ph_retscan(const float* KVT, bf16_t* PREVT) {
    const int tx_ = (int)tidx(), bx_ = (int)bidx(), gx_ = (int)gdim();
    const int n = 8 * RDV * RDK;
    for (int idx = bx_ * 512 + tx_; idx < n; idx += gx_ * 512) {
        const int ed = idx & 32767, bh = idx >> 15, h = bh & 3;
        const float lg = ret_logg(h);
        const float g1 = expf(lg), cd = expf(lg * 256.0f), g255 = expf(lg * 255.0f);
        float kvv[RNC];
#pragma unroll
        for (int nc = 0; nc < RNC; ++nc) kvv[nc] = KVT[((size_t)(bh * RNC + nc) << 15) + ed];
        float st = 0.f;
#pragma unroll
        for (int nc = 0; nc < RNC; ++nc) {
            PREVT[((size_t)(bh * RNC + nc) << 15) + ed] = (bf16_t)f2bf(st * g1);
            st = st * cd + g255 * kvv[nc];
        }
    }
}
__device__ __forceinline__ void p0_csum_part(const float* Wq, const float* g1, const float* b1, float* PARTC, float* PARTB) {
    const int tx_ = (int)tidx(), bx_ = (int)bidx(), gx_ = (int)gdim();
    for (int idx = bx_ * 512 + tx_; idx < 2 * 16 * 2048; idx += gx_ * 512) {
        const int l = idx >> 15, kq = (idx >> 11) & 15, n = idx & 2047;
        const float* w = Wq + (size_t)l * D * 2048 + (size_t)(64 * kq) * 2048 + n;
        float s = 0.f, t = 0.f;
#pragma unroll 32
        for (int k = 0; k < 64; ++k) { const float wv = w[(size_t)k * 2048]; s += g1[l * D + 64 * kq + k] * wv; t += b1[l * D + 64 * kq + k] * wv; }
        PARTC[idx] = s; PARTB[idx] = t;
    }
}
__device__ __forceinline__ void p0_csum_reduce(const float* PARTC, const float* PARTB, float* CSUM, float* BQ) {
    const int tx_ = (int)tidx(), bx_ = (int)bidx(), gx_ = (int)gdim();
    for (int idx = bx_ * 512 + tx_; idx < 2 * 2048; idx += gx_ * 512) {
        const int l = idx >> 11, n = idx & 2047;
        float s = 0.f, t = 0.f;
#pragma unroll
        for (int kq = 0; kq < 16; ++kq) { s += PARTC[(l * 16 + kq) * 2048 + n]; t += PARTB[(l * 16 + kq) * 2048 + n]; }
        CSUM[idx] = s; BQ[idx] = t;
    }
}
__device__ __forceinline__ void ph_kc_kb(const float* keys, const float* CSUM, const float* BQ, float* KC, float* KB) {
    const int tx_ = (int)tidx(), bx_ = (int)bidx(), gx_ = (int)gdim();
    const int lane = tx_ & 63;
    for (int idx = bx_ * 8 + (tx_ >> 6); idx < 2048; idx += gx_ * 8) {
        const int key = idx & 127, pp = (idx >> 7) & 1, hh = idx >> 8;
        const float* kp = keys + ((size_t)pp * PNK + key) * PKD;
        const float* cp = CSUM + hh * 256 + pp * 128; const float* bp = BQ + hh * 256 + pp * 128;
        const float k0 = kp[lane], k1 = kp[lane + 64];
        const float s = wave_sum(k0 * cp[lane] + k1 * cp[lane + 64]), t = wave_sum(k0 * bp[lane] + k1 * bp[lane + 64]);
        if (lane == 0) { KC[idx] = s; KB[idx] = t; }
    }
}
typedef short bf16x8_t __attribute__((ext_vector_type(8)));
template <int NR> struct CvtRowsT { f32x4 v[NR][4]; };
typedef CvtRowsT<2> CvtRows;
template <int NR> __device__ __forceinline__ void cvt2_issue(CvtRowsT<NR>& c, const float* srcU, const float* srcV, int row, int lane) {
#pragma unroll
    for (int r = 0; r < NR; ++r) {
        const int rr = row + r;
        const float* p = (rr < NEXP ? srcU + (size_t)rr * D : srcV + (size_t)(rr - NEXP) * D) + lane * 16;
#pragma unroll
        for (int q = 0; q < 4; ++q) c.v[r][q] = *(const f32x4*)(p + 4 * q);
    }
}
template <int NR> __device__ __forceinline__ void cvt2_finish(const CvtRowsT<NR>& c, unsigned char* dstU, unsigned char* dstV, float* sinv, int row, int lane) {
#pragma unroll
    for (int r = 0; r < NR; ++r) {
        const int rr = row + r;
        float m = 0.f;
#pragma unroll
        for (int q = 0; q < 4; ++q)
#pragma unroll
            for (int i = 0; i < 4; ++i) m = fmaxf(m, fabsf(c.v[r][q][i]));
#pragma unroll
        for (int o = 32; o >= 1; o >>= 1) m = fmaxf(m, __shfl_xor(m, o));
        const int er = rr < NEXP ? rr : rr - NEXP, which = rr < NEXP ? 0 : 1;
        {
            const float sc4 = m > 0.f ? 6.0f / m : 1.0f;
            unsigned d0 = 0u, d1 = 0u;
            d0 = __builtin_amdgcn_cvt_scalef32_pk_fp4_f32(d0, c.v[r][0][0] * sc4, c.v[r][0][1] * sc4, 1.0f, 0); d0 = __builtin_amdgcn_cvt_scalef32_pk_fp4_f32(d0, c.v[r][0][2] * sc4, c.v[r][0][3] * sc4, 1.0f, 1);
            d0 = __builtin_amdgcn_cvt_scalef32_pk_fp4_f32(d0, c.v[r][1][0] * sc4, c.v[r][1][1] * sc4, 1.0f, 2); d0 = __builtin_amdgcn_cvt_scalef32_pk_fp4_f32(d0, c.v[r][1][2] * sc4, c.v[r][1][3] * sc4, 1.0f, 3);
            d1 = __builtin_amdgcn_cvt_scalef32_pk_fp4_f32(d1, c.v[r][2][0] * sc4, c.v[r][2][1] * sc4, 1.0f, 0); d1 = __builtin_amdgcn_cvt_scalef32_pk_fp4_f32(d1, c.v[r][2][2] * sc4, c.v[r][2][3] * sc4, 1.0f, 1);
            d1 = __builtin_amdgcn_cvt_scalef32_pk_fp4_f32(d1, c.v[r][3][0] * sc4, c.v[r][3][1] * sc4, 1.0f, 2); d1 = __builtin_amdgcn_cvt_scalef32_pk_fp4_f32(d1, c.v[r][3][2] * sc4, c.v[r][3][3] * sc4, 1.0f, 3);
            u32x2 w2; w2.x = d0; w2.y = d1;
            *(u32x2*)((which ? dstV : dstU) + (size_t)er * (D / 2) + lane * 8) = w2;
            if (lane == 0) sinv[(size_t)er * 2 + which] = 1.0f / sc4;
        }
    }
}
__device__ __forceinline__ unsigned ord_key(float s) { unsigned u = __float_as_uint(s); return u ^ ((unsigned)((int)u >> 31) | 0x80000000u); }
__device__ __forceinline__ float ord_val(unsigned k) { const unsigned v = (k >> 31) ? (k ^ 0x80000000u) : ~k; return __uint_as_float(v); }
template <int N> __device__ __forceinline__ void bitonic_sort_desc(unsigned (&k)[N]) {
#pragma unroll
    for (int size = 2; size <= N; size <<= 1)
#pragma unroll
        for (int stride = size >> 1; stride > 0; stride >>= 1)
#pragma unroll
            for (int i = 0; i < N; ++i) {
                const int j = i ^ stride;
                if (j > i) {
                    const unsigned a = k[i], b = k[j], hi = a > b ? a : b, lo = a > b ? b : a;
                    const bool desc = (i & size) == 0;
                    k[i] = desc ? hi : lo; k[j] = desc ? lo : hi;
                }
            }
}
template <int N> __device__ __forceinline__ void bitonic_merge_desc(unsigned (&k)[N]) {
#pragma unroll
    for (int stride = N >> 1; stride > 0; stride >>= 1)
#pragma unroll
        for (int i = 0; i < N; ++i) {
            const int j = i ^ stride;
            if (j > i) { const unsigned a = k[i], b = k[j]; k[i] = a > b ? a : b; k[j] = a > b ? b : a; }
        }
}
constexpr int PK_PITCH = 272;
__device__ __forceinline__ void ph_peer_topk(const bf16_t* PQ, const bf16_t* KEYS, int* PIDX, float* PW, LAS unsigned char* l3,
                                             const float* STAT, const float* KC, const float* KB, float* RS,
                                             const float* srcU, const float* srcV, unsigned char* dstU, unsigned char* dstV, float* sinv) {
    const int tid = (int)tidx(), lane = tid & 63, g = lane >> 4, tk = lane & 15;
    const int wave = __builtin_amdgcn_readfirstlane(tid >> 6);
    for (int i = tid; i < 4096; i += 512) {
        const int row = i >> 4, ch = i & 15;
        const u32x4 v = *(const u32x4*)(KEYS + (size_t)row * 128 + ch * 8);
        *(LAS u32x4*)(l3 + row * PK_PITCH + ch * 16) = v;
    }
    __syncthreads();
    const int ntask = (T / 16) * 2;
    for (int task = (int)bidx() * 8 + wave; task < ntask; task += (int)gdim() * 8) {
        const int lane = (int)tidx() & 63, g = lane >> 4, tk = lane & 15;
        const int tg = task >> 1, hq = task & 1;
        const int tok = tg * 16 + tk;
        float mu, rstd;
        {
            float s1 = 0.f, s2 = 0.f;
#pragma unroll
            for (int q = 0; q < 4; ++q) { const float2 v = *(const float2*)(STAT + ((size_t)tok * 16 + 4 * g + q) * 2); s1 += v.x; s2 += v.y; }
            s1 += __shfl_xor(s1, 16); s1 += __shfl_xor(s1, 32); s2 += __shfl_xor(s2, 16); s2 += __shfl_xor(s2, 32);
            mu = s1 * (1.0f / D);
            rstd = 1.0f / sqrtf(fmaxf(s2 * (1.0f / D) - mu * mu, 0.f) + LN_EPS);
            if (hq == 0 && g == 0) *(float2*)(RS + (size_t)tok * 2) = make_float2(mu, rstd);
        }
        float sv0[16], sv1[16]; int si0[16], si1[16];
#pragma unroll
        for (int r = 0; r < 16; ++r) { sv0[r] = 0.f; sv1[r] = 0.f; si0[r] = 0; si1[r] = 0; }
        CvtRowsT<1> cvB;
        for (int hh = 0; hh < 4; ++hh) {
            const int h = hq * 4 + hh;
            const bool mine = (g == hh);
#pragma unroll
            for (int p = 0; p < 2; ++p) {
                const int crow = task * 16 + (hh * 2 + p) * 2;
                if (hh + p > 0) cvt2_finish(cvB, dstU, dstV, sinv, crow - 1, lane);
                CvtRowsT<1> cvA; cvt2_issue(cvA, srcU, srcV, crow, lane);
                f32x4 acc[8];
#pragma unroll
                for (int kt = 0; kt < 8; ++kt) acc[kt] = (f32x4){0.f, 0.f, 0.f, 0.f};
                const bf16_t* qp = PQ + (size_t)tok * 2048 + h * 256 + p * 128 + 8 * g;
#pragma unroll
                for (int ks = 0; ks < 4; ++ks) {
                    asm volatile("" ::: "memory");
                    const bf16x8_t qf = *(const bf16x8_t*)(qp + 32 * ks);
#pragma unroll
                    for (int kt = 0; kt < 8; ++kt) {
                        const bf16x8_t kf = *(const LAS bf16x8_t*)(l3 + (p * 128 + 16 * kt + tk) * PK_PITCH + (32 * ks + 8 * g) * 2);
                        acc[kt] = __builtin_amdgcn_mfma_f32_16x16x32_bf16(kf, qf, acc[kt], 0, 0, 0);
                    }
                }
                cvt2_finish(cvA, dstU, dstV, sinv, crow, lane);
                cvt2_issue(cvB, srcU, srcV, crow + 1, lane);
                f32x4 kc4[8], kb4[8];
#pragma unroll
                for (int kt = 0; kt < 8; ++kt) { kc4[kt] = *(const f32x4*)(KC + h * 256 + p * 128 + 16 * kt + 4 * g); kb4[kt] = *(const f32x4*)(KB + h * 256 + p * 128 + 16 * kt + 4 * g); }
                unsigned k[32];
#pragma unroll
                for (int kt = 0; kt < 8; ++kt)
#pragma unroll
                    for (int r = 0; r < 4; ++r) k[kt * 4 + r] = (ord_key(rstd * (acc[kt][r] - mu * kc4[kt][r]) + kb4[kt][r]) & ~127u) | (unsigned)(127 - (16 * kt + 4 * g + r));
                bitonic_sort_desc<32>(k);
                unsigned t16[16];
#pragma unroll
                for (int r = 0; r < 16; ++r) t16[r] = k[r];
#pragma unroll
                for (int o = 16; o <= 32; o <<= 1) {
                    unsigned ob[16];
#pragma unroll
                    for (int r = 0; r < 16; ++r) ob[r] = (unsigned)__shfl_xor((int)t16[r], o);
#pragma unroll
                    for (int r = 0; r < 16; ++r) t16[r] = t16[r] > ob[15 - r] ? t16[r] : ob[15 - r];
                    bitonic_merge_desc<16>(t16);
                }
#pragma unroll
                for (int r = 0; r < 16; ++r) {
                    const float val = ord_val(t16[r] & ~127u); const int idx = 127 - (int)(t16[r] & 127u);
                    if (p == 0) { sv0[r] = mine ? val : sv0[r]; si0[r] = mine ? idx : si0[r]; }
                    else        { sv1[r] = mine ? val : sv1[r]; si1[r] = mine ? idx : si1[r]; }
                }
            }
        }
        cvt2_finish(cvB, dstU, dstV, sinv, task * 16 + 15, lane);
        unsigned c[64];
        {
            int n = 0;
#pragma unroll
            for (int a = 0; a < 16; ++a)
#pragma unroll
                for (int b = 0; b < 16; ++b)
                    if ((a + 1) * (b + 1) <= 16) { c[n] = (ord_key(sv0[a] + sv1[b]) & ~255u) | (unsigned)(255 - (a * 16 + b)); ++n; }
#pragma unroll
            for (int j = 50; j < 64; ++j) c[j] = 0u;
        }
        bitonic_sort_desc<64>(c);
        float fs[16]; int fe[16];
#pragma unroll
        for (int r = 0; r < 16; ++r) {
            const unsigned m = c[r];
            const int pos = 255 - (int)(m & 255u), a = pos >> 4, b = pos & 15;
            fs[r] = ord_val(m & ~255u);
            int ea = si0[0], eb = si1[0];
#pragma unroll
            for (int j = 1; j < 16; ++j) { ea = (a == j) ? si0[j] : ea; eb = (b == j) ? si1[j] : eb; }
            fe[r] = ea * PNK + eb;
        }
        float sum = 0.f; const float fmx = fs[0];
#pragma unroll
        for (int r = 0; r < 16; ++r) { fs[r] = __expf(fs[r] - fmx); sum += fs[r]; }
        const float inv = 1.0f / sum;
        const int lane2 = (int)tidx() & 63;
        const unsigned oo = (unsigned)(tg * 16 + (lane2 & 15)) * 128u + (unsigned)((hq * 4 + (lane2 >> 4)) * 16);
        int* ip = PIDX + oo;
        float* wp = PW + oo;
#pragma unroll
        for (int r = 0; r < 16; r += 4) {
            *(int4*)(ip + r) = make_int4(fe[r], fe[r + 1], fe[r + 2], fe[r + 3]);
            *(float4*)(wp + r) = make_float4(fs[r] * inv, fs[r + 1] * inv, fs[r + 2] * inv, fs[r + 3] * inv);
        }
    }
    __syncthreads();
}
typedef __bf16 bf16x2v __attribute__((ext_vector_type(2)));
__device__ __forceinline__ float dot2bf(unsigned a, unsigned b, float c) {
    return __builtin_amdgcn_fdot2_f32_bf16(__builtin_bit_cast(bf16x2v, a), __builtin_bit_cast(bf16x2v, b), c, false);
}
__device__ __forceinline__ float gelu_fast(float x) {
    const float z = 1.5957691216057308f * (x + 0.044715f * x * x * x);
    return x * __builtin_amdgcn_rcpf(1.0f + __expf(-z));
}
constexpr int GNT = 4;
constexpr int G_LDS_WAVE = 14848;
typedef float f32x2v __attribute__((ext_vector_type(2)));
typedef int v8i32 __attribute__((ext_vector_type(8)));
typedef int v2i32 __attribute__((ext_vector_type(2)));
__device__ __forceinline__ float row_sum16(float v) {
    v += __builtin_bit_cast(float, __builtin_amdgcn_update_dpp(0, __builtin_bit_cast(int, v), 0xB1, 0xF, 0xF, false));
    v += __builtin_bit_cast(float, __builtin_amdgcn_update_dpp(0, __builtin_bit_cast(int, v), 0x4E, 0xF, 0xF, false));
    v += __builtin_bit_cast(float, __builtin_amdgcn_update_dpp(0, __builtin_bit_cast(int, v), 0x141, 0xF, 0xF, false));
    v += __builtin_bit_cast(float, __builtin_amdgcn_update_dpp(0, __builtin_bit_cast(int, v), 0x140, 0xF, 0xF, false));
    return v;
}
#define G_LD2(dst, base) do { _Pragma("unroll") for (int k_ = 0; k_ < 2; ++k_) (dst)[k_] = *(const u32x4*)((base) + rowoff + 256 * k_); } while (0)
#define G_ACC8(dw, xi) do { acc[(xi)] += __builtin_amdgcn_cvt_scalef32_pk_f32_fp4((dw), 1.0f, 0) * ww_; acc[(xi) + 1] += __builtin_amdgcn_cvt_scalef32_pk_f32_fp4((dw), 1.0f, 1) * ww_; \
                                acc[(xi) + 2] += __builtin_amdgcn_cvt_scalef32_pk_f32_fp4((dw), 1.0f, 2) * ww_; acc[(xi) + 3] += __builtin_amdgcn_cvt_scalef32_pk_f32_fp4((dw), 1.0f, 3) * ww_; } while (0)
__device__ __forceinline__ f32x4 ldpre4(const bf16_t* p) { const u32x2 w = *(const u32x2*)p; return (f32x4){__uint_as_float(w.x << 16), __uint_as_float(w.x & 0xffff0000u), __uint_as_float(w.y << 16), __uint_as_float(w.y & 0xffff0000u)}; }
constexpr int GRING = 3;
__device__ __forceinline__ void ph_peer_gather(const float* X1, const int* PIDX, const float* PW, const unsigned char* TU, const unsigned char* TV, const float* SINV,
                                               const float* lg, const float* lb, float* OUT, bf16_t* XB, LAS unsigned char* l3, const float* RS, const float* g1, const float* b1) {
    const int tid = (int)tidx(), lane = tid & 63, tj = lane >> 4, li = lane & 15;
    const int wave = __builtin_amdgcn_readfirstlane(tid >> 6);
    LAS unsigned* keyL = (LAS unsigned*)(l3 + wave * G_LDS_WAVE);
    LAS float* wL = (LAS float*)(l3 + wave * G_LDS_WAVE + 2048);
    const int ebase = tj * 128;
    const int ngrp = T / GNT;
#pragma unroll 1
    for (int grp = (int)bidx() * 8 + wave; grp < ngrp; grp += (int)gdim() * 8) {
        const int tbase = grp * GNT;
        const int lane = (int)tidx() & 63, tj = lane >> 4, li = lane & 15, ebase = tj * 128;
#pragma unroll
        for (int i = 0; i < 8; ++i) {
            const int e = lane + 64 * i;
            keyL[e] = ((unsigned)(e >> 7) << 23) | ((unsigned)PIDX[(size_t)tbase * 128 + e] << 9) | (unsigned)e;
            wL[e] = PW[(size_t)tbase * 128 + e];
        }
        asm volatile("s_waitcnt lgkmcnt(0)" ::: "memory");
#pragma unroll 1
        for (int k = 2; k <= 128; k <<= 1)
#pragma unroll 1
            for (int j = k >> 1; j > 0; j >>= 1) {
#pragma unroll
                for (int i = 0; i < 4; ++i) {
                    const int q = lane + 64 * i;
                    const int x = ((q & ~(j - 1)) << 1) | (q & (j - 1)), y = x | j;
                    const unsigned a = keyL[x], b = keyL[y];
                    const bool asc = (k == 128) || ((x & k) == 0);
                    const bool sw = asc ? (a > b) : (a < b);
                    keyL[x] = sw ? b : a; keyL[y] = sw ? a : b;
                }
                asm volatile("s_waitcnt lgkmcnt(0)" ::: "memory");
            }
        const size_t ro = (size_t)(tbase + tj) * D + 16 * li;
        size_t rowoff;
        const float2 rs2 = *(const float2*)(RS + (size_t)(tbase + tj) * 2); const float mu1 = rs2.x, rs1 = rs2.y;
        {
            LAS float* hL = (LAS float*)(l3 + wave * G_LDS_WAVE + 4608);
            LAS unsigned char* xbL = l3 + wave * G_LDS_WAVE + 6656;
#pragma unroll
            for (int k = 0; k < 4; ++k) {
                float xv[16];
#pragma unroll
                for (int c = 0; c < 4; ++c) {
                    const f32x4 gg = *(const f32x4*)(g1 + 256 * k + 16 * li + 4 * c), bb = *(const f32x4*)(b1 + 256 * k + 16 * li + 4 * c);
                    const f32x4 a = (ldpre4(XB + ro + 256 * k + 4 * c) - mu1) * rs1 * gg + bb;
                    xv[4 * c] = a[0]; xv[4 * c + 1] = a[1]; xv[4 * c + 2] = a[2]; xv[4 * c + 3] = a[3];
                }
#pragma unroll
                for (int n = 0; n < 4; ++n) {
                    const float sn = n == 0 ? 2.0f : n == 1 ? 0.5f : n == 2 ? 0.125f : 0.03125f, isn = 1.0f / sn;
                    unsigned d0 = 0u, d1 = 0u;
                    d0 = __builtin_amdgcn_cvt_scalef32_pk_fp4_f32(d0, xv[0] * isn, xv[1] * isn, 1.0f, 0);
                    d0 = __builtin_amdgcn_cvt_scalef32_pk_fp4_f32(d0, xv[2] * isn, xv[3] * isn, 1.0f, 1);
                    d0 = __builtin_amdgcn_cvt_scalef32_pk_fp4_f32(d0, xv[4] * isn, xv[5] * isn, 1.0f, 2);
                    d0 = __builtin_amdgcn_cvt_scalef32_pk_fp4_f32(d0, xv[6] * isn, xv[7] * isn, 1.0f, 3);
                    d1 = __builtin_amdgcn_cvt_scalef32_pk_fp4_f32(d1, xv[8] * isn, xv[9] * isn, 1.0f, 0);
                    d1 = __builtin_amdgcn_cvt_scalef32_pk_fp4_f32(d1, xv[10] * isn, xv[11] * isn, 1.0f, 1);
                    d1 = __builtin_amdgcn_cvt_scalef32_pk_fp4_f32(d1, xv[12] * isn, xv[13] * isn, 1.0f, 2);
                    d1 = __builtin_amdgcn_cvt_scalef32_pk_fp4_f32(d1, xv[14] * isn, xv[15] * isn, 1.0f, 3);
                    { const f32x2v q = __builtin_amdgcn_cvt_scalef32_pk_f32_fp4(d0, 1.0f, 0); xv[0] -= q.x * sn; xv[1] -= q.y * sn; }
                    { const f32x2v q = __builtin_amdgcn_cvt_scalef32_pk_f32_fp4(d0, 1.0f, 1); xv[2] -= q.x * sn; xv[3] -= q.y * sn; }
                    { const f32x2v q = __builtin_amdgcn_cvt_scalef32_pk_f32_fp4(d0, 1.0f, 2); xv[4] -= q.x * sn; xv[5] -= q.y * sn; }
                    { const f32x2v q = __builtin_amdgcn_cvt_scalef32_pk_f32_fp4(d0, 1.0f, 3); xv[6] -= q.x * sn; xv[7] -= q.y * sn; }
                    { const f32x2v q = __builtin_amdgcn_cvt_scalef32_pk_f32_fp4(d1, 1.0f, 0); xv[8] -= q.x * sn; xv[9] -= q.y * sn; }
                    { const f32x2v q = __builtin_amdgcn_cvt_scalef32_pk_f32_fp4(d1, 1.0f, 1); xv[10] -= q.x * sn; xv[11] -= q.y * sn; }
                    { const f32x2v q = __builtin_amdgcn_cvt_scalef32_pk_f32_fp4(d1, 1.0f, 2); xv[12] -= q.x * sn; xv[13] -= q.y * sn; }
                    { const f32x2v q = __builtin_amdgcn_cvt_scalef32_pk_f32_fp4(d1, 1.0f, 3); xv[14] -= q.x * sn; xv[15] -= q.y * sn; }
                    u32x2 w2; w2.x = d0; w2.y = d1;
                    *(LAS u32x2*)(xbL + tj * 2048 + n * 512 + 128 * k + 8 * li) = w2;
                }
            }
            asm volatile("s_waitcnt lgkmcnt(0)" ::: "memory");
            const float colw = li == 0 ? 2.0f : li == 1 ? 0.5f : li == 2 ? 0.125f : li == 3 ? 0.03125f : 0.f;
            u32x4 af[2][8];
            const int psrc = (4 * li + tj) * 4;
            u32x4 bf[8];
#define GU_LOADA(buf, q_) do { const unsigned key_ = keyL[((q_) & 3) * 128 + 16 * ((q_) >> 2) + (lane >> 2)]; const unsigned char* ap_ = TU + (size_t)((key_ >> 9) & 16383u) * (D / 2) + 16 * (lane & 3); \
                               _Pragma("unroll") for (int s_ = 0; s_ < 8; ++s_) af[buf][s_] = *(const u32x4*)(ap_ + 64 * s_); } while (0)
#define GU_GROUP(buf, q_) do { f32x4 c0_ = (f32x4){0.f, 0.f, 0.f, 0.f}, c1_ = (f32x4){0.f, 0.f, 0.f, 0.f}; \
                               { const LAS unsigned char* bp_ = xbL + ((q_) & 3) * 2048 + (li & 3) * 512 + 16 * tj; _Pragma("unroll") for (int s_ = 0; s_ < 8; ++s_) bf[s_] = *(const LAS u32x4*)(bp_ + 64 * s_); } \
                               u32x4 ap8_[8]; _Pragma("unroll") for (int s_ = 0; s_ < 8; ++s_) { ap8_[s_].x = (unsigned)__builtin_amdgcn_ds_bpermute(psrc, (int)af[buf][s_].x); ap8_[s_].y = (unsigned)__builtin_amdgcn_ds_bpermute(psrc, (int)af[buf][s_].y); ap8_[s_].z = (unsigned)__builtin_amdgcn_ds_bpermute(psrc, (int)af[buf][s_].z); ap8_[s_].w = (unsigned)__builtin_amdgcn_ds_bpermute(psrc, (int)af[buf][s_].w); } \
                               _Pragma("unroll") for (int s_ = 0; s_ < 8; s_ += 2) { \
                                   c0_ = __builtin_amdgcn_mfma_scale_f32_16x16x128_f8f6f4((v8i32){(int)ap8_[s_].x, (int)ap8_[s_].y, (int)ap8_[s_].z, (int)ap8_[s_].w, 0, 0, 0, 0}, (v8i32){(int)bf[s_].x, (int)bf[s_].y, (int)bf[s_].z, (int)bf[s_].w, 0, 0, 0, 0}, c0_, 4, 4, 0, 0x7F7F7F7F, 0, 0x7F7F7F7F); \
                                   c1_ = __builtin_amdgcn_mfma_scale_f32_16x16x128_f8f6f4((v8i32){(int)ap8_[s_ + 1].x, (int)ap8_[s_ + 1].y, (int)ap8_[s_ + 1].z, (int)ap8_[s_ + 1].w, 0, 0, 0, 0}, (v8i32){(int)bf[s_ + 1].x, (int)bf[s_ + 1].y, (int)bf[s_ + 1].z, (int)bf[s_ + 1].w, 0, 0, 0, 0}, c1_, 4, 4, 0, 0x7F7F7F7F, 0, 0x7F7F7F7F); } \
                               c0_ = c0_ + c1_; f32x4 hs_; \
                               _Pragma("unroll") for (int i_ = 0; i_ < 4; ++i_) hs_[i_] = row_sum16(c0_[i_] * colw); \
                               if (li == 0) *(LAS f32x4*)(hL + ((q_) & 3) * 128 + 16 * ((q_) >> 2) + 4 * tj) = hs_; } while (0)
            GU_LOADA(0, 0);
#pragma unroll 1
            for (int q2 = 0; q2 < 16; ++q2) {
                GU_LOADA(1, 2 * q2 + 1);
                GU_GROUP(0, 2 * q2);
                { const int qn = (2 * q2 + 2) < 32 ? (2 * q2 + 2) : 31; GU_LOADA(0, qn); }
                GU_GROUP(1, 2 * q2 + 1);
            }
#undef GU_LOADA
#undef GU_GROUP
            asm volatile("s_waitcnt lgkmcnt(0)" ::: "memory");
#pragma unroll
            for (int i = 0; i < 8; ++i) {
                const int e = lane + 64 * i;
                const unsigned key_ = keyL[e]; const unsigned ex_ = (key_ >> 9) & 16383u;
                const f32x2v si = *(const f32x2v*)(SINV + 2 * ex_);
                const float d_ = hL[e] * si.x;
                wL[key_ & 511u] = wL[key_ & 511u] * si.y * gelu_fast(d_);
            }
        }
        asm volatile("s_waitcnt lgkmcnt(0)" ::: "memory");
        unsigned voff[16], voffn[16];
        u32x4 vr[2][8];
#define GV_VOFF(DST, T_) do { const int lane_ = (int)tidx() & 63; _Pragma("unroll") for (int i = 0; i < 16; ++i) { const unsigned key_ = keyL[(T_) * 128 + 8 * i + (lane_ >> 3)]; \
                              DST[i] = ((key_ >> 9) & 16383u) * (unsigned)(D / 2) + 16u * (unsigned)(lane_ & 7); } } while (0)
        GV_VOFF(voff, 0);
#pragma unroll
        for (int i = 0; i < 8; ++i) { vr[0][i] = *(const u32x4*)(TV + voff[i]); vr[1][i] = *(const u32x4*)(TV + voff[8 + i]); }
#pragma unroll
        for (int i = 0; i < 16; ++i) voffn[i] = voff[i];
#pragma unroll 1
        for (int t = 0; t < 4; ++t) {
            const int lane = (int)tidx() & 63, g = lane >> 4, li = lane & 15;
            LAS unsigned char* stg = l3 + wave * G_LDS_WAVE + 4608;
            LAS unsigned char* dig = l3 + wave * G_LDS_WAVE + 13824;
            float s0;
            {
                const unsigned k0 = keyL[t * 128 + 2 * lane], k1 = keyL[t * 128 + 2 * lane + 1];
                float w0 = wL[k0 & 511u], w1 = wL[k1 & 511u];
                float mx = fmaxf(fabsf(w0), fabsf(w1));
#pragma unroll
                for (int o = 1; o <= 32; o <<= 1) mx = fmaxf(mx, __shfl_xor(mx, o));
                s0 = mx > 0.f ? mx * (1.0f / 6.0f) : 1.0f;
                float sm = s0;
#define GV_DIGIT(m) { const float ism = 1.0f / sm; const unsigned d_ = __builtin_amdgcn_cvt_scalef32_pk_fp4_f32(0u, w0 * ism, w1 * ism, 1.0f, 0); const f32x2v q_ = __builtin_amdgcn_cvt_scalef32_pk_f32_fp4(d_, 1.0f, 0); \
                      w0 -= q_.x * sm; w1 -= q_.y * sm; *(LAS unsigned char*)(dig + (m) * 64 + lane) = (unsigned char)d_; sm *= 0.25f; }
                GV_DIGIT(0) GV_DIGIT(1) GV_DIGIT(2) GV_DIGIT(3)
#undef GV_DIGIT
            }
            asm volatile("s_waitcnt lgkmcnt(0)" ::: "memory");
            u32x2 awh[2];
            awh[0] = *(const LAS u32x2*)(dig + (li & 3) * 64 + 8 * g); awh[1] = *(const LAS u32x2*)(dig + (li & 3) * 64 + 32 + 8 * g);
            float swt[4];
#pragma unroll
            for (int i = 0; i < 4; ++i) swt[i] = s0 * __builtin_amdgcn_exp2f(-2.0f * (float)i);
            float outv[16];
#pragma unroll
            for (int i = 0; i < 16; ++i) outv[i] = 0.f;
#define GV_STAGE(H, NEXTLOADS) do { \
                _Pragma("unroll") for (int i = 0; i < 8; ++i) { \
                    LAS unsigned char* p = stg + (8 * i + (lane >> 3)) * 136 + 16 * (lane & 7); \
                    u32x2 lo2, hi2; lo2.x = vr[H][i].x; lo2.y = vr[H][i].y; hi2.x = vr[H][i].z; hi2.y = vr[H][i].w; \
                    *(LAS u32x2*)p = lo2; *(LAS u32x2*)(p + 8) = hi2; } \
                NEXTLOADS; \
                asm volatile("s_waitcnt lgkmcnt(0)" ::: "memory"); \
                _Pragma("unroll") for (int cb = 0; cb < 16; ++cb) { \
                    const v2i32 blo = __builtin_amdgcn_ds_read_tr4_b64_v2i32((LAS v2i32*)(stg + (16 * g + li) * 136 + 8 * cb)); \
                    const f32x4 dd = __builtin_amdgcn_mfma_scale_f32_16x16x128_f8f6f4((v8i32){(int)awh[H].x, (int)awh[H].y, 0, 0, 0, 0, 0, 0}, (v8i32){blo.x, blo.y, 0, 0, 0, 0, 0, 0}, \
                                                                                    (f32x4){0.f, 0.f, 0.f, 0.f}, 4, 4, 0, 0x7F7F7F7F, 0, 0x7F7F7F7F); \
                    tmpv[cb] += (dd[0] * swt[0] + dd[1] * swt[1]) + (dd[2] * swt[2] + dd[3] * swt[3]); } \
                asm volatile("s_waitcnt lgkmcnt(0)" ::: "memory"); } while (0)
#pragma unroll 1
            for (int c = 0; c < 4; ++c) {
                if (c == 3 && t < 3) GV_VOFF(voffn, t + 1);
                const unsigned nb = (c < 3) ? 128u * (unsigned)(c + 1) : 0u;
                float tmpv[16];
#pragma unroll
                for (int i = 0; i < 16; ++i) tmpv[i] = 0.f;
                GV_STAGE(0, { _Pragma("unroll") for (int i = 0; i < 8; ++i) vr[0][i] = *(const u32x4*)(TV + ((c < 3) ? voff[i] : voffn[i]) + nb); });
                GV_STAGE(1, { _Pragma("unroll") for (int i = 0; i < 8; ++i) vr[1][i] = *(const u32x4*)(TV + ((c < 3) ? voff[8 + i] : voffn[8 + i]) + nb); });
#pragma unroll
                for (int i = 0; i < 16; ++i) outv[i] = (g == c) ? tmpv[i] : outv[i];
            }
#pragma unroll
            for (int i = 0; i < 16; ++i) voff[i] = voffn[i];
#undef GV_STAGE
            LAS float* obuf = (LAS float*)stg;
#pragma unroll
            for (int cb = 0; cb < 16; ++cb) obuf[256 * g + 16 * cb + li] = outv[cb];
            asm volatile("s_waitcnt lgkmcnt(0)" ::: "memory");
            {
                const size_t tok = (size_t)(tbase + t);
                const float2 rs2e = *(const float2*)(RS + tok * 2); const float mu1 = rs2e.x, rs1 = rs2e.y;
                f32x4 ac[4];
                float sum = 0.f;
#pragma unroll
                for (int q = 0; q < 4; ++q) {
                    const int d0 = 256 * q + 4 * lane;
                    const f32x4 gg = *(const f32x4*)(g1 + d0), bb = *(const f32x4*)(b1 + d0);
                    const f32x4 x1v = (ldpre4(XB + tok * D + d0) - mu1) * rs1 * gg + bb;
                    ac[q] = *(const LAS f32x4*)(obuf + d0) + x1v * DN_ALPHA;
                    sum += (ac[q][0] + ac[q][1]) + (ac[q][2] + ac[q][3]);
                }
#pragma unroll
                for (int o = 1; o <= 32; o <<= 1) sum += __shfl_xor(sum, o);
                const float mu = sum * (1.0f / D);
                float sq = 0.f;
#pragma unroll
                for (int q = 0; q < 4; ++q) { ac[q] = ac[q] - mu; sq += (ac[q][0] * ac[q][0] + ac[q][1] * ac[q][1]) + (ac[q][2] * ac[q][2] + ac[q][3] * ac[q][3]); }
#pragma unroll
                for (int o = 1; o <= 32; o <<= 1) sq += __shfl_xor(sq, o);
                const float rsd = 1.0f / sqrtf(sq * (1.0f / D) + LN_EPS);
#pragma unroll
                for (int q = 0; q < 4; ++q) {
                    const int d0 = 256 * q + 4 * lane;
                    const f32x4 o4 = ac[q] * rsd * *(const f32x4*)(lg + d0) + *(const f32x4*)(lb + d0);
                    if (OUT) *(f32x4*)(OUT + tok * D + d0) = o4;
                    u32x2 w; w.x = pk2(o4[0], o4[1]); w.y = pk2(o4[2], o4[3]);
                    *(u32x2*)(XB + tok * D + d0) = w;
                }
            }
            asm volatile("s_waitcnt lgkmcnt(0)" ::: "memory");
        }
        asm volatile("s_waitcnt lgkmcnt(0)" ::: "memory");
    }
}
typedef short bf16x4_t __attribute__((ext_vector_type(4)));
__device__ __forceinline__ bf16x8_t ld8(const bf16_t* p) { return *(const bf16x8_t*)p; }
__device__ __forceinline__ bf16x8_t cat44(const bf16_t* p0, const bf16_t* p1) {
    const bf16x4_t a = *(const bf16x4_t*)p0, b = *(const bf16x4_t*)p1;
    return (bf16x8_t){a[0], a[1], a[2], a[3], b[0], b[1], b[2], b[3]};
}
__device__ __forceinline__ void ph_retkv(const bf16_t* VRT, const bf16_t* KRT, float* KVT, LAS unsigned char* l3) {
    const int tid = (int)tidx(), lane = tid & 63, g = lane >> 4, li = lane & 15;
    const int wave = __builtin_amdgcn_readfirstlane(tid >> 6);
    const int gd_ = (int)gdim(), bx0_ = (int)bidx();
    const int vcu = (gd_ % 8 == 0) ? (bx0_ % 8) * (gd_ / 8) + bx0_ / 8 : bx0_;
#pragma unroll 1
    for (int item = vcu; item < 8 * RNC; item += gd_) {
        const int bh = item >> 5, n = item & 31;
        {
            const bf16_t* kg = KRT + ((size_t)bh * 128) * S + n * 256;
#pragma unroll
            for (int q = 0; q < 8; ++q) {
                const int c = tid + 512 * q, d = c >> 5, ch = c & 31;
                const u32x4 v = *(const u32x4*)(kg + (size_t)d * S + ch * 8);
                *(LAS u32x4*)(l3 + d * 512 + ((ch ^ (d & 31)) * 16)) = v;
            }
        }
        const bf16_t* vb = VRT + ((size_t)bh * 256 + 32 * wave + li) * S + n * 256 + 8 * g;
        bf16x8_t a0[8], a1[8];
#pragma unroll
        for (int s = 0; s < 8; ++s) { a0[s] = ld8(vb + 32 * s); a1[s] = ld8(vb + (size_t)16 * S + 32 * s); }
        __syncthreads();
        f32x4 acc[2][8];
#pragma unroll
        for (int a = 0; a < 2; ++a)
#pragma unroll
            for (int d = 0; d < 8; ++d) acc[a][d] = (f32x4){0.f, 0.f, 0.f, 0.f};
#pragma unroll
        for (int s = 0; s < 8; ++s) {
#pragma unroll
            for (int dt = 0; dt < 8; ++dt) {
                const int d = 16 * dt + li;
                const bf16x8_t kf = *(const LAS bf16x8_t*)(l3 + d * 512 + (((4 * s + g) ^ (d & 31)) * 16));
                acc[0][dt] = __builtin_amdgcn_mfma_f32_16x16x32_bf16(a0[s], kf, acc[0][dt], 0, 0, 0);
                acc[1][dt] = __builtin_amdgcn_mfma_f32_16x16x32_bf16(a1[s], kf, acc[1][dt], 0, 0, 0);
            }
        }
        float* ob = KVT + (((size_t)item) << 15);
#pragma unroll
        for (int a = 0; a < 2; ++a)
#pragma unroll
            for (int dt = 0; dt < 8; ++dt)
#pragma unroll
                for (int r = 0; r < 4; ++r) ob[(size_t)(32 * wave + 16 * a + 4 * g + r) * 128 + 16 * dt + li] = acc[a][dt][r];
        __syncthreads();
    }
}
constexpr int RO_PREV = 0, RO_K = 65536, RO_V = RO_K + 2 * 8192, RO_END = RO_V + 2 * 16384;
static_assert(RO_END <= 131072, "retout LDS map");
__device__ __forceinline__ void ph_retout(const bf16_t* QR, const bf16_t* KR, const bf16_t* VRT, const bf16_t* PREVT, const bf16_t* GR, bf16_t* YR, LAS unsigned char* l3) {
    const int tid = (int)tidx(), lane = tid & 63, g = lane >> 4, li = lane & 15;
    const int wave = __builtin_amdgcn_readfirstlane(tid >> 6);
    const int gd_ = (int)gdim(), bx0_ = (int)bidx();
    const int vcu = (gd_ % 8 == 0) ? (bx0_ % 8) * (gd_ / 8) + bx0_ / 8 : bx0_;
#pragma unroll 1
    for (int item = vcu; item < 8 * RNC; item += gd_) {
        const int bh = item >> 5, n = item & 31, b = bh >> 2, h = bh & 3;
        const size_t tok0 = (size_t)b * S + n * 256;
        {
            const bf16_t* pg = PREVT + (((size_t)item) << 15);
#pragma unroll
            for (int q = 0; q < 8; ++q) {
                const int c = tid + 512 * q, e = c >> 4, ch = c & 15;
                const u32x4 v = *(const u32x4*)(pg + (size_t)c * 8);
                *(LAS u32x4*)(l3 + RO_PREV + e * 256 + ((ch ^ (e & 15)) * 16)) = v;
            }
        }
        u32x4 kreg, vreg[2];
        const int krow = tid >> 4, kch = tid & 15;
#pragma unroll 1
        for (int hf = 0; hf < 2; ++hf) {
            const int tg = hf == 0 ? wave : 15 - wave, nstep = hf == 0 ? 4 : 8;
            const int c = 16 * tg + li;
            kreg = *(const u32x4*)(KR + (tok0 + krow) * 512 + h * 128 + kch * 8);
#pragma unroll
            for (int q = 0; q < 2; ++q) { const int cx = tid + 512 * q, e = cx >> 2, ch = cx & 3; vreg[q] = *(const u32x4*)(VRT + ((size_t)bh * 256 + e) * S + n * 256 + ch * 8); }
            bf16x8_t qf[4];
            {
                const bf16_t* qp = QR + (tok0 + c) * 512 + h * 128 + 8 * g;
#pragma unroll
                for (int ks = 0; ks < 4; ++ks) qf[ks] = ld8(qp + 32 * ks);
            }
            *(LAS u32x4*)(l3 + RO_K + krow * 256 + ((kch ^ (krow & 15)) * 16)) = kreg;
#pragma unroll
            for (int q = 0; q < 2; ++q) { const int cx = tid + 512 * q, e = cx >> 2, ch = cx & 3; *(LAS u32x4*)(l3 + RO_V + e * 64 + ((ch ^ ((e >> 1) & 3)) * 16)) = vreg[q]; }
            __syncthreads();
            f32x4 y[16];
#pragma unroll
            for (int et = 0; et < 16; ++et) {
                f32x4 a0 = (f32x4){0.f, 0.f, 0.f, 0.f};
                const int e = 16 * et + li;
#pragma unroll
                for (int ks = 0; ks < 4; ++ks) {
                    const bf16x8_t pf = *(const LAS bf16x8_t*)(l3 + RO_PREV + e * 256 + (((4 * ks + g) ^ (e & 15)) * 16));
                    a0 = __builtin_amdgcn_mfma_f32_16x16x32_bf16(pf, qf[ks], a0, 0, 0, 0);
                }
                y[et] = a0;
            }
#pragma unroll 1
            for (int s = 0; s < nstep; ++s) {
                const int buf = s & 1;
                if (s + 1 < nstep) {
                    kreg = *(const u32x4*)(KR + (tok0 + 32 * (s + 1) + krow) * 512 + h * 128 + kch * 8);
#pragma unroll
                    for (int q = 0; q < 2; ++q) { const int cx = tid + 512 * q, e = cx >> 2, ch = cx & 3; vreg[q] = *(const u32x4*)(VRT + ((size_t)bh * 256 + e) * S + n * 256 + 32 * (s + 1) + ch * 8); }
                }
                if (2 * s <= tg) {
                    f32x4 s0 = (f32x4){0.f, 0.f, 0.f, 0.f}, s1 = s0;
#pragma unroll
                    for (int ks = 0; ks < 4; ++ks) {
                        const bf16x8_t k0 = *(const LAS bf16x8_t*)(l3 + RO_K + buf * 8192 + li * 256 + (((4 * ks + g) ^ li) * 16));
                        const bf16x8_t k1 = *(const LAS bf16x8_t*)(l3 + RO_K + buf * 8192 + (16 + li) * 256 + (((4 * ks + g) ^ li) * 16));
                        s0 = __builtin_amdgcn_mfma_f32_16x16x32_bf16(k0, qf[ks], s0, 0, 0, 0);
                        s1 = __builtin_amdgcn_mfma_f32_16x16x32_bf16(k1, qf[ks], s1, 0, 0, 0);
                    }
                    const int m0 = 32 * s + 4 * g;
                    float p0[4], p1[4];
#pragma unroll
                    for (int r = 0; r < 4; ++r) { p0[r] = (m0 + r <= c) ? s0[r] : 0.f; p1[r] = (m0 + 16 + r <= c) ? s1[r] : 0.f; }
                    const bf16x8_t pf = __builtin_bit_cast(bf16x8_t, (u32x4){pk2(p0[0], p0[1]), pk2(p0[2], p0[3]), pk2(p1[0], p1[1]), pk2(p1[2], p1[3])});
#pragma unroll
                    for (int et = 0; et < 16; ++et) {
                        const int e = 16 * et + li, sw = (e >> 1) & 3;
                        const LAS unsigned char* vrow = l3 + RO_V + buf * 16384 + e * 64 + 8 * (g & 1);
                        const bf16x4_t a = *(const LAS bf16x4_t*)(vrow + (((g >> 1) ^ sw) * 16)), cq = *(const LAS bf16x4_t*)(vrow + ((((g >> 1) + 2) ^ sw) * 16));
                        const bf16x8_t vf = (bf16x8_t){a[0], a[1], a[2], a[3], cq[0], cq[1], cq[2], cq[3]};
                        y[et] = __builtin_amdgcn_mfma_f32_16x16x32_bf16(vf, pf, y[et], 0, 0, 0);
                    }
                }
                if (s + 1 < nstep) {
                    *(LAS u32x4*)(l3 + RO_K + (buf ^ 1) * 8192 + krow * 256 + ((kch ^ (krow & 15)) * 16)) = kreg;
#pragma unroll
                    for (int q = 0; q < 2; ++q) { const int cx = tid + 512 * q, e = cx >> 2, ch = cx & 3; *(LAS u32x4*)(l3 + RO_V + (buf ^ 1) * 16384 + e * 64 + ((ch ^ ((e >> 1) & 3)) * 16)) = vreg[q]; }
                }
                __syncthreads();
            }
            float sum = 0.f;
#pragma unroll
            for (int et = 0; et < 16; ++et) sum += (y[et][0] + y[et][1]) + (y[et][2] + y[et][3]);
            sum += __shfl_xor(sum, 16); sum += __shfl_xor(sum, 32);
            const float mu = sum * (1.0f / 256.0f);
            float sq = 0.f;
#pragma unroll
            for (int et = 0; et < 16; ++et) { y[et] = y[et] - mu; sq += (y[et][0] * y[et][0] + y[et][1] * y[et][1]) + (y[et][2] * y[et][2] + y[et][3] * y[et][3]); }
            sq += __shfl_xor(sq, 16); sq += __shfl_xor(sq, 32);
            const float rs = 1.0f / sqrtf(sq * (1.0f / 256.0f) + LN_EPS);
            const bf16_t* gp = GR + (tok0 + c) * 1024 + h * 256 + 4 * g;
            bf16_t* yp = YR + (tok0 + c) * 1024 + h * 256 + 4 * g;
#pragma unroll
            for (int et = 0; et < 16; ++et) {
                const u32x2 gg = *(const u32x2*)(gp + 16 * et);
                u32x2 o;
                o.x = pk2(y[et][0] * rs * __uint_as_float(gg.x << 16), y[et][1] * rs * __uint_as_float(gg.x & 0xffff0000u));
                o.y = pk2(y[et][2] * rs * __uint_as_float(gg.y << 16), y[et][3] * rs * __uint_as_float(gg.y & 0xffff0000u));
                *(u32x2*)(yp + 16 * et) = o;
            }
        }
    }
}
constexpr int MB_KOFF = 0, MB_VOFF = 32768, MB_STATE = 65536, MB_SSTR = 144, MB_LIST = MB_STATE + 256 * MB_SSTR, MB_CNT = MB_LIST + 32 * 256, MB_SCR = MB_CNT + 256, MB_SCR_W = 16 * 68 * 4;
static_assert(MB_SCR + 8 * MB_SCR_W <= 147200, "moba LDS map");
__device__ __forceinline__ void top3_insert(float v, int n, float& v0, float& v1, float& v2, int& i0, int& i1, int& i2) {
    const bool b0 = (v > v0) || (v == v0 && n < i0), b1 = (v > v1) || (v == v1 && n < i1), b2 = (v > v2) || (v == v2 && n < i2);
    const float nv2 = b1 ? v1 : (b2 ? v : v2); const int ni2 = b1 ? i1 : (b2 ? n : i2);
    const float nv1 = b0 ? v0 : (b1 ? v : v1); const int ni1 = b0 ? i0 : (b1 ? n : i1);
    v0 = b0 ? v : v0; i0 = b0 ? n : i0; v1 = nv1; i1 = ni1; v2 = nv2; i2 = ni2;
}
template <int NCG, bool OWN>
__device__ __forceinline__ void moba_block(LAS unsigned char* l3, int tile0, int ntile, const bf16x8_t (&qf)[NCG][2], const int (&qrow)[NCG], f32x4 (&o)[NCG][4], float (&mrun)[NCG], float (&lrun)[NCG], int g, int li) {
    constexpr float LOG2E = 1.4426950408889634f;
    const int sw = li & 7;
#pragma unroll 1
    for (int tt = tile0; tt < ntile; ++tt) {
        const LAS unsigned char* kbase = l3 + MB_KOFF + (64 * tt + li) * 128;
        const LAS unsigned char* vbase = l3 + MB_VOFF + (64 * tt + li) * 128;
        f32x4 sa[NCG][4];
#pragma unroll
        for (int kt = 0; kt < 4; ++kt) {
            const bf16x8_t k0 = *(const LAS bf16x8_t*)(kbase + kt * 2048 + ((g ^ sw) * 16)), k1 = *(const LAS bf16x8_t*)(kbase + kt * 2048 + (((4 + g) ^ sw) * 16));
#pragma unroll
            for (int cg = 0; cg < NCG; ++cg) {
                f32x4 a = __builtin_amdgcn_mfma_f32_16x16x32_bf16(k0, qf[cg][0], (f32x4){0.f, 0.f, 0.f, 0.f}, 0, 0, 0);
                sa[cg][kt] = __builtin_amdgcn_mfma_f32_16x16x32_bf16(k1, qf[cg][1], a, 0, 0, 0);
            }
        }
        bf16x8_t pf[NCG][2];
#pragma unroll
        for (int cg = 0; cg < NCG; ++cg) {
            float tm = NEGF;
#pragma unroll
            for (int kt = 0; kt < 4; ++kt)
#pragma unroll
                for (int r = 0; r < 4; ++r) {
                    float sv = sa[cg][kt][r] * LOG2E;
                    if (OWN) { const int key = 64 * tt + 16 * kt + 4 * g + r; sv = (key <= qrow[cg]) ? sv : NEGF; }
                    sa[cg][kt][r] = sv; tm = fmaxf(tm, sv);
                }
            tm = fmaxf(tm, __shfl_xor(tm, 16)); tm = fmaxf(tm, __shfl_xor(tm, 32));
            const float mn = fmaxf(mrun[cg], tm);
            const float alpha = __builtin_amdgcn_exp2f(mrun[cg] - mn);
            mrun[cg] = mn;
            float ps = 0.f;
#pragma unroll
            for (int kt = 0; kt < 4; ++kt)
#pragma unroll
                for (int r = 0; r < 4; ++r) { const float p = __builtin_amdgcn_exp2f(sa[cg][kt][r] - mn); sa[cg][kt][r] = p; ps += p; }
            lrun[cg] = lrun[cg] * alpha + ps;
#pragma unroll
            for (int dt = 0; dt < 4; ++dt) o[cg][dt] = o[cg][dt] * alpha;
#pragma unroll
            for (int s2 = 0; s2 < 2; ++s2)
                pf[cg][s2] = __builtin_bit_cast(bf16x8_t, (u32x4){pk2(sa[cg][2 * s2][0], sa[cg][2 * s2][1]), pk2(sa[cg][2 * s2][2], sa[cg][2 * s2][3]),
                                                                   pk2(sa[cg][2 * s2 + 1][0], sa[cg][2 * s2 + 1][1]), pk2(sa[cg][2 * s2 + 1][2], sa[cg][2 * s2 + 1][3])});
        }
#pragma unroll
        for (int dt = 0; dt < 4; ++dt)
#pragma unroll
            for (int s2 = 0; s2 < 2; ++s2) {
                const int c0 = 4 * s2 + (g >> 1);
                const bf16x4_t a = *(const LAS bf16x4_t*)(vbase + dt * 2048 + ((c0 ^ sw) * 16) + 8 * (g & 1)), c = *(const LAS bf16x4_t*)(vbase + dt * 2048 + (((c0 + 2) ^ sw) * 16) + 8 * (g & 1));
                const bf16x8_t vf = (bf16x8_t){a[0], a[1], a[2], a[3], c[0], c[1], c[2], c[3]};
#pragma unroll
                for (int cg = 0; cg < NCG; ++cg) o[cg][dt] = __builtin_amdgcn_mfma_f32_16x16x32_bf16(vf, pf[cg][s2], o[cg][dt], 0, 0, 0);
            }
    }
}
__device__ __forceinline__ void moba_past_group(LAS unsigned char* l3, const bf16x8_t (&qf)[2], f32x4 (&o)[4], float& mout, float& lout, int g, int li) {
    constexpr float LOG2E = 1.4426950408889634f;
    const int sw = li & 7;
    f32x4 sa[16];
#pragma unroll
    for (int t = 0; t < 16; ++t) {
        const LAS unsigned char* kbase = l3 + MB_KOFF + (16 * t + li) * 128;
        const bf16x8_t k0 = *(const LAS bf16x8_t*)(kbase + ((g ^ sw) * 16)), k1 = *(const LAS bf16x8_t*)(kbase + (((4 + g) ^ sw) * 16));
        f32x4 a = __builtin_amdgcn_mfma_f32_16x16x32_bf16(k0, qf[0], (f32x4){0.f, 0.f, 0.f, 0.f}, 0, 0, 0);
        sa[t] = __builtin_amdgcn_mfma_f32_16x16x32_bf16(k1, qf[1], a, 0, 0, 0);
    }
    float tm = NEGF;
#pragma unroll
    for (int t = 0; t < 16; ++t) { sa[t] = sa[t] * LOG2E; tm = fmaxf(fmaxf(tm, fmaxf(sa[t][0], sa[t][1])), fmaxf(sa[t][2], sa[t][3])); }
    tm = fmaxf(tm, __shfl_xor(tm, 16)); tm = fmaxf(tm, __shfl_xor(tm, 32));
    float ps = 0.f;
    bf16x8_t pf[8];
#pragma unroll
    for (int u = 0; u < 8; ++u) {
        float p[8];
#pragma unroll
        for (int r = 0; r < 4; ++r) { p[r] = __builtin_amdgcn_exp2f(sa[2 * u][r] - tm); p[4 + r] = __builtin_amdgcn_exp2f(sa[2 * u + 1][r] - tm); }
        ps += ((p[0] + p[1]) + (p[2] + p[3])) + ((p[4] + p[5]) + (p[6] + p[7]));
        pf[u] = __builtin_bit_cast(bf16x8_t, (u32x4){pk2(p[0], p[1]), pk2(p[2], p[3]), pk2(p[4], p[5]), pk2(p[6], p[7])});
    }
#pragma unroll
    for (int dt = 0; dt < 4; ++dt) {
        f32x4 acc = (f32x4){0.f, 0.f, 0.f, 0.f};
#pragma unroll
        for (int u = 0; u < 8; ++u) {
            const LAS unsigned char* vbase = l3 + MB_VOFF + (64 * (u >> 1) + 16 * dt + li) * 128 + 8 * (g & 1);
            const int c0 = 4 * (u & 1) + (g >> 1);
            const bf16x4_t a = *(const LAS bf16x4_t*)(vbase + ((c0 ^ sw) * 16)), c = *(const LAS bf16x4_t*)(vbase + (((c0 + 2) ^ sw) * 16));
            acc = __builtin_amdgcn_mfma_f32_16x16x32_bf16((bf16x8_t){a[0], a[1], a[2], a[3], c[0], c[1], c[2], c[3]}, pf[u], acc, 0, 0, 0);
        }
        o[dt] = acc;
    }
    mout = tm; lout = ps;
}
#define MOBA_BUCKET(j, KR_, VR_) do { \
_Pragma("unroll") \
            for (int q = 0; q < 4; ++q) { \
                const int c = tid + 512 * q, row = c >> 3, ch = c & 7; \
                *(LAS u32x4*)(l3 + MB_KOFF + row * 128 + ((ch ^ (row & 7)) * 16)) = KR_[q]; \
                *(LAS u32x4*)(l3 + MB_VOFF + row * 128 + ((ch ^ (row & 7)) * 16)) = VR_[q]; \
            } \
            __syncthreads(); \
            if (j + 1 < i) { \
                const bf16_t* kg = KA + ((size_t)b * S + (size_t)(j + 1) * 256) * 512 + h * 64; \
                const bf16_t* vg = VAT + ((size_t)bh * 128 + (size_t)(j + 1) * 4) * 4096; \
_Pragma("unroll") \
                for (int q = 0; q < 4; ++q) { const int c = tid + 512 * q, row = c >> 3, ch = c & 7; KR_[q] = *(const u32x4*)((const char*)kg + (unsigned)((row * 512 + ch * 8) * 2)); VR_[q] = *(const u32x4*)((const char*)vg + (unsigned)(c * 16)); } \
            } \
            const int nj = cntL[j]; \
            const int ngrp = (nj + 15) >> 4; \
            { \
                _Pragma("unroll 1") \
                for (int gi = wave; gi < ngrp; gi += 8) { \
                    const int e = gi * 16 + li; \
                    const bool valid = e < nj; \
                    const int q = listL[j * 256 + (valid ? e : gi * 16)]; \
                    bf16x8_t qg[2]; \
                    _Pragma("unroll") \
                    for (int ks = 0; ks < 2; ++ks) qg[ks] = *(const LAS bf16x8_t*)(qL + q * 128 + (((4 * ks + g) ^ (q & 7)) * 16)); \
                    f32x4 o[4]; float mg, lg_; \
                    moba_past_group(l3, qg, o, mg, lg_, g, li); \
                    float l = lg_; l += __shfl_xor(l, 16); l += __shfl_xor(l, 32); \
                    if (valid) { \
                        LAS unsigned char* sp = stL + q * MB_SSTR; \
                        const float mo = *(LAS float*)(sp + 128), lo = *(LAS float*)(sp + 132); \
                        const float mn = fmaxf(mo, mg); \
                        const float a = __builtin_amdgcn_exp2f(mo - mn), bb = __builtin_amdgcn_exp2f(mg - mn); \
                        _Pragma("unroll") \
                        for (int dt = 0; dt < 4; ++dt) { \
                            const u32x2 ow = *(LAS u32x2*)(sp + (16 * dt + 4 * g) * 2); \
                            u32x2 w; \
                            w.x = pk2(__uint_as_float(ow.x << 16) * a + o[dt][0] * bb, __uint_as_float(ow.x & 0xffff0000u) * a + o[dt][1] * bb); \
                            w.y = pk2(__uint_as_float(ow.y << 16) * a + o[dt][2] * bb, __uint_as_float(ow.y & 0xffff0000u) * a + o[dt][3] * bb); \
                            *(LAS u32x2*)(sp + (16 * dt + 4 * g) * 2) = w; \
                        } \
                        if (g == 0) { *(LAS float*)(sp + 128) = mn; *(LAS float*)(sp + 132) = lo * a + l * bb; } \
                    } \
                } \
                __syncthreads(); \
            } \
        } while (0)
__device__ __forceinline__ void ph_moba_own(const bf16_t* QA, const bf16_t* KA, const bf16_t* VAT, const float* KMP, LAS unsigned char* l3, unsigned* SEL, bf16_t* OWNO, float* OWNML) {
    const int tid = (int)tidx(), lane = tid & 63, g = lane >> 4, li = lane & 15;
    const int wave = __builtin_amdgcn_readfirstlane(tid >> 6);
    const int gd_ = (int)gdim(), bx0_ = (int)bidx();
    const int vcu = (gd_ % 8 == 0) ? (bx0_ % 8) * (gd_ / 8) + bx0_ / 8 : bx0_;
#pragma unroll 1
    for (int it = vcu; it < 512; it += gd_) {
        const int bh = (it & 255) >> 4, ii = it & 15, i = (it < 256) ? ii : 31 - ii;
        const int b = bh >> 3, h = bh & 7;
        const size_t tok0 = (size_t)b * S + (size_t)i * 256;
        u32x4 kreg[4], vreg[4];
        {
            const bf16_t* kg = KA + tok0 * 512 + h * 64;
            const bf16_t* vg = VAT + ((size_t)bh * 128 + (size_t)i * 4) * 4096;
#pragma unroll
            for (int q = 0; q < 4; ++q) { const int c = tid + 512 * q, row = c >> 3, ch = c & 7; kreg[q] = *(const u32x4*)((const char*)kg + (unsigned)((row * 512 + ch * 8) * 2)); vreg[q] = *(const u32x4*)((const char*)vg + (unsigned)(c * 16)); }
        }
#pragma unroll
        for (int q = 0; q < 4; ++q) {
            const int c = tid + 512 * q, row = c >> 3, ch = c & 7;
            *(LAS u32x4*)(l3 + MB_KOFF + row * 128 + ((ch ^ (row & 7)) * 16)) = kreg[q];
            *(LAS u32x4*)(l3 + MB_VOFF + row * 128 + ((ch ^ (row & 7)) * 16)) = vreg[q];
        }
        bf16x8_t qf[2][2];
#pragma unroll
        for (int cg = 0; cg < 2; ++cg)
#pragma unroll
            for (int ks = 0; ks < 2; ++ks) qf[cg][ks] = ld8(QA + (tok0 + 32 * wave + 16 * cg + li) * 512 + h * 64 + 32 * ks + 8 * g);
        __syncthreads();
        if (i == 0) { if (g == 0) { SEL[(size_t)bh * 8192 + 32 * wave + li] = 0x404040u; SEL[(size_t)bh * 8192 + 32 * wave + 16 + li] = 0x404040u; } }
        if (i > 0) {
            f32x4 ga[2][2];
#pragma unroll
            for (int cg = 0; cg < 2; ++cg)
#pragma unroll
                for (int nt = 0; nt < 2; ++nt) ga[cg][nt] = (f32x4){0.f, 0.f, 0.f, 0.f};
#pragma unroll
            for (int nt = 0; nt < 2; ++nt)
#pragma unroll
                for (int ks = 0; ks < 2; ++ks) {
                    const float* kp = KMP + ((size_t)((b * 32 + 16 * nt + li) * 2)) * 512 + h * 64 + 32 * ks + 8 * g;
                    const f32x4 a0 = *(const f32x4*)kp + *(const f32x4*)(kp + 512), a1 = *(const f32x4*)(kp + 4) + *(const f32x4*)(kp + 516);
                    const float km[8] = {a0[0], a0[1], a0[2], a0[3], a1[0], a1[1], a1[2], a1[3]};
                    unsigned hi[4], lo[4];
#pragma unroll
                    for (int e = 0; e < 4; ++e) {
                        const unsigned h0 = f2bf(km[2 * e]), h1 = f2bf(km[2 * e + 1]);
                        hi[e] = h0 | (h1 << 16);
                        lo[e] = pk2(km[2 * e] - __uint_as_float(h0 << 16), km[2 * e + 1] - __uint_as_float(h1 << 16));
                    }
                    const bf16x8_t fh = __builtin_bit_cast(bf16x8_t, (u32x4){hi[0], hi[1], hi[2], hi[3]}), fl = __builtin_bit_cast(bf16x8_t, (u32x4){lo[0], lo[1], lo[2], lo[3]});
#pragma unroll
                    for (int cg = 0; cg < 2; ++cg) {
                        ga[cg][nt] = __builtin_amdgcn_mfma_f32_16x16x32_bf16(fh, qf[cg][ks], ga[cg][nt], 0, 0, 0);
                        ga[cg][nt] = __builtin_amdgcn_mfma_f32_16x16x32_bf16(fl, qf[cg][ks], ga[cg][nt], 0, 0, 0);
                    }
                }
#pragma unroll
            for (int cg = 0; cg < 2; ++cg) {
                float v0 = NEGF, v1 = NEGF, v2 = NEGF; int i0 = 64, i1 = 64, i2 = 64;
#pragma unroll
                for (int nt = 0; nt < 2; ++nt)
#pragma unroll
                    for (int r = 0; r < 4; ++r) { const int n = 16 * nt + 4 * g + r; if (n < i) top3_insert(ga[cg][nt][r], n, v0, v1, v2, i0, i1, i2); }
#pragma unroll
                for (int o = 16; o <= 32; o <<= 1) {
                    const float w0 = __shfl_xor(v0, o), w1 = __shfl_xor(v1, o), w2 = __shfl_xor(v2, o);
                    const int j0 = __shfl_xor(i0, o), j1 = __shfl_xor(i1, o), j2 = __shfl_xor(i2, o);
                    if (j0 < 64) top3_insert(w0, j0, v0, v1, v2, i0, i1, i2);
                    if (j1 < 64) top3_insert(w1, j1, v0, v1, v2, i0, i1, i2);
                    if (j2 < 64) top3_insert(w2, j2, v0, v1, v2, i0, i1, i2);
                }
                if (g == 0) SEL[(size_t)bh * 8192 + i * 256 + 32 * wave + 16 * cg + li] = (unsigned)i0 | ((unsigned)i1 << 8) | ((unsigned)i2 << 16);
            }
        }
        {
            f32x4 o[2][4]; float mrun[2], lrun[2]; int qrow[2];
#pragma unroll
            for (int cg = 0; cg < 2; ++cg) { mrun[cg] = NEGF; lrun[cg] = 0.f; qrow[cg] = 32 * wave + 16 * cg + li;
#pragma unroll
                for (int dt = 0; dt < 4; ++dt) o[cg][dt] = (f32x4){0.f, 0.f, 0.f, 0.f}; }
            moba_block<2, true>(l3, 0, (32 * wave + 31) / 64 + 1, qf, qrow, o, mrun, lrun, g, li);
#pragma unroll
            for (int cg = 0; cg < 2; ++cg) {
                float l = lrun[cg]; l += __shfl_xor(l, 16); l += __shfl_xor(l, 32);
                const size_t qi = (size_t)bh * 8192 + i * 256 + qrow[cg];
#pragma unroll
                for (int dt = 0; dt < 4; ++dt) { u32x2 w; w.x = pk2(o[cg][dt][0], o[cg][dt][1]); w.y = pk2(o[cg][dt][2], o[cg][dt][3]); *(u32x2*)(OWNO + qi * 64 + 16 * dt + 4 * g) = w; }
                if (g == 0) *(float2*)(OWNML + qi * 2) = make_float2(mrun[cg], l);
            }
        }
        __syncthreads();
    }
}

constexpr int MBU_MAX = 3;
__device__ const unsigned MBU_TAB[16][MBU_MAX] = {
    {0x00200908u, 0x00201413u, 0xFFFFFFFFu},
    {0x00200A09u, 0x00201312u, 0x00201E1Du},
    {0x000C0403u, 0x00201211u, 0xFFFFFFFFu},
    {0x00060201u, 0x00070400u, 0xFFFFFFFFu},
    {0x00200B0Au, 0x00201110u, 0xFFFFFFFFu},
    {0x000D0504u, 0x0020100Fu, 0x00201D1Cu},
    {0x00200C03u, 0x00100807u, 0x00201F1Eu},
    {0x00200C0Bu, 0x00201007u, 0x00201A19u},
    {0x00040100u, 0x00200F0Eu, 0xFFFFFFFFu},
    {0x00070302u, 0x00200F06u, 0x00201C1Bu},
    {0x00200D01u, 0x000F0706u, 0x00201B1Au},
    {0x00200D04u, 0x00200F00u, 0x00201817u},
    {0x00200D0Cu, 0x00200F02u, 0x00201918u},
    {0x000E0605u, 0x000F0702u, 0x00201716u},
    {0x00200E05u, 0x000D0601u, 0x00201615u},
    {0x00200E0Du, 0x000F0700u, 0x00201514u}
};
constexpr int MP_LIST = 65536, MP_CNT = MP_LIST + 16384, MP_PSTR = 136;
__device__ __forceinline__ void ph_moba_past(const bf16_t* QA, const bf16_t* KA, const bf16_t* VAT, const unsigned* SEL, unsigned char* PART, LAS unsigned char* l3) {
    const int tid = (int)tidx();
    const int wave = __builtin_amdgcn_readfirstlane(tid >> 6);
    LAS unsigned short* listL = (LAS unsigned short*)(l3 + MP_LIST);
    LAS int* cntL = (LAS int*)(l3 + MP_CNT);
    const int gd_ = (int)gdim(), bx0_ = (int)bidx();
    const int vcu = (gd_ % 8 == 0) ? (bx0_ % 8) * (gd_ / 8) + bx0_ / 8 : bx0_;
#pragma unroll 1
    for (int slot = vcu; slot < 256; slot += gd_) {
        const int bh = slot >> 4, bin = slot & 15, b = bh >> 3, h = bh & 7;
#pragma unroll 1
        for (int un = 0; un < MBU_MAX; ++un) {
            const unsigned ud = MBU_TAB[bin][un];
            if (ud == 0xFFFFFFFFu) break;
            const int j = (int)(ud & 255u), ilo = (int)((ud >> 8) & 255u), ihi = (int)((ud >> 16) & 255u);
            __syncthreads();
            {
                const bf16_t* kg = KA + ((size_t)b * S + (size_t)j * 256) * 512 + h * 64;
                const bf16_t* vg = VAT + ((size_t)bh * 128 + (size_t)j * 4) * 4096;
#pragma unroll
                for (int q4 = 0; q4 < 4; ++q4) {
                    const int c = tid + 512 * q4, row = c >> 3, ch = c & 7;
                    const u32x4 kv = *(const u32x4*)((const char*)kg + (unsigned)((row * 512 + ch * 8) * 2)), vv = *(const u32x4*)((const char*)vg + (unsigned)(c * 16));
                    *(LAS u32x4*)(l3 + MB_KOFF + row * 128 + ((ch ^ (row & 7)) * 16)) = kv;
                    *(LAS u32x4*)(l3 + MB_VOFF + row * 128 + ((ch ^ (row & 7)) * 16)) = vv;
                }
            }
            if (tid == 0) cntL[0] = 0;
            __syncthreads();
            const int nq = (ihi - ilo) * 256;
#pragma unroll 1
            for (int e0 = 0; e0 < nq; e0 += 4096) {
                unsigned sw8[8];
#pragma unroll
                for (int k = 0; k < 8; ++k) { const int e = e0 + tid + 512 * k; sw8[k] = SEL[(size_t)bh * 8192 + ilo * 256 + (e < nq ? e : 0)]; }
#pragma unroll
                for (int k = 0; k < 8; ++k) {
                    const int e = e0 + tid + 512 * k, gq = ilo * 256 + e;
                    const unsigned sw_ = sw8[k];
                    const int s0 = (int)(sw_ & 255u), s1 = (int)((sw_ >> 8) & 255u), s2 = (int)((sw_ >> 16) & 255u);
                    const int r = (s0 == j) ? 0 : (s1 == j) ? 1 : (s2 == j) ? 2 : -1;
                    if (e < nq && r >= 0) { const int p = __hip_atomic_fetch_add(cntL, 1, __ATOMIC_RELAXED, __HIP_MEMORY_SCOPE_WORKGROUP); listL[p] = (unsigned short)(gq | (r << 13)); }
                }
            }
            __syncthreads();
            const int cnt = cntL[0];
            const int ng = (cnt + 15) >> 4;
#pragma unroll 1
            for (int gi = 2 * wave; gi < ng; gi += 16) {
                const int lane_ = (int)tidx() & 63, g = lane_ >> 4, li = lane_ & 15;
                if (gi + 1 < ng) {
                    bf16x8_t qf[2][2]; int gqs[2], rs[2]; bool vals[2]; int qrow[2] = {0, 0};
#pragma unroll
                    for (int cg = 0; cg < 2; ++cg) {
                        const int ei = (gi + cg) * 16 + li;
                        vals[cg] = ei < cnt;
                        const unsigned ent = listL[vals[cg] ? ei : (gi + cg) * 16];
                        gqs[cg] = (int)(ent & 8191u); rs[cg] = (int)(ent >> 13);
#pragma unroll
                        for (int ks = 0; ks < 2; ++ks) qf[cg][ks] = ld8(QA + ((size_t)b * S + gqs[cg]) * 512 + h * 64 + 32 * ks + 8 * g);
                    }
                    f32x4 o[2][4]; float mrun[2], lrun[2];
#pragma unroll
                    for (int cg = 0; cg < 2; ++cg) { mrun[cg] = NEGF; lrun[cg] = 0.f;
#pragma unroll
                        for (int dt = 0; dt < 4; ++dt) o[cg][dt] = (f32x4){0.f, 0.f, 0.f, 0.f}; }
                    moba_block<2, false>(l3, 0, 4, qf, qrow, o, mrun, lrun, g, li);
#pragma unroll
                    for (int cg = 0; cg < 2; ++cg) {
                        float l = lrun[cg]; l += __shfl_xor(l, 16); l += __shfl_xor(l, 32);
                        if (vals[cg]) {
                            unsigned char* sp = PART + (((size_t)bh * 8192 + gqs[cg]) * 3 + rs[cg]) * MP_PSTR;
#pragma unroll
                            for (int dt = 0; dt < 4; ++dt) { u32x2 w; w.x = pk2(o[cg][dt][0], o[cg][dt][1]); w.y = pk2(o[cg][dt][2], o[cg][dt][3]); *(u32x2*)(sp + (16 * dt + 4 * g) * 2) = w; }
                            if (g == 0) *(float2*)(sp + 128) = make_float2(mrun[cg], l);
                        }
                    }
                } else {
                    const int ei = gi * 16 + li;
                    const bool valid = ei < cnt;
                    const unsigned ent = listL[valid ? ei : gi * 16];
                    const int gq = (int)(ent & 8191u), r = (int)(ent >> 13);
                    bf16x8_t qg[1][2];
#pragma unroll
                    for (int ks = 0; ks < 2; ++ks) qg[0][ks] = ld8(QA + ((size_t)b * S + gq) * 512 + h * 64 + 32 * ks + 8 * g);
                    f32x4 o[1][4]; float mg[1] = {NEGF}, lg_[1] = {0.f}; int qrow1[1] = {0};
#pragma unroll
                    for (int dt = 0; dt < 4; ++dt) o[0][dt] = (f32x4){0.f, 0.f, 0.f, 0.f};
                    moba_block<1, false>(l3, 0, 4, qg, qrow1, o, mg, lg_, g, li);
                    float l = lg_[0]; l += __shfl_xor(l, 16); l += __shfl_xor(l, 32);
                    if (valid) {
                        unsigned char* sp = PART + (((size_t)bh * 8192 + gq) * 3 + r) * MP_PSTR;
#pragma unroll
                        for (int dt = 0; dt < 4; ++dt) { u32x2 w; w.x = pk2(o[0][dt][0], o[0][dt][1]); w.y = pk2(o[0][dt][2], o[0][dt][3]); *(u32x2*)(sp + (16 * dt + 4 * g) * 2) = w; }
                        if (g == 0) *(float2*)(sp + 128) = make_float2(mg[0], l);
                    }
                }
            }
        }
    }
    __syncthreads();
}
__device__ __forceinline__ void ph_moba_merge(bf16_t* YA, const bf16_t* OWNO, const float* OWNML, const unsigned* SEL, const unsigned char* PART, unsigned gtid, unsigned gthreads) {
#pragma unroll 1
    for (unsigned w = gtid; w < 16u * 8192u * 4u; w += gthreads) {
        const unsigned dt = w & 3u, idx = w >> 2;
        const unsigned bh = idx >> 13, gq = idx & 8191u, b = bh >> 3, h = bh & 7u;
        const unsigned sw_ = SEL[idx];
        const float2 oml = *(const float2*)(OWNML + 2 * (size_t)idx);
        float m[3], l[3];
#pragma unroll
        for (int r = 0; r < 3; ++r) {
            const bool val = ((sw_ >> (8 * r)) & 255u) < 64u;
            const unsigned char* sp = PART + ((size_t)idx * 3 + r) * MP_PSTR;
            m[r] = val ? *(const float*)(sp + 128) : NEGF; l[r] = val ? *(const float*)(sp + 132) : 0.f;
        }
        const float mn = fmaxf(fmaxf(oml.x, m[0]), fmaxf(m[1], m[2]));
        const float a0 = __builtin_amdgcn_exp2f(oml.x - mn);
        float ar[3];
#pragma unroll
        for (int r = 0; r < 3; ++r) ar[r] = (l[r] > 0.f) ? __builtin_amdgcn_exp2f(m[r] - mn) : 0.f;
        const float inv = 1.0f / (oml.y * a0 + l[0] * ar[0] + l[1] * ar[1] + l[2] * ar[2]);
        float acc[16];
        {
            const u32x4 x0 = *(const u32x4*)(OWNO + (size_t)idx * 64 + 16 * dt), x1 = *(const u32x4*)(OWNO + (size_t)idx * 64 + 16 * dt + 8);
            const unsigned xs[8] = {x0.x, x0.y, x0.z, x0.w, x1.x, x1.y, x1.z, x1.w};
#pragma unroll
            for (int e = 0; e < 8; ++e) { acc[2 * e] = __uint_as_float(xs[e] << 16) * a0; acc[2 * e + 1] = __uint_as_float(xs[e] & 0xffff0000u) * a0; }
        }
#pragma unroll
        for (int r = 0; r < 3; ++r) {
            if (ar[r] > 0.f) {
                const unsigned char* sp = PART + ((size_t)idx * 3 + r) * MP_PSTR + dt * 32;
#pragma unroll
                for (int e2 = 0; e2 < 4; ++e2) {
                    const u32x2 xw = *(const u32x2*)(sp + 8 * e2);
                    acc[4 * e2] += __uint_as_float(xw.x << 16) * ar[r]; acc[4 * e2 + 1] += __uint_as_float(xw.x & 0xffff0000u) * ar[r];
                    acc[4 * e2 + 2] += __uint_as_float(xw.y << 16) * ar[r]; acc[4 * e2 + 3] += __uint_as_float(xw.y & 0xffff0000u) * ar[r];
                }
            }
        }
        u32x4 y0, y1;
        y0.x = pk2(acc[0] * inv, acc[1] * inv); y0.y = pk2(acc[2] * inv, acc[3] * inv); y0.z = pk2(acc[4] * inv, acc[5] * inv); y0.w = pk2(acc[6] * inv, acc[7] * inv);
        y1.x = pk2(acc[8] * inv, acc[9] * inv); y1.y = pk2(acc[10] * inv, acc[11] * inv); y1.z = pk2(acc[12] * inv, acc[13] * inv); y1.w = pk2(acc[14] * inv, acc[15] * inv);
        bf16_t* yp = YA + ((size_t)b * S + gq) * 512 + h * 64 + 16 * dt;
        *(u32x4*)yp = y0; *(u32x4*)(yp + 8) = y1;
    }
}
#define XB_TMO      128
#define XB_XCNT(j)  (256  + 64 * (j))
#define XB_XSUB(j)  (1280 + 64 * (j))
#define XB_XGEN(j)  (2304 + 64 * (j))
#define XB_TOP      3328
#define XB_TOPGEN   3392
#define XCD_BAR_WORDS 3456
#define XB_SPIN_CAP (1u << 24)
__device__ __forceinline__ unsigned xb_ld(unsigned* p)              { return __hip_atomic_load(p, __ATOMIC_RELAXED, __HIP_MEMORY_SCOPE_AGENT); }
__device__ __forceinline__ unsigned xb_add(unsigned* p, unsigned v) { return __hip_atomic_fetch_add(p, v, __ATOMIC_RELAXED, __HIP_MEMORY_SCOPE_AGENT); }
__device__ __forceinline__ unsigned xb_xcc_id() { return (unsigned)__builtin_amdgcn_s_getreg((3 << 11) | 20) & 0xFu; }
#define XB_SPIN(cond, bar) do { unsigned _sp = 0; while (cond) { __builtin_amdgcn_s_sleep(1); \
    if ((++_sp & 255u) == 0u) { if (xb_ld(&(bar)[XB_TMO])) break; if (_sp > XB_SPIN_CAP) { atomicAdd(&(bar)[XB_TMO], 1u); break; } } } } while (0)
struct XcdBarrier { unsigned* bar; unsigned x; volatile LAS unsigned* st; };
__device__ __forceinline__ XcdBarrier xcd_barrier_post(unsigned* bar, volatile LAS unsigned* st) {
    XcdBarrier b; b.bar = bar; b.x = xb_xcc_id(); b.st = st;
    if (threadIdx.x == 0) (void)xb_add(&bar[XB_XCNT(b.x)], 1u);
    return b;
}
__device__ __forceinline__ void xcd_barrier_complete(unsigned* bar, unsigned x, unsigned& nloc, unsigned& nx) {
    const unsigned G = gridDim.x * gridDim.y * gridDim.z;
    unsigned sum, cnt, mine, sp = 0u;
    for (;;) {
        sum = 0u; cnt = 0u; mine = 0u;
#pragma unroll
        for (unsigned j = 0; j < 16; ++j) { const unsigned c = xb_ld(&bar[XB_XCNT(j)]); sum += c; cnt += (c > 0u) ? 1u : 0u; mine = (j == x) ? c : mine; }
        if (sum == G) break;
        __builtin_amdgcn_s_sleep(1);
        if ((++sp & 255u) == 0u) { if (xb_ld(&bar[XB_TMO])) break; if (sp > XB_SPIN_CAP) { atomicAdd(&bar[XB_TMO], 1u); break; } }
    }
    nloc = mine > 0u ? mine : 1u; nx = cnt > 0u ? cnt : 1u;
}
__device__ __forceinline__ void xcd_barrier(const XcdBarrier& b) {
    asm volatile("s_waitcnt vmcnt(0)" ::: "memory");
    __syncthreads();
    if (threadIdx.x == 0) {
        unsigned* bar = b.bar;
        __builtin_amdgcn_s_waitcnt(0);
        unsigned nloc = b.st[0], nx = b.st[1];
        if (nloc == 0u) { xcd_barrier_complete(bar, b.x, nloc, nx); b.st[0] = nloc; b.st[1] = nx; }
        const unsigned old = xb_add(&bar[XB_XSUB(b.x)], 1u);
        const unsigned gen = old / nloc;
        if (old + 1u == (gen + 1u) * nloc) {
            __builtin_amdgcn_fence(__ATOMIC_RELEASE, "agent");
            asm volatile("s_waitcnt vmcnt(0)" ::: "memory");
            const unsigned og = xb_add(&bar[XB_TOP], 1u);
            const unsigned tg = og / nx;
            if (og + 1u == (tg + 1u) * nx) xb_add(&bar[XB_TOPGEN], 1u);
            else XB_SPIN(xb_ld(&bar[XB_TOPGEN]) == tg, bar);
            __builtin_amdgcn_fence(__ATOMIC_ACQUIRE, "agent");
            xb_add(&bar[XB_XGEN(b.x)], 1u);
            asm volatile("s_waitcnt vmcnt(0)" ::: "memory");
        } else {
            XB_SPIN(xb_ld(&bar[XB_XGEN(b.x)]) == gen, bar);
            __builtin_amdgcn_fence(__ATOMIC_ACQUIRE, "agent");
            asm volatile("s_waitcnt vmcnt(0)" ::: "memory");
        }
    }
    __syncthreads();
}

constexpr int LDS_BYTES = 147456;
constexpr int RING_BYTES = 131072;
constexpr int MISC_OFF = 147200;
struct Params {
    const float* in[13];
    float* out;
    unsigned char* ws;
};
typedef const __attribute__((address_space(4))) unsigned char* kargp_t;
__device__ __forceinline__ unsigned char* karg(int byte_off) {
    kargp_t k = (kargp_t)__builtin_amdgcn_kernarg_segment_ptr();
    asm volatile("" : "+s"(k));
    return *(unsigned char* const __attribute__((address_space(4)))*)(k + byte_off);
}
#define WSB() (karg(112))
__device__ __forceinline__ int launder_s(int v) { asm volatile("" : "+s"(v)); return v; }
#define GRIDX() launder_s((int)gridDim.x)
#define BLKX() launder_s((int)blockIdx.x)
#define INP(i) ((const float*)karg(8 * (i)))
#define OUTP() ((float*)karg(104))
#define GSYNC() do { XcdBarrier bar_; bar_.bar = (unsigned*)WSB() + 4096; bar_.x = xb_xcc_id(); bar_.st = (volatile LAS unsigned*)((LAS unsigned char*)lds + MISC_OFF) + 8; xcd_barrier(bar_); } while (0)
extern __shared__ __attribute__((aligned(16))) unsigned char lds[];
#define L3 ((LAS unsigned char*)lds)
#define LANE ((int)(tidx() & 63))
#define WAVE (__builtin_amdgcn_readfirstlane((int)(tidx() >> 6)))
#define GTID ((size_t)bidx() * 512 + tidx())
#define GTHREADS ((size_t)gdim() * 512)
__device__ __forceinline__ void prologue_body() {
    {
        unsigned char* ws = WSB();
        const int lane = LANE, wave = WAVE;
        const int gw = bidx() * 8 + wave, NGW = gdim() * 8;
        LAS float* scr = (LAS float*)(L3 + wave * 16384);
        constexpr int I_IN = (D / 64) * (INW / 32), I_MO = (512 / 64) * (D / 32), I_RO = (D / 64) * (D / 32), I_O = I_RO, I_Q = (D / 64) * (2048 / 32);
        constexpr int PER_L = I_IN + I_MO + I_RO + I_O + I_Q;
        for (int it = gw; it < 2 * PER_L; it += NGW) {
            const int l = it / PER_L; int r = it % PER_L;
            if (r < I_IN) { p0_transpose_item<true>(INP(1) + (size_t)l * D * INW, D, INW, (bf16_t*)(ws + WS_WIN) + (size_t)l * WIN_ROWS * D, scr, r, lane); continue; } r -= I_IN;
            if (r < I_MO) { p0_transpose_item<false>(INP(2) + (size_t)l * 512 * D, 512, D, (bf16_t*)(ws + WS_WMO) + (size_t)l * D * 512, scr, r, lane); continue; } r -= I_MO;
            if (r < I_RO) { p0_transpose_item<false>(INP(3) + (size_t)l * D * D, D, D, (bf16_t*)(ws + WS_WRO) + (size_t)l * D * D, scr, r, lane); continue; } r -= I_RO;
            if (r < I_O) { p0_transpose_item<false>(INP(4) + (size_t)l * D * D, D, D, (bf16_t*)(ws + WS_WO) + (size_t)l * D * D, scr, r, lane); continue; } r -= I_O;
            p0_transpose_item<false>(INP(7) + (size_t)l * D * 2048, D, 2048, (bf16_t*)(ws + WS_WQ) + (size_t)l * 2048 * D, scr, r, lane, INP(5) + l * D);
        }
        Tables tb; tb.qdec = (float*)(ws + WS_TBL); tb.kdec = tb.qdec + 1024; tb.ropeA = (float*)(ws + WS_ROPEA); tb.ropeR = (float*)(ws + WS_ROPER); tb.ropeRT = (float*)(ws + WS_ROPERT);
        cvt_copy(INP(8), (bf16_t*)(ws + WS_KEYS), (size_t)2 * 2 * PNK * PKD, GTID, GTHREADS);
        p0_csum_part(INP(7), INP(5), INP(6), (float*)(ws + WS_TBL + TB_PARTC), (float*)(ws + WS_TBL + TB_PARTB));
        __syncthreads();
        p0_tables(tb, GTID, GTHREADS, (LAS float*)L3);
        cvt_copy(INP(0), (bf16_t*)(ws + WS_XB), (size_t)T * D, GTID, GTHREADS);
    }
}
template <int l> __device__ __forceinline__ void layer_body() {
        {
            unsigned char* ws = WSB();
            pg8::Gemm g{(bf16_t*)(ws + WS_XB), (bf16_t*)(ws + WS_WIN) + (size_t)l * WIN_ROWS * D, T, WIN_NROWS, D}; pg8::StaticOrder So; So.init(T, WIN_NROWS, GRIDX(), BLKX());
            EpiProjAll E{ws};
            pg8::gemm_phase<EpiProjAll, pg8::StaticOrder, true, true>(L3, g, So, E);
        }
        {
            unsigned char* ws = WSB();
            pg8::Gemm g{(bf16_t*)(ws + WS_WIN) + ((size_t)l * WIN_ROWS + WIN_NROWS) * D, (bf16_t*)(ws + WS_XB), WIN_SROWS, T, D}; pg8::StaticOrder So; So.init(WIN_SROWS, T, GRIDX(), BLKX());
            EpiProjS E{ws};
            pg8::gemm_phase<EpiProjS, pg8::StaticOrder, true, true>(L3, g, So, E);
        }
        GSYNC();
        {
            unsigned char* ws = WSB();
            if (l == 0) p0_csum_reduce((const float*)(ws + WS_TBL + TB_PARTC), (const float*)(ws + WS_TBL + TB_PARTB), (float*)(ws + WS_TBL + TB_CSUM), (float*)(ws + WS_TBL + TB_BQ));
            ph_moba_own((const bf16_t*)(ws + WS_QA), (const bf16_t*)(ws + WS_KA), (const bf16_t*)(ws + WS_VAT), (const float*)(ws + WS_KMP), L3, (unsigned*)(ws + WS_MSEL), (bf16_t*)(ws + WS_MOWNO), (float*)(ws + WS_MOWNML));
            ph_retkv((const bf16_t*)(ws + WS_VRT), (const bf16_t*)(ws + WS_KRT), (float*)(ws + WS_KVT), L3);
        }
        GSYNC();
        { unsigned char* ws = WSB(); ph_moba_past((const bf16_t*)(ws + WS_QA), (const bf16_t*)(ws + WS_KA), (const bf16_t*)(ws + WS_VAT), (const unsigned*)(ws + WS_MSEL), ws + WS_MPART, L3); }
        { unsigned char* ws = WSB(); ph_retscan((const float*)(ws + WS_KVT), (bf16_t*)(ws + WS_PREVT));
          ph_kc_kb(INP(8) + (size_t)l * 2 * PNK * PKD, (const float*)(ws + WS_TBL + TB_CSUM) + l * 2048, (const float*)(ws + WS_TBL + TB_BQ) + l * 2048, (float*)(ws + WS_TBL + TB_KC), (float*)(ws + WS_TBL + TB_KB)); }
        GSYNC();
        { unsigned char* ws = WSB(); ph_retout((const bf16_t*)(ws + WS_QR), (const bf16_t*)(ws + WS_KR), (const bf16_t*)(ws + WS_VRT), (const bf16_t*)(ws + WS_PREVT), (const bf16_t*)(ws + WS_GR), (bf16_t*)(ws + WS_YR), L3); }
        { unsigned char* ws = WSB(); ph_moba_merge((bf16_t*)(ws + WS_QA), (const bf16_t*)(ws + WS_MOWNO), (const float*)(ws + WS_MOWNML), (const unsigned*)(ws + WS_MSEL), ws + WS_MPART, GTID, GTHREADS); }
        GSYNC();
        {
            unsigned char* ws = WSB();
            pg8::Gemm g{(bf16_t*)(ws + WS_QA), (bf16_t*)(ws + WS_WMO) + (size_t)l * D * 512, T, D, 512}; pg8::StaticOrder So; So.init(T, D, GRIDX(), BLKX());
            EpiBranchA E{(const bf16_t*)(ws + WS_GA), (bf16_t*)(ws + WS_MERGED)};
            pg8::gemm_phase<EpiBranchA, pg8::StaticOrder, true, true>(L3, g, So, E);
        }
        {
            unsigned char* ws = WSB();
            pg8::Gemm g{(bf16_t*)(ws + WS_YR), (bf16_t*)(ws + WS_WRO) + (size_t)l * D * D, T, D, D}; pg8::StaticOrder So; So.init(T, D, GRIDX(), BLKX());
            EpiBranchR E{(const bf16_t*)(ws + WS_GRT), (bf16_t*)(ws + WS_MERGED)};
            pg8::gemm_phase<EpiBranchR, pg8::StaticOrder, true, true>(L3, g, So, E);
        }
        GSYNC();
        {
            unsigned char* ws = WSB();
            pg8::Gemm g{(bf16_t*)(ws + WS_MERGED), (bf16_t*)(ws + WS_WO) + (size_t)l * D * D, T, D, D}; pg8::StaticOrder So; So.init(T, D, GRIDX(), BLKX());
            EpiMix E{(l == 0) ? INP(0) : (const float*)OUTP(), (float*)(ws + WS_X1), (bf16_t*)(ws + WS_XB), (float*)(ws + WS_STAT)};
            pg8::gemm_phase<EpiMix, pg8::StaticOrder, true, true>(L3, g, So, E);
        }
        GSYNC();
        {
            unsigned char* ws = WSB();
            pg8::Gemm g{(bf16_t*)(ws + WS_XB), (bf16_t*)(ws + WS_WQ) + (size_t)l * 2048 * D, T, 2048, D}; pg8::StaticOrder So; So.init(T, 2048, GRIDX(), BLKX());
            EpiPlain E{(bf16_t*)(ws + WS_PQ), 2048};
            pg8::gemm_phase<EpiPlain, pg8::StaticOrder, true, true>(L3, g, So, E);
        }
        GSYNC();
        { unsigned char* ws = WSB(); ph_peer_topk((const bf16_t*)(ws + WS_PQ), (const bf16_t*)(ws + WS_KEYS) + (size_t)l * 2 * PNK * PKD, (int*)(ws + WS_PIDX), (float*)(ws + WS_PW), L3,
                                                 (const float*)(ws + WS_STAT), (const float*)(ws + WS_TBL + TB_KC), (const float*)(ws + WS_TBL + TB_KB), (float*)(ws + WS_TBL + TB_RS),
                                                 INP(9) + (size_t)l * NEXP * D, INP(10) + (size_t)l * NEXP * D, ws + WS_TABU, ws + WS_TABV, (float*)(ws + WS_SINV)); }
        GSYNC();
        { unsigned char* ws = WSB(); ph_peer_gather((const float*)(ws + WS_X1), (const int*)(ws + WS_PIDX), (const float*)(ws + WS_PW), (const unsigned char*)(ws + WS_TABU), (const unsigned char*)(ws + WS_TABV), (const float*)(ws + WS_SINV),
                                                   INP(11) + l * D, INP(12) + l * D, (l == 1) ? OUTP() : (float*)nullptr, (bf16_t*)(ws + WS_XB), L3, (const float*)(ws + WS_TBL + TB_RS), INP(5) + l * D, INP(6) + l * D); }
        GSYNC();
}
__global__ void __launch_bounds__(512, 2) mega(Params P) {
    {
        volatile LAS unsigned* MISC = (volatile LAS unsigned*)((LAS unsigned char*)lds + MISC_OFF);
        for (int u = threadIdx.x; u < 64; u += blockDim.x) MISC[u] = 0u;
        __syncthreads();
        (void)xcd_barrier_post((unsigned*)WSB() + 4096, MISC + 8);
    }
    prologue_body();
    GSYNC();

    layer_body<0>();
    layer_body<1>();
}

extern "C" void kernel_launch(void* const* d_in, const int* in_sizes, int n_in, void* d_out, int out_size, void* d_ws, size_t ws_size,
                              hipStream_t stream) {
    static int grid = 0;
    if (grid == 0) {
        if (ws_size < WS_END) { fprintf(stderr, "kernel_launch: workspace too small: need %zu, have %zu\n", (size_t)WS_END, ws_size); grid = -1; return; }
        int dev = 0, cus = 0, per_cu = 0;
        (void)hipGetDevice(&dev);
        (void)hipDeviceGetAttribute(&cus, hipDeviceAttributeMultiprocessorCount, dev);
        (void)hipFuncSetAttribute((const void*)mega, hipFuncAttributeMaxDynamicSharedMemorySize, LDS_BYTES);
        (void)hipOccupancyMaxActiveBlocksPerMultiprocessor(&per_cu, (const void*)mega, 512, LDS_BYTES);
        if (per_cu < 1) { fprintf(stderr, "occupancy query says %d blocks per CU\n", per_cu); per_cu = 1; }
        grid = cus * per_cu;
        (void)hipGetLastError();
    }
    if (grid < 0) return;
    (void)hipMemsetAsync(d_ws, 0, CTL_BYTES, stream);
    Params p{};
    for (int i = 0; i < 13; ++i) p.in[i] = (const float*)d_in[i];
    p.out = (float*)d_out; p.ws = (unsigned char*)d_ws;
    void* args[] = {&p};
    hipError_t e = hipLaunchCooperativeKernel((const void*)mega, dim3(grid), dim3(512), args, LDS_BYTES, stream);
    if (e != hipSuccess) fprintf(stderr, "cooperative launch failed: %s (grid %d)\n", hipGetErrorString(e), grid);
}
```

```cpp
#include <hip/hip_runtime.h>
#include <cstdint>
#include <cstdio>

constexpr int D = 1024, NB = 2, S = 8192, T = NB * S;
constexpr int INW = 6656;
constexpr int OFF_QA = 0, OFF_KA = 512, OFF_VA = 1024, OFF_QR = 1536, OFF_KR = 2048, OFF_VR = 2560,
              OFF_GR = 3584, OFF_GA = 4608, OFF_GRT = 5632;
constexpr int MH = 8, MD = 64, MBLK = 256, MNB = S / MBLK;
constexpr int RH = 4, RDK = 128, RDV = 256, RC = 256, RNC = S / RC;
constexpr int PH = 8, PK = 16, PNK = 128, PKD = 128;
constexpr int NEXP = 16384;
constexpr float LN_EPS = 1e-5f;
constexpr float DN_ALPHA = 1.4142135623730951f;
constexpr float NEGF = -1e30f;
constexpr int WIN_ROWS = 7168, WIN_NROWS = 5120, WIN_SROWS = 2048;

#define LAS __attribute__((address_space(3)))
typedef unsigned short bf16_t;
typedef float f32x4 __attribute__((ext_vector_type(4)));
typedef unsigned u32x4 __attribute__((ext_vector_type(4)));
typedef unsigned u32x2 __attribute__((ext_vector_type(2)));

constexpr size_t MiB = 1u << 20;
constexpr size_t WS_CTL = 0, CTL_BYTES = 65536;
constexpr size_t WS_WIN = 1 * MiB, WIN_LSTRIDE = (size_t)WIN_ROWS * D * 2;
constexpr size_t WS_WMO = 29 * MiB, WS_WRO = 31 * MiB, WS_WO = 35 * MiB, WS_WQ = 39 * MiB;
constexpr size_t WS_KEYS = 47 * MiB, WS_TBL = 48 * MiB, WS_ROPEA = 49 * MiB, WS_ROPER = 51 * MiB, WS_ROPERT = 55 * MiB, WS_KMP = 59 * MiB;
constexpr size_t WS_XB = 60 * MiB;
constexpr size_t WS_QA = 92 * MiB, WS_KA = 108 * MiB, WS_VAT = 124 * MiB, WS_QR = 140 * MiB, WS_PQ = WS_QA;
constexpr size_t WS_KR = 156 * MiB, WS_KRT = 172 * MiB;
constexpr size_t WS_VRT = 188 * MiB, WS_MERGED = WS_VRT;
constexpr size_t WS_GR = 220 * MiB, WS_GA = 252 * MiB, WS_GRT = 284 * MiB;
constexpr size_t WS_KVT = 316 * MiB, WS_YR = WS_KVT, WS_PIDX = WS_KVT, WS_PW = WS_KVT + 8 * MiB;
constexpr size_t WS_PREVT = 348 * MiB;
constexpr size_t WS_X1 = 364 * MiB;
constexpr size_t WS_MPART = WS_X1, WS_MOWNO = 428 * MiB, WS_MOWNML = 444 * MiB, WS_MSEL = 446 * MiB;
constexpr size_t WS_TABU = 428 * MiB, WS_TABV = 444 * MiB, WS_SINV = 460 * MiB;
constexpr size_t WS_STAT = 462 * MiB;
constexpr size_t WS_END = 464 * MiB;
constexpr size_t TB_CSUM = 16384, TB_BQ = 32768, TB_KC = 49152, TB_KB = 65536, TB_RS = 131072, TB_PARTC = 524288, TB_PARTB = 786432;

__device__ __forceinline__ float bf2f(bf16_t b) { return __uint_as_float(((unsigned)b) << 16); }
__device__ __forceinline__ unsigned f2bf(float f) { const unsigned u = __float_as_uint(f); return (u + 0x7fffu + ((u >> 16) & 1u)) >> 16; }
__device__ __forceinline__ unsigned pk2(float lo, float hi) { return f2bf(lo) | (f2bf(hi) << 16); }
__device__ __forceinline__ float wave_sum(float v) {
#pragma unroll
    for (int o = 32; o >= 1; o >>= 1) v += __shfl_xor(v, o);
    return v;
}
__device__ __forceinline__ float ret_logg(int h) { return (float)log(1.0 - exp2(-5.0 - (double)h)); }
__device__ __forceinline__ float gelu_tanh(float x) { return 0.5f * x * (1.0f + tanhf(0.7978845608028654f * (x + 0.044715f * x * x * x))); }
__device__ __forceinline__ float sigmoidf_(float x) { return __builtin_amdgcn_rcpf(1.0f + __expf(-x)); }
__device__ __forceinline__ unsigned tidx() { unsigned t = threadIdx.x; asm volatile("" : "+v"(t)); return t; }
__device__ __forceinline__ unsigned bidx() { unsigned t = blockIdx.x; asm volatile("" : "+s"(t)); return t; }
__device__ __forceinline__ unsigned gdim() { unsigned t = gridDim.x; asm volatile("" : "+s"(t)); return t; }
namespace pg8 {
#define PG8_LAS __attribute__((address_space(3)))
typedef unsigned short bf16_t;
typedef short bf16x8 __attribute__((ext_vector_type(8)));
typedef float f32x4 __attribute__((ext_vector_type(4)));
typedef unsigned u32x4 __attribute__((ext_vector_type(4)));
constexpr int BM = 256, BK = 64, HALF = 128, HTB = HALF * BK * 2  , STAGE_BYTES = 8 * HTB, NXCD = 8, WGM = 8;

__host__ __device__ __forceinline__ int lds_byte(int r, int c) { const int st = (r >> 4) * 2 + (c >> 5), rr = r & 15, cc = c & 31, ob = rr * 64 + cc * 2; return st * 1024 + (ob ^ (((ob >> 9) & 1) << 5)); }
__host__ __device__ __forceinline__ void stage_rc(int b, int& R, int& C) { const int st = b / 1024, sb = b % 1024, swz = sb ^ (((sb >> 9) & 1) << 5); R = (st >> 1) * 16 + swz / 64; C = (st & 1) * 32 + (swz % 64) / 2; }
__host__ __device__ __forceinline__ int perm32(int rho) { const int n = rho >> 4, i = rho & 15; return 8 * (i >> 2) + 4 * n + (i & 3); }

struct Unit { int pm, pn; };
struct Gemm { const bf16_t* A; const bf16_t* Bt; int M, N, K; };

struct StaticOrder {
    int nM, nN, nwg, G, c;
    __host__ __device__ void init(int M, int N, int G_, int c_) { nM = M / BM; nN = N / BM; nwg = nM * nN; G = G_; c = c_; }
    __host__ __device__ bool next(int i, Unit& u) const {
        const long L = (long)i * G + c; if (L >= nwg) return false;
        int wgid = (int)L; { const int q = nwg / NXCD, r = nwg % NXCD, xcd = wgid % NXCD, off = wgid / NXCD; wgid = (xcd < r ? xcd * (q + 1) : r * (q + 1) + (xcd - r) * q) + off; }
        const int nig = WGM * nN, gid = wgid / nig, fm = gid * WGM, gsz = (nM - fm) < WGM ? (nM - fm) : WGM;
        u.pm = fm + ((wgid % nig) % gsz); u.pn = (wgid % nig) / gsz; return true;
    }
    __device__ __forceinline__ void a_ready(const Unit&) const {}
    __device__ __forceinline__ void done(const Unit&) const {}
};

__device__ __forceinline__ unsigned cvt_pk_bf16(float lo, float hi) { unsigned r; asm volatile("v_cvt_pk_bf16_f32 %0, %1, %2" : "=v"(r) : "v"(lo), "v"(hi)); return r; }
typedef float f32x2 __attribute__((ext_vector_type(2)));
template <class Epi, class Sched, bool ALIGN_EPI = false, bool SP2 = false>
__device__ __forceinline__ void gemm_phase(PG8_LAS unsigned char* lds, const Gemm g, const Sched& S, const Epi& E) {
    int tid_ = threadIdx.x; asm volatile("" : "+v"(tid_));
    const int tid = tid_, wid = __builtin_amdgcn_readfirstlane(tid >> 6), lane = tid & 63, wr = wid >> 2, wc = wid & 3, fr = lane & 15, fq = lane >> 4;
    const int K = g.K, nt = K / BK;
    unsigned voffA[2], voffB[2];
#pragma unroll
    for (int i = 0; i < 2; ++i) { int R, C; stage_rc(tid * 16 + i * 8192, R, C); const int Rb = Epi::PERM ? ((R & ~31) + perm32(R & 31)) : R;
        voffA[i] = (unsigned)(R * K + C) * 2u; voffB[i] = (unsigned)(Rb * K + C) * 2u; }
    const size_t kstep = (size_t)(BK * 2);
    const size_t hstep = (size_t)HALF * K * 2;
    const size_t tstep = 2 * hstep;
    const unsigned ldsw = (unsigned)wid * 1024u;
    const int aoff = lds_byte(wr * 64 + fr, fq * 8), boff = lds_byte(wc * 32 + fr, fq * 8);
#define PG8_SA(b, h) (((b) * 2 + (h)) * HTB)
#define PG8_SB(b, h) ((4 + (b) * 2 + (h)) * HTB)
#define PG8_STAGE(bufoff, gbase, voff) do { _Pragma("unroll") for (int _i = 0; _i < 2; ++_i) \
        __builtin_amdgcn_global_load_lds((const unsigned*)((const char*)(gbase) + (voff)[_i]), (PG8_LAS unsigned*)(lds + (bufoff) + ldsw + _i * 8192), 16, 0, 0); } while (0)
#define PG8_LDA(dst, b, h) do { _Pragma("unroll") for (int m = 0; m < 4; ++m) _Pragma("unroll") for (int k = 0; k < 2; ++k) dst[m][k] = *(const PG8_LAS bf16x8*)(lds + PG8_SA(b, h) + aoff + m * 2048 + k * 1024); } while (0)
#define PG8_LDB(dst, b, h) do { _Pragma("unroll") for (int n = 0; n < 2; ++n) _Pragma("unroll") for (int k = 0; k < 2; ++k) dst[n][k] = *(const PG8_LAS bf16x8*)(lds + PG8_SB(b, h) + boff + n * 2048 + k * 1024); } while (0)
#define PG8_MMA(ai, bj, At, Bt) do { __builtin_amdgcn_s_setprio(1); _Pragma("unroll") for (int m = 0; m < 4; ++m) _Pragma("unroll") for (int n = 0; n < 2; ++n) _Pragma("unroll") for (int k = 0; k < 2; ++k) \
        acc[ai][bj][m][n] = __builtin_amdgcn_mfma_f32_16x16x32_bf16(Bt[n][k], At[m][k], acc[ai][bj][m][n], 0, 0, 0); __builtin_amdgcn_s_setprio(0); } while (0)
#define PG8_WAIT_V(n) asm volatile("s_waitcnt vmcnt(" #n ")" ::: "memory")
#define PG8_WAIT_L(n) asm volatile("s_waitcnt lgkmcnt(" #n ")" ::: "memory")
#define PG8_BAR __builtin_amdgcn_s_barrier()
#define PG8_SCHED __builtin_amdgcn_sched_barrier(0)
    Unit cur, nxt; int ui = 0;
    if (!S.next(0, cur)) return;
    f32x4 acc[2][2][4][2];
#pragma unroll
    for (int a = 0; a < 2; ++a)
#pragma unroll
        for (int b = 0; b < 2; ++b)
#pragma unroll
            for (int m = 0; m < 4; ++m)
#pragma unroll
                for (int n = 0; n < 2; ++n) acc[a][b][m][n] = (f32x4){0.f, 0.f, 0.f, 0.f};
    bf16x8 At[4][2], B0[2][2], B1[2][2];
    const char* cA = (const char*)g.A + (size_t)cur.pm * tstep; const char* cB = (const char*)g.Bt + (size_t)cur.pn * tstep;
    S.a_ready(cur);
    if constexpr (SP2) {
        PG8_STAGE(PG8_SB(0, 0), cB, voffB); PG8_STAGE(PG8_SB(0, 1), cB + hstep, voffB); PG8_STAGE(PG8_SA(0, 0), cA, voffA); PG8_STAGE(PG8_SA(0, 1), cA + hstep, voffA);
        if (wr == 1) PG8_BAR;
        PG8_WAIT_V(2); PG8_BAR;
        PG8_STAGE(PG8_SB(1, 0), cB + kstep, voffB); PG8_STAGE(PG8_SA(1, 0), cA + kstep, voffA); PG8_STAGE(PG8_SB(1, 1), cB + hstep + kstep, voffB);
        PG8_WAIT_V(6); PG8_BAR;
    } else {
        PG8_STAGE(PG8_SB(0, 0), cB, voffB); PG8_STAGE(PG8_SA(0, 0), cA, voffA); PG8_STAGE(PG8_SB(0, 1), cB + hstep, voffB); PG8_STAGE(PG8_SA(0, 1), cA + hstep, voffA);
        if (wr == 1) PG8_BAR;
        PG8_WAIT_V(4); PG8_BAR;
        PG8_STAGE(PG8_SB(1, 0), cB + kstep, voffB); PG8_STAGE(PG8_SA(1, 0), cA + kstep, voffA); PG8_STAGE(PG8_SB(1, 1), cB + hstep + kstep, voffB);
        PG8_WAIT_V(6); PG8_BAR;
    }
    for (;;) {
        const bool has_next = S.next(ui + 1, nxt);
        const char* nA = has_next ? (const char*)g.A + (size_t)nxt.pm * tstep : cA; const char* nB = has_next ? (const char*)g.Bt + (size_t)nxt.pn * tstep : cB;
        for (int t = 0; t < nt; t += 2) {
            const bool last = (t == nt - 2);
            const char* a1 = cA + (size_t)(t + 1) * kstep;
            const char* a2 = last ? nA : cA + (size_t)(t + 2) * kstep; const char* b2 = last ? nB : cB + (size_t)(t + 2) * kstep;
            const char* a3 = a2 + kstep; const char* b3 = b2 + kstep;
            if (last && has_next) S.a_ready(nxt);
            if constexpr (SP2) {
            PG8_LDB(B0, 0, 0); PG8_LDB(B1, 0, 1); PG8_SCHED; PG8_LDA(At, 0, 0); PG8_STAGE(PG8_SA(1, 1), a1 + hstep, voffA);
            PG8_WAIT_V(8); PG8_WAIT_L(0); PG8_BAR; PG8_MMA(0, 0, At, B0); PG8_MMA(0, 1, At, B1); PG8_BAR; PG8_SCHED;
            PG8_LDA(At, 0, 1); PG8_STAGE(PG8_SB(0, 0), b2, voffB); PG8_STAGE(PG8_SB(0, 1), b2 + hstep, voffB); PG8_STAGE(PG8_SA(0, 0), a2, voffA);
            PG8_WAIT_V(8); PG8_WAIT_L(0); PG8_BAR; PG8_MMA(1, 0, At, B0); PG8_MMA(1, 1, At, B1); PG8_BAR; PG8_SCHED;
            PG8_LDB(B0, 1, 0); PG8_LDB(B1, 1, 1); PG8_SCHED; PG8_LDA(At, 1, 0); PG8_STAGE(PG8_SA(0, 1), a2 + hstep, voffA);
            PG8_WAIT_V(8); PG8_WAIT_L(0); PG8_BAR; PG8_MMA(0, 0, At, B0); PG8_MMA(0, 1, At, B1); PG8_BAR; PG8_SCHED;
            PG8_LDA(At, 1, 1); PG8_STAGE(PG8_SB(1, 0), b3, voffB); PG8_STAGE(PG8_SB(1, 1), b3 + hstep, voffB); PG8_STAGE(PG8_SA(1, 0), a3, voffA);
            PG8_WAIT_V(8); PG8_WAIT_L(0); PG8_BAR; PG8_MMA(1, 0, At, B0); PG8_MMA(1, 1, At, B1); PG8_BAR; PG8_SCHED;
            } else {
            PG8_LDB(B0, 0, 0); PG8_SCHED; PG8_LDA(At, 0, 0); PG8_STAGE(PG8_SA(1, 1), a1 + hstep, voffA);
            PG8_WAIT_L(8); PG8_BAR; PG8_WAIT_L(0); PG8_MMA(0, 0, At, B0); PG8_BAR; PG8_SCHED;
            PG8_LDB(B1, 0, 1); PG8_STAGE(PG8_SB(0, 0), b2, voffB);
            PG8_BAR; PG8_WAIT_L(0); PG8_MMA(0, 1, At, B1); PG8_BAR;
            PG8_LDA(At, 0, 1); PG8_STAGE(PG8_SA(0, 0), a2, voffA);
            PG8_BAR; PG8_WAIT_L(0); PG8_MMA(1, 0, At, B0); PG8_BAR; PG8_SCHED;
            PG8_STAGE(PG8_SB(0, 1), b2 + hstep, voffB);
            PG8_WAIT_V(6); PG8_BAR; PG8_MMA(1, 1, At, B1); PG8_BAR;
            PG8_LDB(B0, 1, 0); PG8_SCHED; PG8_LDA(At, 1, 0); PG8_STAGE(PG8_SA(0, 1), a2 + hstep, voffA);
            PG8_WAIT_L(8); PG8_BAR; PG8_WAIT_L(0); PG8_MMA(0, 0, At, B0); PG8_BAR; PG8_SCHED;
            PG8_LDB(B1, 1, 1); PG8_STAGE(PG8_SB(1, 0), b3, voffB);
            PG8_BAR; PG8_WAIT_L(0); PG8_MMA(0, 1, At, B1); PG8_BAR;
            PG8_LDA(At, 1, 1); PG8_STAGE(PG8_SA(1, 0), a3, voffA);
            PG8_BAR; PG8_WAIT_L(0); PG8_MMA(1, 0, At, B0); PG8_BAR; PG8_SCHED;
            PG8_STAGE(PG8_SB(1, 1), b3 + hstep, voffB);
            PG8_WAIT_V(6); PG8_BAR; PG8_MMA(1, 1, At, B1); PG8_BAR;
            }
        }
        if constexpr (ALIGN_EPI) { if (wr == 0) PG8_BAR; }
        if constexpr (!Epi::AFTER_DRAIN) { E(acc, cur, wr, wc, fr, fq); S.done(cur); }
        if (!has_next) break;
#pragma unroll
        for (int a = 0; a < 2; ++a)
#pragma unroll
            for (int b = 0; b < 2; ++b)
#pragma unroll
                for (int m = 0; m < 4; ++m)
#pragma unroll
                    for (int n = 0; n < 2; ++n) acc[a][b][m][n] = (f32x4){0.f, 0.f, 0.f, 0.f};
        cur = nxt; cA = nA; cB = nB; ++ui;
        if constexpr (ALIGN_EPI) { if (wr == 1) PG8_BAR; }
    }
    PG8_WAIT_V(0);
    if constexpr (!ALIGN_EPI) { if (wr == 0) PG8_BAR; }
    PG8_BAR;
    if constexpr (Epi::AFTER_DRAIN) { E.fused(acc, cur, wr, wc, fr, fq, lds, wid, lane); S.done(cur); }
#undef PG8_SA
#undef PG8_SB
#undef PG8_STAGE
#undef PG8_LDA
#undef PG8_LDB
#undef PG8_MMA
#undef PG8_WAIT_V
#undef PG8_WAIT_L
#undef PG8_BAR
#undef PG8_SCHED
}
}
using pg8::Unit;
typedef float f32x2_t __attribute__((ext_vector_type(2))); typedef __bf16 bf16x2_t __attribute__((ext_vector_type(2)));
__device__ __forceinline__ unsigned cvtpk(float lo, float hi) { f32x2_t v = {lo, hi}; bf16x2_t b = __builtin_convertvector(v, bf16x2_t); return __builtin_bit_cast(unsigned, b); }
typedef pg8::f32x4 af4;
__device__ __forceinline__ void st8bf(bf16_t* p, const float (&o)[8]) {
    u32x4 w; w.x = cvtpk(o[0], o[1]); w.y = cvtpk(o[2], o[3]); w.z = cvtpk(o[4], o[5]); w.w = cvtpk(o[6], o[7]);
    *(u32x4*)p = w;
}
__device__ __forceinline__ void rot8(const af4& v0, const af4& v1, const float4& r0, const float4& r1, float (&o)[8]) {
    o[0] = v0[0] * r0.x - v0[1] * r0.y; o[1] = v0[1] * r0.x + v0[0] * r0.y;
    o[2] = v0[2] * r0.z - v0[3] * r0.w; o[3] = v0[3] * r0.z + v0[2] * r0.w;
    o[4] = v1[0] * r1.x - v1[1] * r1.y; o[5] = v1[1] * r1.x + v1[0] * r1.y;
    o[6] = v1[2] * r1.z - v1[3] * r1.w; o[7] = v1[3] * r1.z + v1[2] * r1.w;
}

__device__ __forceinline__ void st8v(bf16_t* p, const af4& a, const af4& b) {
    u32x4 w; w.x = cvtpk(a[0], a[1]); w.y = cvtpk(a[2], a[3]); w.z = cvtpk(b[0], b[1]); w.w = cvtpk(b[2], b[3]);
    *(u32x4*)p = w;
}
__device__ __forceinline__ af4 rot4(const af4& v, const float4& r) {
    af4 o; o[0] = v[0] * r.x - v[1] * r.y; o[1] = v[1] * r.x + v[0] * r.y; o[2] = v[2] * r.z - v[3] * r.w; o[3] = v[3] * r.z + v[2] * r.w; return o;
}
__device__ __forceinline__ af4 red16(af4 v) {
#pragma unroll
    for (int e = 0; e < 4; ++e) { float x = v[e]; x += __shfl_xor(x, 1); x += __shfl_xor(x, 2); x += __shfl_xor(x, 4); x += __shfl_xor(x, 8); v[e] = x; }
    return v;
}
struct EpiMobaQK {
    static constexpr bool PERM = true, AFTER_DRAIN = false;
    unsigned char* ws;
    __device__ __forceinline__ void operator()(const af4 (&acc)[2][2][4][2], const Unit& u, int wr, int wc, int fr, int fq) const {
        const float* const ropeA = (const float*)(ws + WS_ROPEA);
        const int pn = u.pn;
        const int row0 = u.pm * 256 + wr * 64 + fr;
        const int c0 = (pn & 1) * 256 + wc * 32 + 8 * fq;
        const float* rbase = ropeA + ((c0 & 63) >> 1) * 2;
        if (pn < 2) {
            bf16_t* const QA = (bf16_t*)(ws + WS_QA);
            float4 rr[2][2];
            { const float4* rp = (const float4*)(rbase + (size_t)(row0 & (S - 1)) * 64); rr[0][0] = rp[0]; rr[0][1] = rp[1]; }
#pragma unroll
            for (int it = 0; it < 8; ++it) {
                const int ai = it >> 2, m = it & 3;
                const int row = row0 + ai * 128 + m * 16;
                if (it < 7) { const int nrow = row0 + ((it + 1) >> 2) * 128 + ((it + 1) & 3) * 16; const float4* rp = (const float4*)(rbase + (size_t)(nrow & (S - 1)) * 64); rr[(it + 1) & 1][0] = rp[0]; rr[(it + 1) & 1][1] = rp[1]; }
                asm volatile("" ::: "memory");
                const float4 r0 = rr[it & 1][0], r1 = rr[it & 1][1];
#pragma unroll
                for (int bj = 0; bj < 2; ++bj) {
                    const af4 o0 = rot4(acc[ai][bj][m][0], r0) * 0.125f, o1 = rot4(acc[ai][bj][m][1], r1) * 0.125f;
                    st8v(QA + (size_t)row * 512 + c0 + bj * 128, o0, o1);
                }
            }
        } else {
            bf16_t* const KA = (bf16_t*)(ws + WS_KA);
            af4 k00 = {0.f, 0.f, 0.f, 0.f}, k01 = k00, k10 = k00, k11 = k00;
#pragma unroll
            for (int it = 0; it < 8; ++it) {
                const int ai = it >> 2, m = it & 3;
                const int row = row0 + ai * 128 + m * 16;
                asm volatile("" ::: "memory");
                const float4* rp = (const float4*)(rbase + (size_t)(row & (S - 1)) * 64);
                const float4 r0 = rp[0], r1 = rp[1];
                const af4 a0 = rot4(acc[ai][0][m][0], r0), a1 = rot4(acc[ai][0][m][1], r1);
                const af4 b0 = rot4(acc[ai][1][m][0], r0), b1 = rot4(acc[ai][1][m][1], r1);
                k00 += a0; k01 += a1; k10 += b0; k11 += b1;
                st8v(KA + (size_t)row * 512 + c0, a0, a1);
                st8v(KA + (size_t)row * 512 + c0 + 128, b0, b1);
            }
            k00 = red16(k00); k01 = red16(k01); k10 = red16(k10); k11 = red16(k11);
            if (fr == 0) {
                float* kp = (float*)(ws + WS_KMP) + ((size_t)(u.pm * 2 + wr)) * 512 + c0;
                *(af4*)kp = k00; *(af4*)(kp + 4) = k01; *(af4*)(kp + 128) = k10; *(af4*)(kp + 132) = k11;
            }
        }
    }
};
struct EpiRetQK {
    static constexpr bool PERM = true, AFTER_DRAIN = false;
    unsigned char* ws;
    __device__ __forceinline__ void operator()(const af4 (&acc)[2][2][4][2], const Unit& u, int wr, int wc, int fr, int fq) const {
        const float* const ropeR = (const float*)(ws + WS_ROPER);
        const int pn = u.pn;
        const bool isK = pn >= 2;
        bf16_t* const dst = (bf16_t*)(ws + (isK ? WS_KR : WS_QR));
        const float* const tab = (const float*)(ws + WS_TBL) + (isK ? 1024 : 0);
        const int row0 = u.pm * 256 + wr * 64 + fr;
        const int c0 = (pn & 1) * 256 + wc * 32 + 8 * fq;
        const int h0 = c0 >> 7;
        const float* rbase = ropeR + ((c0 & 127) >> 1) * 2;
        float4 rr[2][2]; float dd[2][2];
        { const int s = row0 & (S - 1); const float4* rp = (const float4*)(rbase + (size_t)s * 128); rr[0][0] = rp[0]; rr[0][1] = rp[1]; dd[0][0] = tab[h0 * 256 + (s & 255)]; dd[0][1] = tab[(h0 + 1) * 256 + (s & 255)]; }
#pragma unroll
        for (int it = 0; it < 8; ++it) {
            const int ai = it >> 2, m = it & 3;
            const int row = row0 + ai * 128 + m * 16;
            if (it < 7) {
                const int s = (row0 + ((it + 1) >> 2) * 128 + ((it + 1) & 3) * 16) & (S - 1);
                const float4* rp = (const float4*)(rbase + (size_t)s * 128);
                rr[(it + 1) & 1][0] = rp[0]; rr[(it + 1) & 1][1] = rp[1]; dd[(it + 1) & 1][0] = tab[h0 * 256 + (s & 255)]; dd[(it + 1) & 1][1] = tab[(h0 + 1) * 256 + (s & 255)];
            }
            asm volatile("" ::: "memory");
            const float4 r0 = rr[it & 1][0], r1 = rr[it & 1][1];
#pragma unroll
            for (int bj = 0; bj < 2; ++bj) {
                const float dec = dd[it & 1][bj];
                const af4 o0 = rot4(acc[ai][bj][m][0], r0) * dec, o1 = rot4(acc[ai][bj][m][1], r1) * dec;
                st8v(dst + (size_t)row * 512 + c0 + bj * 128, o0, o1);
            }
        }
    }
};
struct EpiGates {
    static constexpr bool PERM = true, AFTER_DRAIN = false;
    unsigned char* ws;
    __device__ __forceinline__ void operator()(const af4 (&acc)[2][2][4][2], const Unit& u, int wr, int wc, int fr, int fq) const {
        const int pn = u.pn, seg = pn >> 2;
        bf16_t* const dst = (bf16_t*)(ws + (seg == 0 ? WS_GR : (seg == 1 ? WS_GA : WS_GRT)));
        const int row0 = u.pm * 256 + wr * 64 + fr;
        const int c0 = (pn & 3) * 256 + wc * 32 + 8 * fq;
#pragma unroll
        for (int ai = 0; ai < 2; ++ai)
#pragma unroll
            for (int m = 0; m < 4; ++m) {
                asm volatile("" ::: "memory");
                const int row = row0 + ai * 128 + m * 16;
#pragma unroll
                for (int bj = 0; bj < 2; ++bj) {
                    af4 o0 = acc[ai][bj][m][0], o1 = acc[ai][bj][m][1];
#pragma unroll
                    for (int e = 0; e < 4; ++e) {
                        const float s0 = sigmoidf_(o0[e]), s1 = sigmoidf_(o1[e]);
                        o0[e] = seg == 0 ? o0[e] * s0 : s0; o1[e] = seg == 0 ? o1[e] * s1 : s1;
                    }
                    if (seg == 0) st8v(dst + (size_t)row * 1024 + c0 + bj * 128, o0, o1);
                    else {
                        u32x2 w;
                        w.x = (unsigned)(o0[0] * 255.0f + 0.5f) | ((unsigned)(o0[1] * 255.0f + 0.5f) << 8) | ((unsigned)(o0[2] * 255.0f + 0.5f) << 16) | ((unsigned)(o0[3] * 255.0f + 0.5f) << 24);
                        w.y = (unsigned)(o1[0] * 255.0f + 0.5f) | ((unsigned)(o1[1] * 255.0f + 0.5f) << 8) | ((unsigned)(o1[2] * 255.0f + 0.5f) << 16) | ((unsigned)(o1[3] * 255.0f + 0.5f) << 24);
                        *(u32x2*)((unsigned char*)dst + (size_t)row * 1024 + c0 + bj * 128) = w;
                    }
                }
            }
    }
};

struct EpiProjAll {
    static constexpr bool PERM = true, AFTER_DRAIN = false;
    unsigned char* ws;
    __device__ __forceinline__ void operator()(const af4 (&acc)[2][2][4][2], const Unit& u, int wr, int wc, int fr, int fq) const {
        if (u.pn < 4) { const Unit v{u.pm, u.pn}; EpiMobaQK{ws}(acc, v, wr, wc, fr, fq); }
        else if (u.pn < 8) { const Unit v{u.pm, u.pn - 4}; EpiRetQK{ws}(acc, v, wr, wc, fr, fq); }
        else { const Unit v{u.pm, u.pn - 8}; EpiGates{ws}(acc, v, wr, wc, fr, fq); }
    }
};
struct EpiProjS {
    static constexpr bool PERM = true, AFTER_DRAIN = false;
    unsigned char* ws;
    __device__ __forceinline__ void operator()(const af4 (&acc)[2][2][4][2], const Unit& u, int wr, int wc, int fr, int fq) const {
        bf16_t* const VAT = (bf16_t*)(ws + WS_VAT); bf16_t* const VRT = (bf16_t*)(ws + WS_VRT); bf16_t* const KRT = (bf16_t*)(ws + WS_KRT);
        const float* const ropeRT = (const float*)(ws + WS_ROPERT); const float* const kdec = (const float*)(ws + WS_TBL) + 1024;
        const int pm = u.pm;
        const int f0 = pm * 256 + wr * 64 + fr;
        const int t00 = u.pn * 256 + wc * 32 + 8 * fq;
#pragma unroll
        for (int ai = 0; ai < 2; ++ai)
#pragma unroll
            for (int m = 0; m < 4; ++m) {
                asm volatile("" ::: "memory");
                const int f = f0 + ai * 128 + m * 16;
#pragma unroll
                for (int bj = 0; bj < 2; ++bj) {
                    const int t0 = t00 + bj * 128, b = t0 >> 13, s0 = t0 & (S - 1);
                    float o[8];
#pragma unroll
                    for (int e = 0; e < 4; ++e) { o[e] = acc[ai][bj][m][0][e]; o[4 + e] = acc[ai][bj][m][1][e]; }
                    if (pm < 2) {
                        const int h = f >> 6, d = f & 63;
                        st8bf(VAT + ((((size_t)(b * 8 + h) * 128 + (s0 >> 6)) * 64 + d) * 64 + (s0 & 63)), o);
                    } else if (pm < 6) {
                        const int fe = f - 512, h = fe >> 8, e2 = fe & 255;
                        st8bf(VRT + (((size_t)(b * 4 + h) * 256 + e2) * S + s0), o);
                    } else {
                        const int fk = f - 1536, h = fk >> 7, d = fk & 127, j = d >> 1;
                        const float sgn = (d & 1) ? 1.0f : -1.0f;
                        const float4* rp = (const float4*)(ropeRT + ((size_t)j * S + s0) * 2);
                        const float4* dp = (const float4*)(kdec + h * 256 + (s0 & 255));
                        const float4 r0 = rp[0], r1 = rp[1], r2 = rp[2], r3 = rp[3], d0 = dp[0], d1 = dp[1];
                        const float cs[8] = {r0.x, r0.z, r1.x, r1.z, r2.x, r2.z, r3.x, r3.z};
                        const float sn[8] = {r0.y, r0.w, r1.y, r1.w, r2.y, r2.w, r3.y, r3.w};
                        const float dc[8] = {d0.x, d0.y, d0.z, d0.w, d1.x, d1.y, d1.z, d1.w};
#pragma unroll
                        for (int e = 0; e < 8; ++e) {
                            const float part = __shfl_xor(o[e], 1);
                            o[e] = (o[e] * cs[e] + sgn * part * sn[e]) * dc[e];
                        }
                        st8bf(KRT + (((size_t)(b * 4 + h) * 128 + d) * S + s0), o);
                    }
                }
            }
    }
};

struct EpiBranchA {
    static constexpr bool PERM = true, AFTER_DRAIN = false;
    const bf16_t* GA; bf16_t* MG;
    __device__ __forceinline__ void operator()(const af4 (&acc)[2][2][4][2], const Unit& u, int wr, int wc, int fr, int fq) const {
        const int row0 = u.pm * 256 + wr * 64 + fr, col0 = u.pn * 256 + wc * 32 + 8 * fq;
#pragma unroll
        for (int ai = 0; ai < 2; ++ai)
#pragma unroll
            for (int m = 0; m < 4; ++m)
#pragma unroll
                for (int bj = 0; bj < 2; ++bj) {
                    const size_t off = (size_t)(row0 + ai * 128 + m * 16) * 1024 + col0 + bj * 128;
                    const u32x2 g = *(const u32x2*)((const unsigned char*)GA + off);
                    float o[8];
#pragma unroll
                    for (int e = 0; e < 4; ++e) { o[e] = acc[ai][bj][m][0][e]; o[4 + e] = acc[ai][bj][m][1][e]; }
#pragma unroll
                    for (int e = 0; e < 4; ++e) { o[e] *= (float)((g.x >> (8 * e)) & 255u) * (1.0f / 255.0f); o[4 + e] *= (float)((g.y >> (8 * e)) & 255u) * (1.0f / 255.0f); }
                    st8bf(MG + off, o);
                }
    }
};
struct EpiBranchR {
    static constexpr bool PERM = true, AFTER_DRAIN = false;
    const bf16_t* GRT; bf16_t* MG;
    __device__ __forceinline__ void operator()(const af4 (&acc)[2][2][4][2], const Unit& u, int wr, int wc, int fr, int fq) const {
        const int row0 = u.pm * 256 + wr * 64 + fr, col0 = u.pn * 256 + wc * 32 + 8 * fq;
#pragma unroll
        for (int ai = 0; ai < 2; ++ai)
#pragma unroll
            for (int m = 0; m < 4; ++m)
#pragma unroll
                for (int bj = 0; bj < 2; ++bj) {
                    const size_t off = (size_t)(row0 + ai * 128 + m * 16) * 1024 + col0 + bj * 128;
                    const u32x2 g = *(const u32x2*)((const unsigned char*)GRT + off);
                    const u32x4 t = *(const u32x4*)(MG + off);
                    float o[8];
#pragma unroll
                    for (int e = 0; e < 4; ++e) { o[e] = acc[ai][bj][m][0][e]; o[4 + e] = acc[ai][bj][m][1][e]; }
                    const unsigned tw[4] = {t.x, t.y, t.z, t.w};
#pragma unroll
                    for (int e = 0; e < 8; ++e) {
                        const float gv = (float)(((e < 4 ? g.x : g.y) >> (8 * (e & 3))) & 255u) * (1.0f / 255.0f);
                        const float tv = (e & 1) ? __uint_as_float(tw[e >> 1] & 0xffff0000u) : __uint_as_float(tw[e >> 1] << 16);
                        o[e] = o[e] * gv + tv;
                    }
                    st8bf(MG + off, o);
                }
    }
};
struct EpiMix {
    static constexpr bool PERM = true, AFTER_DRAIN = false;
    const float* X; float* X1; bf16_t* XBo; float* STAT;
    __device__ __forceinline__ void operator()(const af4 (&acc)[2][2][4][2], const Unit& u, int wr, int wc, int fr, int fq) const {
        const int row0 = u.pm * 256 + wr * 64 + fr, col0 = u.pn * 256 + wc * 32 + 8 * fq;
#pragma unroll
        for (int ai = 0; ai < 2; ++ai)
#pragma unroll
            for (int m = 0; m < 4; ++m) {
                const int row = row0 + ai * 128 + m * 16;
                float s1 = 0.f, s2 = 0.f;
#pragma unroll
                for (int bj = 0; bj < 2; ++bj) {
                    const size_t off = (size_t)row * 1024 + col0 + bj * 128;
                    const u32x4 xw = *(const u32x4*)(XBo + off);
                    const f32x4 x0 = (f32x4){__uint_as_float(xw.x << 16), __uint_as_float(xw.x & 0xffff0000u), __uint_as_float(xw.y << 16), __uint_as_float(xw.y & 0xffff0000u)};
                    const f32x4 x1 = (f32x4){__uint_as_float(xw.z << 16), __uint_as_float(xw.z & 0xffff0000u), __uint_as_float(xw.w << 16), __uint_as_float(xw.w & 0xffff0000u)};
                    const af4 p0 = x0 * DN_ALPHA + acc[ai][bj][m][0], p1 = x1 * DN_ALPHA + acc[ai][bj][m][1];
                    st8v(XBo + off, p0, p1);
                    s1 += (p0[0] + p0[1]) + (p0[2] + p0[3]) + (p1[0] + p1[1]) + (p1[2] + p1[3]);
                    s2 += (p0[0] * p0[0] + p0[1] * p0[1]) + (p0[2] * p0[2] + p0[3] * p0[3]) + (p1[0] * p1[0] + p1[1] * p1[1]) + (p1[2] * p1[2] + p1[3] * p1[3]);
                }
                s1 += __shfl_xor(s1, 16); s1 += __shfl_xor(s1, 32); s2 += __shfl_xor(s2, 16); s2 += __shfl_xor(s2, 32);
                if (fq == 0) *(float2*)(STAT + ((size_t)row * 16 + u.pn * 4 + wc) * 2) = make_float2(s1, s2);
            }
    }
};
struct EpiPlain {
    static constexpr bool PERM = true, AFTER_DRAIN = false;
    bf16_t* O; int ldc;
    __device__ __forceinline__ void operator()(const af4 (&acc)[2][2][4][2], const Unit& u, int wr, int wc, int fr, int fq) const {
        const int row0 = u.pm * 256 + wr * 64 + fr, col0 = u.pn * 256 + wc * 32 + 8 * fq;
#pragma unroll
        for (int ai = 0; ai < 2; ++ai)
#pragma unroll
            for (int m = 0; m < 4; ++m)
#pragma unroll
                for (int bj = 0; bj < 2; ++bj) {
                    float o[8];
#pragma unroll
                    for (int e = 0; e < 4; ++e) { o[e] = acc[ai][bj][m][0][e]; o[4 + e] = acc[ai][bj][m][1][e]; }
                    st8bf(O + (size_t)(row0 + ai * 128 + m * 16) * ldc + col0 + bj * 128, o);
                }
    }
};
__device__ __forceinline__ int win_dest_row(int n) {
    if (n < 1024) { const int seg = n >> 9, r = n & 511, h = r >> 6, d = r & 63; const int pd = d < 32 ? 2 * d : 2 * (d - 32) + 1; return seg * 512 + h * 64 + pd; }
    if (n < 1536) return WIN_NROWS + (n - 1024);
    if (n < 2048) return 1024 + (n - 1536);
    if (n < 2560) return 1536 + (n - 2048);
    if (n < 3584) return WIN_NROWS + 512 + (n - 2560);
    return 2048 + (n - 3584);
}
template <bool WIN>
__device__ __forceinline__ void p0_transpose_item(const float* W, int K, int N, bf16_t* WT, LAS float* scr, int item, int lane, const float* rowscale = nullptr) {
    const int nblk = N / 32, kb = item / nblk, nb = item % nblk, k0 = 64 * kb, n0 = 32 * nb;
    float tv[32];
#pragma unroll
    for (int i = 0; i < 32; ++i) tv[i] = W[(size_t)(k0 + 2 * i + (lane >> 5)) * N + n0 + (lane & 31)];
#pragma unroll
    for (int i = 0; i < 32; ++i) { const int kk = 2 * i + (lane >> 5); scr[kk * 33 + (lane & 31)] = rowscale ? tv[i] * rowscale[k0 + kk] : tv[i]; }
    asm volatile("s_waitcnt lgkmcnt(0)" ::: "memory");
    const int c = lane & 7;
#pragma unroll
    for (int j = 0; j < 4; ++j) {
        const int n = (lane >> 3) + 8 * j; const LAS float* s = scr + (8 * c) * 33 + n;
        u32x4 o; o.x = pk2(s[0 * 33], s[1 * 33]); o.y = pk2(s[2 * 33], s[3 * 33]); o.z = pk2(s[4 * 33], s[5 * 33]); o.w = pk2(s[6 * 33], s[7 * 33]);
        const int nl = n0 + n;
        const int row = WIN ? win_dest_row(nl) : nl;
        *(u32x4*)(WT + (size_t)row * K + k0 + 8 * c) = o;
        if (WIN && nl >= OFF_KR && nl < OFF_VR) *(u32x4*)(WT + (size_t)(WIN_NROWS + 1536 + (nl - OFF_KR)) * K + k0 + 8 * c) = o;
    }
    asm volatile("s_waitcnt lgkmcnt(0)" ::: "memory");
}
__device__ __forceinline__ void cvt_copy(const float* src, bf16_t* dst, size_t n, size_t gtid, size_t gthreads) {
    size_t i = gtid * 8;
    for (; i + 3 * gthreads * 8 < n; i += 4 * gthreads * 8) {
        f32x4 a[4], b[4];
#pragma unroll
        for (int q = 0; q < 4; ++q) { a[q] = *(const f32x4*)(src + i + q * gthreads * 8); b[q] = *(const f32x4*)(src + i + q * gthreads * 8 + 4); }
#pragma unroll
        for (int q = 0; q < 4; ++q) {
            u32x4 w; w.x = pk2(a[q][0], a[q][1]); w.y = pk2(a[q][2], a[q][3]); w.z = pk2(b[q][0], b[q][1]); w.w = pk2(b[q][2], b[q][3]);
            *(u32x4*)(dst + i + q * gthreads * 8) = w;
        }
    }
    for (; i < n; i += gthreads * 8) {
        const f32x4 a = *(const f32x4*)(src + i), b = *(const f32x4*)(src + i + 4);
        u32x4 w; w.x = pk2(a[0], a[1]); w.y = pk2(a[2], a[3]); w.z = pk2(b[0], b[1]); w.w = pk2(b[2], b[3]);
        *(u32x4*)(dst + i) = w;
    }
}
struct Tables { float* ropeA; float* ropeR; float* ropeRT; float* qdec; float* kdec; };
__device__ __forceinline__ void p0_tables(const Tables& tb, size_t gtid, size_t gthreads, LAS float* invL) {
    const int t_ = (int)tidx();
    if (t_ < 32) invL[t_] = (float)pow(10000.0, -(double)t_ / 32.0);
    else if (t_ < 96) invL[t_] = (float)(1.0 / pow(10000.0, (double)(t_ - 32) / 63.0));
    __syncthreads();
    for (size_t i = gtid; i < (size_t)S * 32; i += gthreads) {
        const int s = (int)(i >> 5), j = (int)(i & 31);
        const float ang = (float)s * invL[j];
        float sn, c; sincosf(ang, &sn, &c);
        tb.ropeA[i * 2] = c; tb.ropeA[i * 2 + 1] = sn;
    }
    for (size_t i = gtid; i < (size_t)S * 64; i += gthreads) {
        const int s = (int)(i >> 6), j = (int)(i & 63);
        const float ang = (float)s * invL[32 + j];
        float sn, c; sincosf(ang, &sn, &c);
        tb.ropeR[i * 2] = c; tb.ropeR[i * 2 + 1] = sn;
        tb.ropeRT[((size_t)j * S + s) * 2] = c; tb.ropeRT[((size_t)j * S + s) * 2 + 1] = sn;
    }
    for (size_t i = gtid; i < 4 * 256; i += gthreads) {
        const int h = (int)(i >> 8), c = (int)(i & 255);
        const float lg = ret_logg(h);
        tb.qdec[i] = expf(lg * (float)c);
        tb.kdec[i] = 0.08838834764831845f * expf(-lg * (float)c);
    }
    __syncthreads();
}

__device__ __forceinline__ void ph_retscan(const float* KVT, bf16_t* PREVT) {
    const int tx_ = (int)tidx(), bx_ = (int)bidx(), gx_ = (int)gdim();
    const int n = 8 * RDV * RDK;
    for (int idx = bx_ * 512 + tx_; idx < n; idx += gx_ * 512) {
        const int ed = idx & 32767, bh = idx >> 15, h = bh & 3;
        const float lg = ret_logg(h);
        const float g1 = expf(lg), cd = expf(lg * 256.0f), g255 = expf(lg * 255.0f);
        float kvv[RNC];
#pragma unroll
        for (int nc = 0; nc < RNC; ++nc) kvv[nc] = KVT[((size_t)(bh * RNC + nc) << 15) + ed];
        float st = 0.f;
#pragma unroll
        for (int nc = 0; nc < RNC; ++nc) {
            PREVT[((size_t)(bh * RNC + nc) << 15) + ed] = (bf16_t)f2bf(st * g1);
            st = st * cd + g255 * kvv[nc];
        }
    }
}
__device__ __forceinline__ void p0_csum_part(const float* Wq, const float* g1, const float* b1, float* PARTC, float* PARTB) {
    const int tx_ = (int)tidx(), bx_ = (int)bidx(), gx_ = (int)gdim();
    for (int idx = bx_ * 512 + tx_; idx < 2 * 16 * 2048; idx += gx_ * 512) {
        const int l = idx >> 15, kq = (idx >> 11) & 15, n = idx & 2047;
        const float* w = Wq + (size_t)l * D * 2048 + (size_t)(64 * kq) * 2048 + n;
        float s = 0.f, t = 0.f;
#pragma unroll 32
        for (int k = 0; k < 64; ++k) { const float wv = w[(size_t)k * 2048]; s += g1[l * D + 64 * kq + k] * wv; t += b1[l * D + 64 * kq + k] * wv; }
        PARTC[idx] = s; PARTB[idx] = t;
    }
}
__device__ __forceinline__ void p0_csum_reduce(const float* PARTC, const float* PARTB, float* CSUM, float* BQ) {
    const int tx_ = (int)tidx(), bx_ = (int)bidx(), gx_ = (int)gdim();
    for (int idx = bx_ * 512 + tx_; idx < 2 * 2048; idx += gx_ * 512) {
        const int l = idx >> 11, n = idx & 2047;
        float s = 0.f, t = 0.f;
#pragma unroll
        for (int kq = 0; kq < 16; ++kq) { s += PARTC[(l * 16 + kq) * 2048 + n]; t += PARTB[(l * 16 + kq) * 2048 + n]; }
        CSUM[idx] = s; BQ[idx] = t;
    }
}
__device__ __forceinline__ void ph_kc_kb(const float* keys, const float* CSUM, const float* BQ, float* KC, float* KB) {
    const int tx_ = (int)tidx(), bx_ = (int)bidx(), gx_ = (int)gdim();
    const int lane = tx_ & 63;
    for (int idx = bx_ * 8 + (tx_ >> 6); idx < 2048; idx += gx_ * 8) {
        const int key = idx & 127, pp = (idx >> 7) & 1, hh = idx >> 8;
        const float* kp = keys + ((size_t)pp * PNK + key) * PKD;
        const float* cp = CSUM + hh * 256 + pp * 128; const float* bp = BQ + hh * 256 + pp * 128;
        const float k0 = kp[lane], k1 = kp[lane + 64];
        const float s = wave_sum(k0 * cp[lane] + k1 * cp[lane + 64]), t = wave_sum(k0 * bp[lane] + k1 * bp[lane + 64]);
        if (lane == 0) { KC[idx] = s; KB[idx] = t; }
    }
}
typedef short bf16x8_t __attribute__((ext_vector_type(8)));
template <int NR> struct CvtRowsT { f32x4 v[NR][4]; };
typedef CvtRowsT<2> CvtRows;
template <int NR> __device__ __forceinline__ void cvt2_issue(CvtRowsT<NR>& c, const float* srcU, const float* srcV, int row, int lane) {
#pragma unroll
    for (int r = 0; r < NR; ++r) {
        const int rr = row + r;
        const float* p = (rr < NEXP ? srcU + (size_t)rr * D : srcV + (size_t)(rr - NEXP) * D) + lane * 16;
#pragma unroll
        for (int q = 0; q < 4; ++q) c.v[r][q] = *(const f32x4*)(p + 4 * q);
    }
}
template <int NR> __device__ __forceinline__ void cvt2_finish(const CvtRowsT<NR>& c, unsigned char* dstU, unsigned char* dstV, float* sinv, int row, int lane) {
#pragma unroll
    for (int r = 0; r < NR; ++r) {
        const int rr = row + r;
        float m = 0.f;
#pragma unroll
        for (int q = 0; q < 4; ++q)
#pragma unroll
            for (int i = 0; i < 4; ++i) m = fmaxf(m, fabsf(c.v[r][q][i]));
#pragma unroll
        for (int o = 32; o >= 1; o >>= 1) m = fmaxf(m, __shfl_xor(m, o));
        const int er = rr < NEXP ? rr : rr - NEXP, which = rr < NEXP ? 0 : 1;
        {
            const float sc4 = m > 0.f ? 6.0f / m : 1.0f;
            unsigned d0 = 0u, d1 = 0u;
            d0 = __builtin_amdgcn_cvt_scalef32_pk_fp4_f32(d0, c.v[r][0][0] * sc4, c.v[r][0][1] * sc4, 1.0f, 0); d0 = __builtin_amdgcn_cvt_scalef32_pk_fp4_f32(d0, c.v[r][0][2] * sc4, c.v[r][0][3] * sc4, 1.0f, 1);
            d0 = __builtin_amdgcn_cvt_scalef32_pk_fp4_f32(d0, c.v[r][1][0] * sc4, c.v[r][1][1] * sc4, 1.0f, 2); d0 = __builtin_amdgcn_cvt_scalef32_pk_fp4_f32(d0, c.v[r][1][2] * sc4, c.v[r][1][3] * sc4, 1.0f, 3);
            d1 = __builtin_amdgcn_cvt_scalef32_pk_fp4_f32(d1, c.v[r][2][0] * sc4, c.v[r][2][1] * sc4, 1.0f, 0); d1 = __builtin_amdgcn_cvt_scalef32_pk_fp4_f32(d1, c.v[r][2][2] * sc4, c.v[r][2][3] * sc4, 1.0f, 1);
            d1 = __builtin_amdgcn_cvt_scalef32_pk_fp4_f32(d1, c.v[r][3][0] * sc4, c.v[r][3][1] * sc4, 1.0f, 2); d1 = __builtin_amdgcn_cvt_scalef32_pk_fp4_f32(d1, c.v[r][3][2] * sc4, c.v[r][3][3] * sc4, 1.0f, 3);
            u32x2 w2; w2.x = d0; w2.y = d1;
            *(u32x2*)((which ? dstV : dstU) + (size_t)er * (D / 2) + (which ? (lane >> 5) * 256 + (lane & 15) * 16 + ((lane >> 4) & 1) * 8 : lane * 8)) = w2;
            if (lane == 0) sinv[(size_t)er * 2 + which] = 1.0f / sc4;
        }
    }
}
__device__ __forceinline__ unsigned ord_key(float s) { unsigned u = __float_as_uint(s); return u ^ ((unsigned)((int)u >> 31) | 0x80000000u); }
__device__ __forceinline__ float ord_val(unsigned k) { const unsigned v = (k >> 31) ? (k ^ 0x80000000u) : ~k; return __uint_as_float(v); }
template <int N> __device__ __forceinline__ void bitonic_sort_desc(unsigned (&k)[N]) {
#pragma unroll
    for (int size = 2; size <= N; size <<= 1)
#pragma unroll
        for (int stride = size >> 1; stride > 0; stride >>= 1)
#pragma unroll
            for (int i = 0; i < N; ++i) {
                const int j = i ^ stride;
                if (j > i) {
                    const unsigned a = k[i], b = k[j], hi = a > b ? a : b, lo = a > b ? b : a;
                    const bool desc = (i & size) == 0;
                    k[i] = desc ? hi : lo; k[j] = desc ? lo : hi;
                }
            }
}
template <int N> __device__ __forceinline__ void bitonic_merge_desc(unsigned (&k)[N]) {
#pragma unroll
    for (int stride = N >> 1; stride > 0; stride >>= 1)
#pragma unroll
        for (int i = 0; i < N; ++i) {
            const int j = i ^ stride;
            if (j > i) { const unsigned a = k[i], b = k[j]; k[i] = a > b ? a : b; k[j] = a > b ? b : a; }
        }
}
constexpr int PK_PITCH = 272;
__device__ __forceinline__ void ph_peer_topk(const bf16_t* PQ, const bf16_t* KEYS, int* PIDX, float* PW, LAS unsigned char* l3,
                                             const float* STAT, const float* KC, const float* KB, float* RS,
                                             const float* srcU, const float* srcV, unsigned char* dstU, unsigned char* dstV, float* sinv) {
    const int tid = (int)tidx(), lane = tid & 63, g = lane >> 4, tk = lane & 15;
    const int wave = __builtin_amdgcn_readfirstlane(tid >> 6);
    for (int i = tid; i < 4096; i += 512) {
        const int row = i >> 4, ch = i & 15;
        const u32x4 v = *(const u32x4*)(KEYS + (size_t)row * 128 + ch * 8);
        *(LAS u32x4*)(l3 + row * PK_PITCH + ch * 16) = v;
    }
    __syncthreads();
    const int ntask = (T / 16) * 2;
    for (int task = (int)bidx() * 8 + wave; task < ntask; task += (int)gdim() * 8) {
        const int lane = (int)tidx() & 63, g = lane >> 4, tk = lane & 15;
        const int tg = task >> 1, hq = task & 1;
        const int tok = tg * 16 + tk;
        float mu, rstd;
        {
            float s1 = 0.f, s2 = 0.f;
#pragma unroll
            for (int q = 0; q < 4; ++q) { const float2 v = *(const float2*)(STAT + ((size_t)tok * 16 + 4 * g + q) * 2); s1 += v.x; s2 += v.y; }
            s1 += __shfl_xor(s1, 16); s1 += __shfl_xor(s1, 32); s2 += __shfl_xor(s2, 16); s2 += __shfl_xor(s2, 32);
            mu = s1 * (1.0f / D);
            rstd = 1.0f / sqrtf(fmaxf(s2 * (1.0f / D) - mu * mu, 0.f) + LN_EPS);
            if (hq == 0 && g == 0) *(float2*)(RS + (size_t)tok * 2) = make_float2(mu, rstd);
        }
        float sv0[16], sv1[16]; int si0[16], si1[16];
#pragma unroll
        for (int r = 0; r < 16; ++r) { sv0[r] = 0.f; sv1[r] = 0.f; si0[r] = 0; si1[r] = 0; }
        CvtRowsT<1> cvB;
        for (int hh = 0; hh < 4; ++hh) {
            const int h = hq * 4 + hh;
            const bool mine = (g == hh);
#pragma unroll
            for (int p = 0; p < 2; ++p) {
                const int crow = task * 16 + (hh * 2 + p) * 2;
                if (hh + p > 0) cvt2_finish(cvB, dstU, dstV, sinv, crow - 1, lane);
                CvtRowsT<1> cvA; cvt2_issue(cvA, srcU, srcV, crow, lane);
                f32x4 acc[8];
#pragma unroll
                for (int kt = 0; kt < 8; ++kt) acc[kt] = (f32x4){0.f, 0.f, 0.f, 0.f};
                const bf16_t* qp = PQ + (size_t)tok * 2048 + h * 256 + p * 128 + 8 * g;
#pragma unroll
                for (int ks = 0; ks < 4; ++ks) {
                    asm volatile("" ::: "memory");
                    const bf16x8_t qf = *(const bf16x8_t*)(qp + 32 * ks);
#pragma unroll
                    for (int kt = 0; kt < 8; ++kt) {
                        const bf16x8_t kf = *(const LAS bf16x8_t*)(l3 + (p * 128 + 16 * kt + tk) * PK_PITCH + (32 * ks + 8 * g) * 2);
                        acc[kt] = __builtin_amdgcn_mfma_f32_16x16x32_bf16(kf, qf, acc[kt], 0, 0, 0);
                    }
                }
                cvt2_finish(cvA, dstU, dstV, sinv, crow, lane);
                cvt2_issue(cvB, srcU, srcV, crow + 1, lane);
                f32x4 kc4[8], kb4[8];
#pragma unroll
                for (int kt = 0; kt < 8; ++kt) { kc4[kt] = *(const f32x4*)(KC + h * 256 + p * 128 + 16 * kt + 4 * g); kb4[kt] = *(const f32x4*)(KB + h * 256 + p * 128 + 16 * kt + 4 * g); }
                unsigned k[32];
#pragma unroll
                for (int kt = 0; kt < 8; ++kt)
#pragma unroll
                    for (int r = 0; r < 4; ++r) k[kt * 4 + r] = (ord_key(rstd * (acc[kt][r] - mu * kc4[kt][r]) + kb4[kt][r]) & ~127u) | (unsigned)(127 - (16 * kt + 4 * g + r));
                bitonic_sort_desc<32>(k);
                unsigned t16[16];
#pragma unroll
                for (int r = 0; r < 16; ++r) t16[r] = k[r];
#pragma unroll
                for (int o = 16; o <= 32; o <<= 1) {
                    unsigned ob[16];
#pragma unroll
                    for (int r = 0; r < 16; ++r) ob[r] = (unsigned)__shfl_xor((int)t16[r], o);
#pragma unroll
                    for (int r = 0; r < 16; ++r) t16[r] = t16[r] > ob[15 - r] ? t16[r] : ob[15 - r];
                    bitonic_merge_desc<16>(t16);
                }
#pragma unroll
                for (int r = 0; r < 16; ++r) {
                    const float val = ord_val(t16[r] & ~127u); const int idx = 127 - (int)(t16[r] & 127u);
                    if (p == 0) { sv0[r] = mine ? val : sv0[r]; si0[r] = mine ? idx : si0[r]; }
                    else        { sv1[r] = mine ? val : sv1[r]; si1[r] = mine ? idx : si1[r]; }
                }
            }
        }
        cvt2_finish(cvB, dstU, dstV, sinv, task * 16 + 15, lane);
        unsigned c[64];
        {
            int n = 0;
#pragma unroll
            for (int a = 0; a < 16; ++a)
#pragma unroll
                for (int b = 0; b < 16; ++b)
                    if ((a + 1) * (b + 1) <= 16) { c[n] = (ord_key(sv0[a] + sv1[b]) & ~255u) | (unsigned)(255 - (a * 16 + b)); ++n; }
#pragma unroll
            for (int j = 50; j < 64; ++j) c[j] = 0u;
        }
        bitonic_sort_desc<64>(c);
        float fs[16]; int fe[16];
#pragma unroll
        for (int r = 0; r < 16; ++r) {
            const unsigned m = c[r];
            const int pos = 255 - (int)(m & 255u), a = pos >> 4, b = pos & 15;
            fs[r] = ord_val(m & ~255u);
            int ea = si0[0], eb = si1[0];
#pragma unroll
            for (int j = 1; j < 16; ++j) { ea = (a == j) ? si0[j] : ea; eb = (b == j) ? si1[j] : eb; }
            fe[r] = ea * PNK + eb;
        }
        float sum = 0.f; const float fmx = fs[0];
#pragma unroll
        for (int r = 0; r < 16; ++r) { fs[r] = __expf(fs[r] - fmx); sum += fs[r]; }
        const float inv = 1.0f / sum;
        const int lane2 = (int)tidx() & 63;
        const unsigned oo = (unsigned)(tg * 16 + (lane2 & 15)) * 128u + (unsigned)((hq * 4 + (lane2 >> 4)) * 16);
        int* ip = PIDX + oo;
        float* wp = PW + oo;
#pragma unroll
        for (int r = 0; r < 16; r += 4) {
            *(int4*)(ip + r) = make_int4(fe[r], fe[r + 1], fe[r + 2], fe[r + 3]);
            *(float4*)(wp + r) = make_float4(fs[r] * inv, fs[r + 1] * inv, fs[r + 2] * inv, fs[r + 3] * inv);
        }
    }
    __syncthreads();
}
typedef __bf16 bf16x2v __attribute__((ext_vector_type(2)));
__device__ __forceinline__ float dot2bf(unsigned a, unsigned b, float c) {
    return __builtin_amdgcn_fdot2_f32_bf16(__builtin_bit_cast(bf16x2v, a), __builtin_bit_cast(bf16x2v, b), c, false);
}
__device__ __forceinline__ float gelu_fast(float x) {
    const float z = 1.5957691216057308f * (x + 0.044715f * x * x * x);
    return x * __builtin_amdgcn_rcpf(1.0f + __expf(-z));
}
constexpr int GNT = 4;
constexpr int G_LDS_WAVE = 14848;
typedef float f32x2v __attribute__((ext_vector_type(2)));
typedef int v8i32 __attribute__((ext_vector_type(8)));
__device__ __forceinline__ float row_sum16(float v) {
    v += __builtin_bit_cast(float, __builtin_amdgcn_update_dpp(0, __builtin_bit_cast(int, v), 0xB1, 0xF, 0xF, false));
    v += __builtin_bit_cast(float, __builtin_amdgcn_update_dpp(0, __builtin_bit_cast(int, v), 0x4E, 0xF, 0xF, false));
    v += __builtin_bit_cast(float, __builtin_amdgcn_update_dpp(0, __builtin_bit_cast(int, v), 0x141, 0xF, 0xF, false));
    v += __builtin_bit_cast(float, __builtin_amdgcn_update_dpp(0, __builtin_bit_cast(int, v), 0x140, 0xF, 0xF, false));
    return v;
}
#define G_LD2(dst, base) do { _Pragma("unroll") for (int k_ = 0; k_ < 2; ++k_) (dst)[k_] = *(const u32x4*)((base) + rowoff + 256 * k_); } while (0)
#define G_ACC8(dw, xi) do { acc[(xi)] += __builtin_amdgcn_cvt_scalef32_pk_f32_fp4((dw), 1.0f, 0) * ww_; acc[(xi) + 1] += __builtin_amdgcn_cvt_scalef32_pk_f32_fp4((dw), 1.0f, 1) * ww_; \
                                acc[(xi) + 2] += __builtin_amdgcn_cvt_scalef32_pk_f32_fp4((dw), 1.0f, 2) * ww_; acc[(xi) + 3] += __builtin_amdgcn_cvt_scalef32_pk_f32_fp4((dw), 1.0f, 3) * ww_; } while (0)
__device__ __forceinline__ f32x4 ldpre4(const bf16_t* p) { const u32x2 w = *(const u32x2*)p; return (f32x4){__uint_as_float(w.x << 16), __uint_as_float(w.x & 0xffff0000u), __uint_as_float(w.y << 16), __uint_as_float(w.y & 0xffff0000u)}; }
constexpr int GRING = 3;
__device__ __forceinline__ void ph_peer_gather(const float* X1, const int* PIDX, const float* PW, const unsigned char* TU, const unsigned char* TV, const float* SINV,
                                               const float* lg, const float* lb, float* OUT, bf16_t* XB, LAS unsigned char* l3, const float* RS, const float* g1, const float* b1) {
    const int tid = (int)tidx(), lane = tid & 63, tj = lane >> 4, li = lane & 15;
    const int wave = __builtin_amdgcn_readfirstlane(tid >> 6);
    LAS unsigned* keyL = (LAS unsigned*)(l3 + wave * G_LDS_WAVE);
    LAS float* wL = (LAS float*)(l3 + wave * G_LDS_WAVE + 2048);
    const int ebase = tj * 128;
    const int ngrp = T / GNT;
#pragma unroll 1
    for (int grp = (int)bidx() * 8 + wave; grp < ngrp; grp += (int)gdim() * 8) {
        const int tbase = grp * GNT;
        const int lane = (int)tidx() & 63, tj = lane >> 4, li = lane & 15, ebase = tj * 128;
#pragma unroll
        for (int i = 0; i < 8; ++i) {
            const int e = lane + 64 * i;
            keyL[e] = ((unsigned)(e >> 7) << 23) | ((unsigned)PIDX[(size_t)tbase * 128 + e] << 9) | (unsigned)e;
            wL[e] = PW[(size_t)tbase * 128 + e];
        }
        asm volatile("s_waitcnt lgkmcnt(0)" ::: "memory");
#pragma unroll 1
        for (int k = 2; k <= 128; k <<= 1)
#pragma unroll 1
            for (int j = k >> 1; j > 0; j >>= 1) {
#pragma unroll
                for (int i = 0; i < 4; ++i) {
                    const int q = lane + 64 * i;
                    const int x = ((q & ~(j - 1)) << 1) | (q & (j - 1)), y = x | j;
                    const unsigned a = keyL[x], b = keyL[y];
                    const bool asc = (k == 128) || ((x & k) == 0);
                    const bool sw = asc ? (a > b) : (a < b);
                    keyL[x] = sw ? b : a; keyL[y] = sw ? a : b;
                }
                asm volatile("s_waitcnt lgkmcnt(0)" ::: "memory");
            }
        const size_t ro = (size_t)(tbase + tj) * D + 16 * li;
        size_t rowoff;
        const float2 rs2 = *(const float2*)(RS + (size_t)(tbase + tj) * 2); const float mu1 = rs2.x, rs1 = rs2.y;
        {
            LAS float* hL = (LAS float*)(l3 + wave * G_LDS_WAVE + 4608);
            LAS unsigned char* xbL = l3 + wave * G_LDS_WAVE + 6656;
#pragma unroll
            for (int k = 0; k < 4; ++k) {
                float xv[16];
#pragma unroll
                for (int c = 0; c < 4; ++c) {
                    const f32x4 gg = *(const f32x4*)(g1 + 256 * k + 16 * li + 4 * c), bb = *(const f32x4*)(b1 + 256 * k + 16 * li + 4 * c);
                    const f32x4 a = (ldpre4(XB + ro + 256 * k + 4 * c) - mu1) * rs1 * gg + bb;
                    xv[4 * c] = a[0]; xv[4 * c + 1] = a[1]; xv[4 * c + 2] = a[2]; xv[4 * c + 3] = a[3];
                }
#pragma unroll
                for (int n = 0; n < 4; ++n) {
                    const float sn = n == 0 ? 2.0f : n == 1 ? 0.5f : n == 2 ? 0.125f : 0.03125f, isn = 1.0f / sn;
                    unsigned d0 = 0u, d1 = 0u;
                    d0 = __builtin_amdgcn_cvt_scalef32_pk_fp4_f32(d0, xv[0] * isn, xv[1] * isn, 1.0f, 0);
                    d0 = __builtin_amdgcn_cvt_scalef32_pk_fp4_f32(d0, xv[2] * isn, xv[3] * isn, 1.0f, 1);
                    d0 = __builtin_amdgcn_cvt_scalef32_pk_fp4_f32(d0, xv[4] * isn, xv[5] * isn, 1.0f, 2);
                    d0 = __builtin_amdgcn_cvt_scalef32_pk_fp4_f32(d0, xv[6] * isn, xv[7] * isn, 1.0f, 3);
                    d1 = __builtin_amdgcn_cvt_scalef32_pk_fp4_f32(d1, xv[8] * isn, xv[9] * isn, 1.0f, 0);
                    d1 = __builtin_amdgcn_cvt_scalef32_pk_fp4_f32(d1, xv[10] * isn, xv[11] * isn, 1.0f, 1);
                    d1 = __builtin_amdgcn_cvt_scalef32_pk_fp4_f32(d1, xv[12] * isn, xv[13] * isn, 1.0f, 2);
                    d1 = __builtin_amdgcn_cvt_scalef32_pk_fp4_f32(d1, xv[14] * isn, xv[15] * isn, 1.0f, 3);
                    { const f32x2v q = __builtin_amdgcn_cvt_scalef32_pk_f32_fp4(d0, 1.0f, 0); xv[0] -= q.x * sn; xv[1] -= q.y * sn; }
                    { const f32x2v q = __builtin_amdgcn_cvt_scalef32_pk_f32_fp4(d0, 1.0f, 1); xv[2] -= q.x * sn; xv[3] -= q.y * sn; }
                    { const f32x2v q = __builtin_amdgcn_cvt_scalef32_pk_f32_fp4(d0, 1.0f, 2); xv[4] -= q.x * sn; xv[5] -= q.y * sn; }
                    { const f32x2v q = __builtin_amdgcn_cvt_scalef32_pk_f32_fp4(d0, 1.0f, 3); xv[6] -= q.x * sn; xv[7] -= q.y * sn; }
                    { const f32x2v q = __builtin_amdgcn_cvt_scalef32_pk_f32_fp4(d1, 1.0f, 0); xv[8] -= q.x * sn; xv[9] -= q.y * sn; }
                    { const f32x2v q = __builtin_amdgcn_cvt_scalef32_pk_f32_fp4(d1, 1.0f, 1); xv[10] -= q.x * sn; xv[11] -= q.y * sn; }
                    { const f32x2v q = __builtin_amdgcn_cvt_scalef32_pk_f32_fp4(d1, 1.0f, 2); xv[12] -= q.x * sn; xv[13] -= q.y * sn; }
                    { const f32x2v q = __builtin_amdgcn_cvt_scalef32_pk_f32_fp4(d1, 1.0f, 3); xv[14] -= q.x * sn; xv[15] -= q.y * sn; }
                    u32x2 w2; w2.x = d0; w2.y = d1;
                    *(LAS u32x2*)(xbL + tj * 2048 + n * 512 + 128 * k + 8 * li) = w2;
                }
            }
            asm volatile("s_waitcnt lgkmcnt(0)" ::: "memory");
            const float colw = li == 0 ? 2.0f : li == 1 ? 0.5f : li == 2 ? 0.125f : li == 3 ? 0.03125f : 0.f;
            u32x4 af[2][8];
            const int psrc = (4 * li + tj) * 4;
            u32x4 bf[8];
#define GU_LOADA(buf, q_) do { const unsigned key_ = keyL[((q_) & 3) * 128 + 16 * ((q_) >> 2) + (lane >> 2)]; const unsigned char* ap_ = TU + (size_t)((key_ >> 9) & 16383u) * (D / 2) + 16 * (lane & 3); \
                               _Pragma("unroll") for (int s_ = 0; s_ < 8; ++s_) af[buf][s_] = *(const u32x4*)(ap_ + 64 * s_); } while (0)
#define GU_GROUP(buf, q_) do { f32x4 c0_ = (f32x4){0.f, 0.f, 0.f, 0.f}, c1_ = (f32x4){0.f, 0.f, 0.f, 0.f}; \
                               { const LAS unsigned char* bp_ = xbL + ((q_) & 3) * 2048 + (li & 3) * 512 + 16 * tj; _Pragma("unroll") for (int s_ = 0; s_ < 8; ++s_) bf[s_] = *(const LAS u32x4*)(bp_ + 64 * s_); } \
                               u32x4 ap8_[8]; _Pragma("unroll") for (int s_ = 0; s_ < 8; ++s_) { ap8_[s_].x = (unsigned)__builtin_amdgcn_ds_bpermute(psrc, (int)af[buf][s_].x); ap8_[s_].y = (unsigned)__builtin_amdgcn_ds_bpermute(psrc, (int)af[buf][s_].y); ap8_[s_].z = (unsigned)__builtin_amdgcn_ds_bpermute(psrc, (int)af[buf][s_].z); ap8_[s_].w = (unsigned)__builtin_amdgcn_ds_bpermute(psrc, (int)af[buf][s_].w); } \
                               _Pragma("unroll") for (int s_ = 0; s_ < 8; s_ += 2) { \
                                   c0_ = __builtin_amdgcn_mfma_scale_f32_16x16x128_f8f6f4((v8i32){(int)ap8_[s_].x, (int)ap8_[s_].y, (int)ap8_[s_].z, (int)ap8_[s_].w, 0, 0, 0, 0}, (v8i32){(int)bf[s_].x, (int)bf[s_].y, (int)bf[s_].z, (int)bf[s_].w, 0, 0, 0, 0}, c0_, 4, 4, 0, 0x7F7F7F7F, 0, 0x7F7F7F7F); \
                                   c1_ = __builtin_amdgcn_mfma_scale_f32_16x16x128_f8f6f4((v8i32){(int)ap8_[s_ + 1].x, (int)ap8_[s_ + 1].y, (int)ap8_[s_ + 1].z, (int)ap8_[s_ + 1].w, 0, 0, 0, 0}, (v8i32){(int)bf[s_ + 1].x, (int)bf[s_ + 1].y, (int)bf[s_ + 1].z, (int)bf[s_ + 1].w, 0, 0, 0, 0}, c1_, 4, 4, 0, 0x7F7F7F7F, 0, 0x7F7F7F7F); } \
                               c0_ = c0_ + c1_; f32x4 hs_; \
                               _Pragma("unroll") for (int i_ = 0; i_ < 4; ++i_) hs_[i_] = row_sum16(c0_[i_] * colw); \
                               if (li == 0) *(LAS f32x4*)(hL + ((q_) & 3) * 128 + 16 * ((q_) >> 2) + 4 * tj) = hs_; } while (0)
            GU_LOADA(0, 0);
#pragma unroll 1
            for (int q2 = 0; q2 < 16; ++q2) {
                GU_LOADA(1, 2 * q2 + 1);
                GU_GROUP(0, 2 * q2);
                { const int qn = (2 * q2 + 2) < 32 ? (2 * q2 + 2) : 31; GU_LOADA(0, qn); }
                GU_GROUP(1, 2 * q2 + 1);
            }
#undef GU_LOADA
#undef GU_GROUP
            asm volatile("s_waitcnt lgkmcnt(0)" ::: "memory");
#pragma unroll
            for (int i = 0; i < 8; ++i) {
                const int e = lane + 64 * i;
                const unsigned key_ = keyL[e]; const unsigned ex_ = (key_ >> 9) & 16383u;
                const f32x2v si = *(const f32x2v*)(SINV + 2 * ex_);
                const float d_ = hL[e] * si.x;
                wL[key_ & 511u] = wL[key_ & 511u] * si.y * gelu_fast(d_);
            }
        }
        asm volatile("s_waitcnt lgkmcnt(0)" ::: "memory");
        f32x2v acc[32];
#pragma unroll
        for (int i = 0; i < 32; ++i) acc[i] = (f32x2v){0.f, 0.f};
        {
            u32x4 vb[GRING][2]; float mw[GRING];
#pragma unroll
            for (int r = 0; r < GRING; ++r) {
                const unsigned key_ = keyL[ebase + r];
                mw[r] = wL[key_ & 511u];
                rowoff = (size_t)((key_ >> 9) & 16383u) * (D / 2) + 16 * li;
                G_LD2(vb[r], TV);
            }
#pragma unroll 1
            for (int st = 0; st < 126 + GRING; st += GRING) {
#pragma unroll
                for (int r = 0; r < GRING; ++r) {
                    const float ww_ = mw[r];
#pragma unroll
                    for (int s_ = 0; s_ < 2; ++s_) { __builtin_amdgcn_sched_barrier(0); G_ACC8(vb[r][s_].x, 16 * s_ + 0); G_ACC8(vb[r][s_].y, 16 * s_ + 4); G_ACC8(vb[r][s_].z, 16 * s_ + 8); G_ACC8(vb[r][s_].w, 16 * s_ + 12); }
                    const bool more = (st + r + GRING) < 128;
                    const int nx = more ? (st + r + GRING) : 127;
                    const unsigned key_ = keyL[ebase + nx];
                    mw[r] = more ? wL[key_ & 511u] : 0.f;
                    rowoff = (size_t)((key_ >> 9) & 16383u) * (D / 2) + 16 * li;
                    asm volatile("" ::: "memory");
                    G_LD2(vb[r], TV);
                    asm volatile("" ::: "memory");
                }
            }
        }
        {
            const int lane_e = (int)tidx() & 63, tj = lane_e >> 4, li = lane_e & 15;
            const size_t ro = (size_t)(tbase + tj) * D + 16 * li;
            const float2 rs2e = *(const float2*)(RS + (size_t)(tbase + tj) * 2); const float mu1 = rs2e.x, rs1 = rs2e.y;
            float sum = 0.f;
#pragma unroll
            for (int k = 0; k < 4; ++k)
#pragma unroll
                for (int c = 0; c < 4; ++c) {
                    if (c == 0) asm volatile("" ::: "memory");
                    const f32x4 gg = *(const f32x4*)(g1 + 256 * k + 16 * li + 4 * c), bb = *(const f32x4*)(b1 + 256 * k + 16 * li + 4 * c);
                    const f32x4 a = (ldpre4(XB + ro + 256 * k + 4 * c) - mu1) * rs1 * gg + bb;
                    acc[8 * k + 2 * c] += (f32x2v){a[0], a[1]} * DN_ALPHA; acc[8 * k + 2 * c + 1] += (f32x2v){a[2], a[3]} * DN_ALPHA;
                }
#pragma unroll
            for (int i = 0; i < 32; ++i) sum += acc[i].x + acc[i].y;
            const float mu = row_sum16(sum) * (1.0f / D);
            float sq = 0.f;
#pragma unroll
            for (int i = 0; i < 32; ++i) { acc[i] = acc[i] - mu; sq += acc[i].x * acc[i].x + acc[i].y * acc[i].y; }
            const float rsd = 1.0f / sqrtf(row_sum16(sq) * (1.0f / D) + LN_EPS);
#pragma unroll
            for (int k = 0; k < 4; ++k)
#pragma unroll
                for (int c = 0; c < 4; c += 2) {
                    asm volatile("" ::: "memory");
                    const size_t off = 256 * k + 16 * li + 4 * c;
                    const f32x4 g0 = *(const f32x4*)(lg + off), g1 = *(const f32x4*)(lg + off + 4), c0 = *(const f32x4*)(lb + off), c1 = *(const f32x4*)(lb + off + 4);
                    const f32x2v a0 = acc[8 * k + 2 * c], a1 = acc[8 * k + 2 * c + 1], a2 = acc[8 * k + 2 * c + 2], a3 = acc[8 * k + 2 * c + 3];
                    f32x4 o0, o1;
                    o0[0] = a0.x * rsd * g0[0] + c0[0]; o0[1] = a0.y * rsd * g0[1] + c0[1]; o0[2] = a1.x * rsd * g0[2] + c0[2]; o0[3] = a1.y * rsd * g0[3] + c0[3];
                    o1[0] = a2.x * rsd * g1[0] + c1[0]; o1[1] = a2.y * rsd * g1[1] + c1[1]; o1[2] = a3.x * rsd * g1[2] + c1[2]; o1[3] = a3.y * rsd * g1[3] + c1[3];
                    if (OUT) { float* op = OUT + (size_t)(tbase + tj) * D + off; *(f32x4*)op = o0; *(f32x4*)(op + 4) = o1; }
                    u32x4 w; w.x = pk2(o0[0], o0[1]); w.y = pk2(o0[2], o0[3]); w.z = pk2(o1[0], o1[1]); w.w = pk2(o1[2], o1[3]);
                    *(u32x4*)(XB + (size_t)(tbase + tj) * D + off) = w;
                }
        }
        asm volatile("s_waitcnt lgkmcnt(0)" ::: "memory");
    }
}
typedef short bf16x4_t __attribute__((ext_vector_type(4)));
__device__ __forceinline__ bf16x8_t ld8(const bf16_t* p) { return *(const bf16x8_t*)p; }
__device__ __forceinline__ bf16x8_t cat44(const bf16_t* p0, const bf16_t* p1) {
    const bf16x4_t a = *(const bf16x4_t*)p0, b = *(const bf16x4_t*)p1;
    return (bf16x8_t){a[0], a[1], a[2], a[3], b[0], b[1], b[2], b[3]};
}
__device__ __forceinline__ void ph_retkv(const bf16_t* VRT, const bf16_t* KRT, float* KVT, LAS unsigned char* l3) {
    const int tid = (int)tidx(), lane = tid & 63, g = lane >> 4, li = lane & 15;
    const int wave = __builtin_amdgcn_readfirstlane(tid >> 6);
    const int gd_ = (int)gdim(), bx0_ = (int)bidx();
    const int vcu = (gd_ % 8 == 0) ? (bx0_ % 8) * (gd_ / 8) + bx0_ / 8 : bx0_;
#pragma unroll 1
    for (int item = vcu; item < 8 * RNC; item += gd_) {
        const int bh = item >> 5, n = item & 31;
        {
            const bf16_t* kg = KRT + ((size_t)bh * 128) * S + n * 256;
#pragma unroll
            for (int q = 0; q < 8; ++q) {
                const int c = tid + 512 * q, d = c >> 5, ch = c & 31;
                const u32x4 v = *(const u32x4*)(kg + (size_t)d * S + ch * 8);
                *(LAS u32x4*)(l3 + d * 512 + ((ch ^ (d & 31)) * 16)) = v;
            }
        }
        const bf16_t* vb = VRT + ((size_t)bh * 256 + 32 * wave + li) * S + n * 256 + 8 * g;
        bf16x8_t a0[8], a1[8];
#pragma unroll
        for (int s = 0; s < 8; ++s) { a0[s] = ld8(vb + 32 * s); a1[s] = ld8(vb + (size_t)16 * S + 32 * s); }
        __syncthreads();
        f32x4 acc[2][8];
#pragma unroll
        for (int a = 0; a < 2; ++a)
#pragma unroll
            for (int d = 0; d < 8; ++d) acc[a][d] = (f32x4){0.f, 0.f, 0.f, 0.f};
#pragma unroll
        for (int s = 0; s < 8; ++s) {
#pragma unroll
            for (int dt = 0; dt < 8; ++dt) {
                const int d = 16 * dt + li;
                const bf16x8_t kf = *(const LAS bf16x8_t*)(l3 + d * 512 + (((4 * s + g) ^ (d & 31)) * 16));
                acc[0][dt] = __builtin_amdgcn_mfma_f32_16x16x32_bf16(a0[s], kf, acc[0][dt], 0, 0, 0);
                acc[1][dt] = __builtin_amdgcn_mfma_f32_16x16x32_bf16(a1[s], kf, acc[1][dt], 0, 0, 0);
            }
        }
        float* ob = KVT + (((size_t)item) << 15);
#pragma unroll
        for (int a = 0; a < 2; ++a)
#pragma unroll
            for (int dt = 0; dt < 8; ++dt)
#pragma unroll
                for (int r = 0; r < 4; ++r) ob[(size_t)(32 * wave + 16 * a + 4 * g + r) * 128 + 16 * dt + li] = acc[a][dt][r];
        __syncthreads();
    }
}
constexpr int RO_PREV = 0, RO_K = 65536, RO_V = RO_K + 2 * 8192, RO_END = RO_V + 2 * 16384;
static_assert(RO_END <= 131072, "retout LDS map");
__device__ __forceinline__ void ph_retout(const bf16_t* QR, const bf16_t* KR, const bf16_t* VRT, const bf16_t* PREVT, const bf16_t* GR, bf16_t* YR, LAS unsigned char* l3) {
    const int tid = (int)tidx(), lane = tid & 63, g = lane >> 4, li = lane & 15;
    const int wave = __builtin_amdgcn_readfirstlane(tid >> 6);
    const int gd_ = (int)gdim(), bx0_ = (int)bidx();
    const int vcu = (gd_ % 8 == 0) ? (bx0_ % 8) * (gd_ / 8) + bx0_ / 8 : bx0_;
#pragma unroll 1
    for (int item = vcu; item < 8 * RNC; item += gd_) {
        const int bh = item >> 5, n = item & 31, b = bh >> 2, h = bh & 3;
        const size_t tok0 = (size_t)b * S + n * 256;
        {
            const bf16_t* pg = PREVT + (((size_t)item) << 15);
#pragma unroll
            for (int q = 0; q < 8; ++q) {
                const int c = tid + 512 * q, e = c >> 4, ch = c & 15;
                const u32x4 v = *(const u32x4*)(pg + (size_t)c * 8);
                *(LAS u32x4*)(l3 + RO_PREV + e * 256 + ((ch ^ (e & 15)) * 16)) = v;
            }
        }
        u32x4 kreg, vreg[2];
        const int krow = tid >> 4, kch = tid & 15;
#pragma unroll 1
        for (int hf = 0; hf < 2; ++hf) {
            const int tg = hf == 0 ? wave : 15 - wave, nstep = hf == 0 ? 4 : 8;
            const int c = 16 * tg + li;
            kreg = *(const u32x4*)(KR + (tok0 + krow) * 512 + h * 128 + kch * 8);
#pragma unroll
            for (int q = 0; q < 2; ++q) { const int cx = tid + 512 * q, e = cx >> 2, ch = cx & 3; vreg[q] = *(const u32x4*)(VRT + ((size_t)bh * 256 + e) * S + n * 256 + ch * 8); }
            bf16x8_t qf[4];
            {
                const bf16_t* qp = QR + (tok0 + c) * 512 + h * 128 + 8 * g;
#pragma unroll
                for (int ks = 0; ks < 4; ++ks) qf[ks] = ld8(qp + 32 * ks);
            }
            *(LAS u32x4*)(l3 + RO_K + krow * 256 + ((kch ^ (krow & 15)) * 16)) = kreg;
#pragma unroll
            for (int q = 0; q < 2; ++q) { const int cx = tid + 512 * q, e = cx >> 2, ch = cx & 3; *(LAS u32x4*)(l3 + RO_V + e * 64 + ((ch ^ ((e >> 1) & 3)) * 16)) = vreg[q]; }
            __syncthreads();
            f32x4 y[16];
#pragma unroll
            for (int et = 0; et < 16; ++et) {
                f32x4 a0 = (f32x4){0.f, 0.f, 0.f, 0.f};
                const int e = 16 * et + li;
#pragma unroll
                for (int ks = 0; ks < 4; ++ks) {
                    const bf16x8_t pf = *(const LAS bf16x8_t*)(l3 + RO_PREV + e * 256 + (((4 * ks + g) ^ (e & 15)) * 16));
                    a0 = __builtin_amdgcn_mfma_f32_16x16x32_bf16(pf, qf[ks], a0, 0, 0, 0);
                }
                y[et] = a0;
            }
#pragma unroll 1
            for (int s = 0; s < nstep; ++s) {
                const int buf = s & 1;
                if (s + 1 < nstep) {
                    kreg = *(const u32x4*)(KR + (tok0 + 32 * (s + 1) + krow) * 512 + h * 128 + kch * 8);
#pragma unroll
                    for (int q = 0; q < 2; ++q) { const int cx = tid + 512 * q, e = cx >> 2, ch = cx & 3; vreg[q] = *(const u32x4*)(VRT + ((size_t)bh * 256 + e) * S + n * 256 + 32 * (s + 1) + ch * 8); }
                }
                if (2 * s <= tg) {
                    f32x4 s0 = (f32x4){0.f, 0.f, 0.f, 0.f}, s1 = s0;
#pragma unroll
                    for (int ks = 0; ks < 4; ++ks) {
                        const bf16x8_t k0 = *(const LAS bf16x8_t*)(l3 + RO_K + buf * 8192 + li * 256 + (((4 * ks + g) ^ li) * 16));
                        const bf16x8_t k1 = *(const LAS bf16x8_t*)(l3 + RO_K + buf * 8192 + (16 + li) * 256 + (((4 * ks + g) ^ li) * 16));
                        s0 = __builtin_amdgcn_mfma_f32_16x16x32_bf16(k0, qf[ks], s0, 0, 0, 0);
                        s1 = __builtin_amdgcn_mfma_f32_16x16x32_bf16(k1, qf[ks], s1, 0, 0, 0);
                    }
                    const int m0 = 32 * s + 4 * g;
                    float p0[4], p1[4];
#pragma unroll
                    for (int r = 0; r < 4; ++r) { p0[r] = (m0 + r <= c) ? s0[r] : 0.f; p1[r] = (m0 + 16 + r <= c) ? s1[r] : 0.f; }
                    const bf16x8_t pf = __builtin_bit_cast(bf16x8_t, (u32x4){pk2(p0[0], p0[1]), pk2(p0[2], p0[3]), pk2(p1[0], p1[1]), pk2(p1[2], p1[3])});
#pragma unroll
                    for (int et = 0; et < 16; ++et) {
                        const int e = 16 * et + li, sw = (e >> 1) & 3;
                        const LAS unsigned char* vrow = l3 + RO_V + buf * 16384 + e * 64 + 8 * (g & 1);
                        const bf16x4_t a = *(const LAS bf16x4_t*)(vrow + (((g >> 1) ^ sw) * 16)), cq = *(const LAS bf16x4_t*)(vrow + ((((g >> 1) + 2) ^ sw) * 16));
                        const bf16x8_t vf = (bf16x8_t){a[0], a[1], a[2], a[3], cq[0], cq[1], cq[2], cq[3]};
                        y[et] = __builtin_amdgcn_mfma_f32_16x16x32_bf16(vf, pf, y[et], 0, 0, 0);
                    }
                }
                if (s + 1 < nstep) {
                    *(LAS u32x4*)(l3 + RO_K + (buf ^ 1) * 8192 + krow * 256 + ((kch ^ (krow & 15)) * 16)) = kreg;
#pragma unroll
                    for (int q = 0; q < 2; ++q) { const int cx = tid + 512 * q, e = cx >> 2, ch = cx & 3; *(LAS u32x4*)(l3 + RO_V + (buf ^ 1) * 16384 + e * 64 + ((ch ^ ((e >> 1) & 3)) * 16)) = vreg[q]; }
                }
                __syncthreads();
            }
            float sum = 0.f;
#pragma unroll
            for (int et = 0; et < 16; ++et) sum += (y[et][0] + y[et][1]) + (y[et][2] + y[et][3]);
            sum += __shfl_xor(sum, 16); sum += __shfl_xor(sum, 32);
            const float mu = sum * (1.0f / 256.0f);
            float sq = 0.f;
#pragma unroll
            for (int et = 0; et < 16; ++et) { y[et] = y[et] - mu; sq += (y[et][0] * y[et][0] + y[et][1] * y[et][1]) + (y[et][2] * y[et][2] + y[et][3] * y[et][3]); }
            sq += __shfl_xor(sq, 16); sq += __shfl_xor(sq, 32);
            const float rs = 1.0f / sqrtf(sq * (1.0f / 256.0f) + LN_EPS);
            const bf16_t* gp = GR + (tok0 + c) * 1024 + h * 256 + 4 * g;
            bf16_t* yp = YR + (tok0 + c) * 1024 + h * 256 + 4 * g;
#pragma unroll
            for (int et = 0; et < 16; ++et) {
                const u32x2 gg = *(const u32x2*)(gp + 16 * et);
                u32x2 o;
                o.x = pk2(y[et][0] * rs * __uint_as_float(gg.x << 16), y[et][1] * rs * __uint_as_float(gg.x & 0xffff0000u));
                o.y = pk2(y[et][2] * rs * __uint_as_float(gg.y << 16), y[et][3] * rs * __uint_as_float(gg.y & 0xffff0000u));
                *(u32x2*)(yp + 16 * et) = o;
            }
        }
    }
}
constexpr int MB_KOFF = 0, MB_VOFF = 32768, MB_STATE = 65536, MB_SSTR = 144, MB_LIST = MB_STATE + 256 * MB_SSTR, MB_CNT = MB_LIST + 32 * 256, MB_SCR = MB_CNT + 256, MB_SCR_W = 16 * 68 * 4;
static_assert(MB_SCR + 8 * MB_SCR_W <= 147200, "moba LDS map");
__device__ __forceinline__ void top3_insert(float v, int n, float& v0, float& v1, float& v2, int& i0, int& i1, int& i2) {
    const bool b0 = (v > v0) || (v == v0 && n < i0), b1 = (v > v1) || (v == v1 && n < i1), b2 = (v > v2) || (v == v2 && n < i2);
    const float nv2 = b1 ? v1 : (b2 ? v : v2); const int ni2 = b1 ? i1 : (b2 ? n : i2);
    const float nv1 = b0 ? v0 : (b1 ? v : v1); const int ni1 = b0 ? i0 : (b1 ? n : i1);
    v0 = b0 ? v : v0; i0 = b0 ? n : i0; v1 = nv1; i1 = ni1; v2 = nv2; i2 = ni2;
}
template <int NCG, bool OWN>
__device__ __forceinline__ void moba_block(LAS unsigned char* l3, int tile0, int ntile, const bf16x8_t (&qf)[NCG][2], const int (&qrow)[NCG], f32x4 (&o)[NCG][4], float (&mrun)[NCG], float (&lrun)[NCG], int g, int li) {
    constexpr float LOG2E = 1.4426950408889634f;
    const int sw = li & 7;
#pragma unroll 1
    for (int tt = tile0; tt < ntile; ++tt) {
        const LAS unsigned char* kbase = l3 + MB_KOFF + (64 * tt + li) * 128;
        const LAS unsigned char* vbase = l3 + MB_VOFF + (64 * tt + li) * 128;
        f32x4 sa[NCG][4];
#pragma unroll
        for (int kt = 0; kt < 4; ++kt) {
            const bf16x8_t k0 = *(const LAS bf16x8_t*)(kbase + kt * 2048 + ((g ^ sw) * 16)), k1 = *(const LAS bf16x8_t*)(kbase + kt * 2048 + (((4 + g) ^ sw) * 16));
#pragma unroll
            for (int cg = 0; cg < NCG; ++cg) {
                f32x4 a = __builtin_amdgcn_mfma_f32_16x16x32_bf16(k0, qf[cg][0], (f32x4){0.f, 0.f, 0.f, 0.f}, 0, 0, 0);
                sa[cg][kt] = __builtin_amdgcn_mfma_f32_16x16x32_bf16(k1, qf[cg][1], a, 0, 0, 0);
            }
        }
        bf16x8_t pf[NCG][2];
#pragma unroll
        for (int cg = 0; cg < NCG; ++cg) {
            float tm = NEGF;
#pragma unroll
            for (int kt = 0; kt < 4; ++kt)
#pragma unroll
                for (int r = 0; r < 4; ++r) {
                    float sv = sa[cg][kt][r] * LOG2E;
                    if (OWN) { const int key = 64 * tt + 16 * kt + 4 * g + r; sv = (key <= qrow[cg]) ? sv : NEGF; }
                    sa[cg][kt][r] = sv; tm = fmaxf(tm, sv);
                }
            tm = fmaxf(tm, __shfl_xor(tm, 16)); tm = fmaxf(tm, __shfl_xor(tm, 32));
            const float mn = fmaxf(mrun[cg], tm);
            const float alpha = __builtin_amdgcn_exp2f(mrun[cg] - mn);
            mrun[cg] = mn;
            float ps = 0.f;
#pragma unroll
            for (int kt = 0; kt < 4; ++kt)
#pragma unroll
                for (int r = 0; r < 4; ++r) { const float p = __builtin_amdgcn_exp2f(sa[cg][kt][r] - mn); sa[cg][kt][r] = p; ps += p; }
            lrun[cg] = lrun[cg] * alpha + ps;
#pragma unroll
            for (int dt = 0; dt < 4; ++dt) o[cg][dt] = o[cg][dt] * alpha;
#pragma unroll
            for (int s2 = 0; s2 < 2; ++s2)
                pf[cg][s2] = __builtin_bit_cast(bf16x8_t, (u32x4){pk2(sa[cg][2 * s2][0], sa[cg][2 * s2][1]), pk2(sa[cg][2 * s2][2], sa[cg][2 * s2][3]),
                                                                   pk2(sa[cg][2 * s2 + 1][0], sa[cg][2 * s2 + 1][1]), pk2(sa[cg][2 * s2 + 1][2], sa[cg][2 * s2 + 1][3])});
        }
#pragma unroll
        for (int dt = 0; dt < 4; ++dt)
#pragma unroll
            for (int s2 = 0; s2 < 2; ++s2) {
                const int c0 = 4 * s2 + (g >> 1);
                const bf16x4_t a = *(const LAS bf16x4_t*)(vbase + dt * 2048 + ((c0 ^ sw) * 16) + 8 * (g & 1)), c = *(const LAS bf16x4_t*)(vbase + dt * 2048 + (((c0 + 2) ^ sw) * 16) + 8 * (g & 1));
                const bf16x8_t vf = (bf16x8_t){a[0], a[1], a[2], a[3], c[0], c[1], c[2], c[3]};
#pragma unroll
                for (int cg = 0; cg < NCG; ++cg) o[cg][dt] = __builtin_amdgcn_mfma_f32_16x16x32_bf16(vf, pf[cg][s2], o[cg][dt], 0, 0, 0);
            }
    }
}
__device__ __forceinline__ void moba_past_group(LAS unsigned char* l3, const bf16x8_t (&qf)[2], f32x4 (&o)[4], float& mout, float& lout, int g, int li) {
    constexpr float LOG2E = 1.4426950408889634f;
    const int sw = li & 7;
    f32x4 sa[16];
#pragma unroll
    for (int t = 0; t < 16; ++t) {
        const LAS unsigned char* kbase = l3 + MB_KOFF + (16 * t + li) * 128;
        const bf16x8_t k0 = *(const LAS bf16x8_t*)(kbase + ((g ^ sw) * 16)), k1 = *(const LAS bf16x8_t*)(kbase + (((4 + g) ^ sw) * 16));
        f32x4 a = __builtin_amdgcn_mfma_f32_16x16x32_bf16(k0, qf[0], (f32x4){0.f, 0.f, 0.f, 0.f}, 0, 0, 0);
        sa[t] = __builtin_amdgcn_mfma_f32_16x16x32_bf16(k1, qf[1], a, 0, 0, 0);
    }
    float tm = NEGF;
#pragma unroll
    for (int t = 0; t < 16; ++t) { sa[t] = sa[t] * LOG2E; tm = fmaxf(fmaxf(tm, fmaxf(sa[t][0], sa[t][1])), fmaxf(sa[t][2], sa[t][3])); }
    tm = fmaxf(tm, __shfl_xor(tm, 16)); tm = fmaxf(tm, __shfl_xor(tm, 32));
    float ps = 0.f;
    bf16x8_t pf[8];
#pragma unroll
    for (int u = 0; u < 8; ++u) {
        float p[8];
#pragma unroll
        for (int r = 0; r < 4; ++r) { p[r] = __builtin_amdgcn_exp2f(sa[2 * u][r] - tm); p[4 + r] = __builtin_amdgcn_exp2f(sa[2 * u + 1][r] - tm); }
        ps += ((p[0] + p[1]) + (p[2] + p[3])) + ((p[4] + p[5]) + (p[6] + p[7]));
        pf[u] = __builtin_bit_cast(bf16x8_t, (u32x4){pk2(p[0], p[1]), pk2(p[2], p[3]), pk2(p[4], p[5]), pk2(p[6], p[7])});
    }
#pragma unroll
    for (int dt = 0; dt < 4; ++dt) {
        f32x4 acc = (f32x4){0.f, 0.f, 0.f, 0.f};
#pragma unroll
        for (int u = 0; u < 8; ++u) {
            const LAS unsigned char* vbase = l3 + MB_VOFF + (64 * (u >> 1) + 16 * dt + li) * 128 + 8 * (g & 1);
            const int c0 = 4 * (u & 1) + (g >> 1);
            const bf16x4_t a = *(const LAS bf16x4_t*)(vbase + ((c0 ^ sw) * 16)), c = *(const LAS bf16x4_t*)(vbase + (((c0 + 2) ^ sw) * 16));
            acc = __builtin_amdgcn_mfma_f32_16x16x32_bf16((bf16x8_t){a[0], a[1], a[2], a[3], c[0], c[1], c[2], c[3]}, pf[u], acc, 0, 0, 0);
        }
        o[dt] = acc;
    }
    mout = tm; lout = ps;
}
__device__ __forceinline__ void ph_moba_own(const bf16_t* QA, const bf16_t* KA, const bf16_t* VAT, const float* KMP, LAS unsigned char* l3, unsigned* SEL, bf16_t* OWNO, float* OWNML) {
    const int tid = (int)tidx(), lane = tid & 63, g = lane >> 4, li = lane & 15;
    const int wave = __builtin_amdgcn_readfirstlane(tid >> 6);
    const int gd_ = (int)gdim(), bx0_ = (int)bidx();
    const int vcu = (gd_ % 8 == 0) ? (bx0_ % 8) * (gd_ / 8) + bx0_ / 8 : bx0_;
#pragma unroll 1
    for (int it = vcu; it < 512; it += gd_) {
        const int bh = (it & 255) >> 4, ii = it & 15, i = (it < 256) ? ii : 31 - ii;
        const int b = bh >> 3, h = bh & 7;
        const size_t tok0 = (size_t)b * S + (size_t)i * 256;
        u32x4 kreg[4], vreg[4];
        {
            const bf16_t* kg = KA + tok0 * 512 + h * 64;
            const bf16_t* vg = VAT + ((size_t)bh * 128 + (size_t)i * 4) * 4096;
#pragma unroll
            for (int q = 0; q < 4; ++q) { const int c = tid + 512 * q, row = c >> 3, ch = c & 7; kreg[q] = *(const u32x4*)((const char*)kg + (unsigned)((row * 512 + ch * 8) * 2)); vreg[q] = *(const u32x4*)((const char*)vg + (unsigned)(c * 16)); }
        }
#pragma unroll
        for (int q = 0; q < 4; ++q) {
            const int c = tid + 512 * q, row = c >> 3, ch = c & 7;
            *(LAS u32x4*)(l3 + MB_KOFF + row * 128 + ((ch ^ (row & 7)) * 16)) = kreg[q];
            *(LAS u32x4*)(l3 + MB_VOFF + row * 128 + ((ch ^ (row & 7)) * 16)) = vreg[q];
        }
        bf16x8_t qf[2][2];
#pragma unroll
        for (int cg = 0; cg < 2; ++cg)
#pragma unroll
            for (int ks = 0; ks < 2; ++ks) qf[cg][ks] = ld8(QA + (tok0 + 32 * wave + 16 * cg + li) * 512 + h * 64 + 32 * ks + 8 * g);
        __syncthreads();
        if (i == 0) { if (g == 0) { SEL[(size_t)bh * 8192 + 32 * wave + li] = 0x404040u; SEL[(size_t)bh * 8192 + 32 * wave + 16 + li] = 0x404040u; } }
        if (i > 0) {
            f32x4 ga[2][2];
#pragma unroll
            for (int cg = 0; cg < 2; ++cg)
#pragma unroll
                for (int nt = 0; nt < 2; ++nt) ga[cg][nt] = (f32x4){0.f, 0.f, 0.f, 0.f};
#pragma unroll
            for (int nt = 0; nt < 2; ++nt)
#pragma unroll
                for (int ks = 0; ks < 2; ++ks) {
                    const float* kp = KMP + ((size_t)((b * 32 + 16 * nt + li) * 2)) * 512 + h * 64 + 32 * ks + 8 * g;
                    const f32x4 a0 = *(const f32x4*)kp + *(const f32x4*)(kp + 512), a1 = *(const f32x4*)(kp + 4) + *(const f32x4*)(kp + 516);
                    const float km[8] = {a0[0], a0[1], a0[2], a0[3], a1[0], a1[1], a1[2], a1[3]};
                    unsigned hi[4], lo[4];
#pragma unroll
                    for (int e = 0; e < 4; ++e) {
                        const unsigned h0 = f2bf(km[2 * e]), h1 = f2bf(km[2 * e + 1]);
                        hi[e] = h0 | (h1 << 16);
                        lo[e] = pk2(km[2 * e] - __uint_as_float(h0 << 16), km[2 * e + 1] - __uint_as_float(h1 << 16));
                    }
                    const bf16x8_t fh = __builtin_bit_cast(bf16x8_t, (u32x4){hi[0], hi[1], hi[2], hi[3]}), fl = __builtin_bit_cast(bf16x8_t, (u32x4){lo[0], lo[1], lo[2], lo[3]});
#pragma unroll
                    for (int cg = 0; cg < 2; ++cg) {
                        ga[cg][nt] = __builtin_amdgcn_mfma_f32_16x16x32_bf16(fh, qf[cg][ks], ga[cg][nt], 0, 0, 0);
                        ga[cg][nt] = __builtin_amdgcn_mfma_f32_16x16x32_bf16(fl, qf[cg][ks], ga[cg][nt], 0, 0, 0);
                    }
                }
#pragma unroll
            for (int cg = 0; cg < 2; ++cg) {
                float v0 = NEGF, v1 = NEGF, v2 = NEGF; int i0 = 64, i1 = 64, i2 = 64;
#pragma unroll
                for (int nt = 0; nt < 2; ++nt)
#pragma unroll
                    for (int r = 0; r < 4; ++r) { const int n = 16 * nt + 4 * g + r; if (n < i) top3_insert(ga[cg][nt][r], n, v0, v1, v2, i0, i1, i2); }
#pragma unroll
                for (int o = 16; o <= 32; o <<= 1) {
                    const float w0 = __shfl_xor(v0, o), w1 = __shfl_xor(v1, o), w2 = __shfl_xor(v2, o);
                    const int j0 = __shfl_xor(i0, o), j1 = __shfl_xor(i1, o), j2 = __shfl_xor(i2, o);
                    if (j0 < 64) top3_insert(w0, j0, v0, v1, v2, i0, i1, i2);
                    if (j1 < 64) top3_insert(w1, j1, v0, v1, v2, i0, i1, i2);
                    if (j2 < 64) top3_insert(w2, j2, v0, v1, v2, i0, i1, i2);
                }
                if (g == 0) SEL[(size_t)bh * 8192 + i * 256 + 32 * wave + 16 * cg + li] = (unsigned)i0 | ((unsigned)i1 << 8) | ((unsigned)i2 << 16);
            }
        }
        {
            f32x4 o[2][4]; float mrun[2], lrun[2]; int qrow[2];
#pragma unroll
            for (int cg = 0; cg < 2; ++cg) { mrun[cg] = NEGF; lrun[cg] = 0.f; qrow[cg] = 32 * wave + 16 * cg + li;
#pragma unroll
                for (int dt = 0; dt < 4; ++dt) o[cg][dt] = (f32x4){0.f, 0.f, 0.f, 0.f}; }
            moba_block<2, true>(l3, 0, (32 * wave + 31) / 64 + 1, qf, qrow, o, mrun, lrun, g, li);
#pragma unroll
            for (int cg = 0; cg < 2; ++cg) {
                float l = lrun[cg]; l += __shfl_xor(l, 16); l += __shfl_xor(l, 32);
                const size_t qi = (size_t)bh * 8192 + i * 256 + qrow[cg];
#pragma unroll
                for (int dt = 0; dt < 4; ++dt) { u32x2 w; w.x = pk2(o[cg][dt][0], o[cg][dt][1]); w.y = pk2(o[cg][dt][2], o[cg][dt][3]); *(u32x2*)(OWNO + qi * 64 + 16 * dt + 4 * g) = w; }
                if (g == 0) *(float2*)(OWNML + qi * 2) = make_float2(mrun[cg], l);
            }
        }
        __syncthreads();
    }
}

constexpr int MBU_MAX = 3;
__device__ const unsigned MBU_TAB[16][MBU_MAX] = {
    {0x00200908u, 0x00201413u, 0xFFFFFFFFu},
    {0x00200A09u, 0x00201312u, 0x00201E1Du},
    {0x000C0403u, 0x00201211u, 0xFFFFFFFFu},
    {0x00060201u, 0x00070400u, 0xFFFFFFFFu},
    {0x00200B0Au, 0x00201110u, 0xFFFFFFFFu},
    {0x000D0504u, 0x0020100Fu, 0x00201D1Cu},
    {0x00200C03u, 0x00100807u, 0x00201F1Eu},
    {0x00200C0Bu, 0x00201007u, 0x00201A19u},
    {0x00040100u, 0x00200F0Eu, 0xFFFFFFFFu},
    {0x00070302u, 0x00200F06u, 0x00201C1Bu},
    {0x00200D01u, 0x000F0706u, 0x00201B1Au},
    {0x00200D04u, 0x00200F00u, 0x00201817u},
    {0x00200D0Cu, 0x00200F02u, 0x00201918u},
    {0x000E0605u, 0x000F0702u, 0x00201716u},
    {0x00200E05u, 0x000D0601u, 0x00201615u},
    {0x00200E0Du, 0x000F0700u, 0x00201514u}
};
constexpr int MP_LIST = 65536, MP_CNT = MP_LIST + 16384, MP_PSTR = 136;
__device__ __forceinline__ void ph_moba_past(const bf16_t* QA, const bf16_t* KA, const bf16_t* VAT, const unsigned* SEL, unsigned char* PART, LAS unsigned char* l3) {
    const int tid = (int)tidx();
    const int wave = __builtin_amdgcn_readfirstlane(tid >> 6);
    LAS unsigned short* listL = (LAS unsigned short*)(l3 + MP_LIST);
    LAS int* cntL = (LAS int*)(l3 + MP_CNT);
    const int gd_ = (int)gdim(), bx0_ = (int)bidx();
    const int vcu = (gd_ % 8 == 0) ? (bx0_ % 8) * (gd_ / 8) + bx0_ / 8 : bx0_;
#pragma unroll 1
    for (int slot = vcu; slot < 256; slot += gd_) {
        const int bh = slot >> 4, bin = slot & 15, b = bh >> 3, h = bh & 7;
#pragma unroll 1
        for (int un = 0; un < MBU_MAX; ++un) {
            const unsigned ud = MBU_TAB[bin][un];
            if (ud == 0xFFFFFFFFu) break;
            const int j = (int)(ud & 255u), ilo = (int)((ud >> 8) & 255u), ihi = (int)((ud >> 16) & 255u);
            __syncthreads();
            {
                const bf16_t* kg = KA + ((size_t)b * S + (size_t)j * 256) * 512 + h * 64;
                const bf16_t* vg = VAT + ((size_t)bh * 128 + (size_t)j * 4) * 4096;
#pragma unroll
                for (int q4 = 0; q4 < 4; ++q4) {
                    const int c = tid + 512 * q4, row = c >> 3, ch = c & 7;
                    const u32x4 kv = *(const u32x4*)((const char*)kg + (unsigned)((row * 512 + ch * 8) * 2)), vv = *(const u32x4*)((const char*)vg + (unsigned)(c * 16));
                    *(LAS u32x4*)(l3 + MB_KOFF + row * 128 + ((ch ^ (row & 7)) * 16)) = kv;
                    *(LAS u32x4*)(l3 + MB_VOFF + row * 128 + ((ch ^ (row & 7)) * 16)) = vv;
                }
            }
            if (tid == 0) cntL[0] = 0;
            __syncthreads();
            const int nq = (ihi - ilo) * 256;
#pragma unroll 1
            for (int e0 = 0; e0 < nq; e0 += 4096) {
                unsigned sw8[8];
#pragma unroll
                for (int k = 0; k < 8; ++k) { const int e = e0 + tid + 512 * k; sw8[k] = SEL[(size_t)bh * 8192 + ilo * 256 + (e < nq ? e : 0)]; }
#pragma unroll
                for (int k = 0; k < 8; ++k) {
                    const int e = e0 + tid + 512 * k, gq = ilo * 256 + e;
                    const unsigned sw_ = sw8[k];
                    const int s0 = (int)(sw_ & 255u), s1 = (int)((sw_ >> 8) & 255u), s2 = (int)((sw_ >> 16) & 255u);
                    const int r = (s0 == j) ? 0 : (s1 == j) ? 1 : (s2 == j) ? 2 : -1;
                    if (e < nq && r >= 0) { const int p = __hip_atomic_fetch_add(cntL, 1, __ATOMIC_RELAXED, __HIP_MEMORY_SCOPE_WORKGROUP); listL[p] = (unsigned short)(gq | (r << 13)); }
                }
            }
            __syncthreads();
            const int cnt = cntL[0];
            const int ng = (cnt + 15) >> 4;
#pragma unroll 1
            for (int gi = 2 * wave; gi < ng; gi += 16) {
                const int lane_ = (int)tidx() & 63, g = lane_ >> 4, li = lane_ & 15;
                if (gi + 1 < ng) {
                    bf16x8_t qf[2][2]; int gqs[2], rs[2]; bool vals[2]; int qrow[2] = {0, 0};
#pragma unroll
                    for (int cg = 0; cg < 2; ++cg) {
                        const int ei = (gi + cg) * 16 + li;
                        vals[cg] = ei < cnt;
                        const unsigned ent = listL[vals[cg] ? ei : (gi + cg) * 16];
                        gqs[cg] = (int)(ent & 8191u); rs[cg] = (int)(ent >> 13);
#pragma unroll
                        for (int ks = 0; ks < 2; ++ks) qf[cg][ks] = ld8(QA + ((size_t)b * S + gqs[cg]) * 512 + h * 64 + 32 * ks + 8 * g);
                    }
                    f32x4 o[2][4]; float mrun[2], lrun[2];
#pragma unroll
                    for (int cg = 0; cg < 2; ++cg) { mrun[cg] = NEGF; lrun[cg] = 0.f;
#pragma unroll
                        for (int dt = 0; dt < 4; ++dt) o[cg][dt] = (f32x4){0.f, 0.f, 0.f, 0.f}; }
                    moba_block<2, false>(l3, 0, 4, qf, qrow, o, mrun, lrun, g, li);
#pragma unroll
                    for (int cg = 0; cg < 2; ++cg) {
                        float l = lrun[cg]; l += __shfl_xor(l, 16); l += __shfl_xor(l, 32);
                        if (vals[cg]) {
                            unsigned char* sp = PART + (((size_t)bh * 8192 + gqs[cg]) * 3 + rs[cg]) * MP_PSTR;
#pragma unroll
                            for (int dt = 0; dt < 4; ++dt) { u32x2 w; w.x = pk2(o[cg][dt][0], o[cg][dt][1]); w.y = pk2(o[cg][dt][2], o[cg][dt][3]); *(u32x2*)(sp + (16 * dt + 4 * g) * 2) = w; }
                            if (g == 0) *(float2*)(sp + 128) = make_float2(mrun[cg], l);
                        }
                    }
                } else {
                    const int ei = gi * 16 + li;
                    const bool valid = ei < cnt;
                    const unsigned ent = listL[valid ? ei : gi * 16];
                    const int gq = (int)(ent & 8191u), r = (int)(ent >> 13);
                    bf16x8_t qg[1][2];
#pragma unroll
                    for (int ks = 0; ks < 2; ++ks) qg[0][ks] = ld8(QA + ((size_t)b * S + gq) * 512 + h * 64 + 32 * ks + 8 * g);
                    f32x4 o[1][4]; float mg[1] = {NEGF}, lg_[1] = {0.f}; int qrow1[1] = {0};
#pragma unroll
                    for (int dt = 0; dt < 4; ++dt) o[0][dt] = (f32x4){0.f, 0.f, 0.f, 0.f};
                    moba_block<1, false>(l3, 0, 4, qg, qrow1, o, mg, lg_, g, li);
                    float l = lg_[0]; l += __shfl_xor(l, 16); l += __shfl_xor(l, 32);
                    if (valid) {
                        unsigned char* sp = PART + (((size_t)bh * 8192 + gq) * 3 + r) * MP_PSTR;
#pragma unroll
                        for (int dt = 0; dt < 4; ++dt) { u32x2 w; w.x = pk2(o[0][dt][0], o[0][dt][1]); w.y = pk2(o[0][dt][2], o[0][dt][3]); *(u32x2*)(sp + (16 * dt + 4 * g) * 2) = w; }
                        if (g == 0) *(float2*)(sp + 128) = make_float2(mg[0], l);
                    }
                }
            }
        }
    }
    __syncthreads();
}
__device__ __forceinline__ void ph_moba_merge(bf16_t* YA, const bf16_t* OWNO, const float* OWNML, const unsigned* SEL, const unsigned char* PART, unsigned gtid, unsigned gthreads) {
#pragma unroll 1
    for (unsigned w = gtid; w < 16u * 8192u * 4u; w += gthreads) {
        const unsigned dt = w & 3u, idx = w >> 2;
        const unsigned bh = idx >> 13, gq = idx & 8191u, b = bh >> 3, h = bh & 7u;
        const unsigned sw_ = SEL[idx];
        const float2 oml = *(const float2*)(OWNML + 2 * (size_t)idx);
        float m[3], l[3];
#pragma unroll
        for (int r = 0; r < 3; ++r) {
            const bool val = ((sw_ >> (8 * r)) & 255u) < 64u;
            const unsigned char* sp = PART + ((size_t)idx * 3 + r) * MP_PSTR;
            m[r] = val ? *(const float*)(sp + 128) : NEGF; l[r] = val ? *(const float*)(sp + 132) : 0.f;
        }
        const float mn = fmaxf(fmaxf(oml.x, m[0]), fmaxf(m[1], m[2]));
        const float a0 = __builtin_amdgcn_exp2f(oml.x - mn);
        float ar[3];
#pragma unroll
        for (int r = 0; r < 3; ++r) ar[r] = (l[r] > 0.f) ? __builtin_amdgcn_exp2f(m[r] - mn) : 0.f;
        const float inv = 1.0f / (oml.y * a0 + l[0] * ar[0] + l[1] * ar[1] + l[2] * ar[2]);
        float acc[16];
        {
            const u32x4 x0 = *(const u32x4*)(OWNO + (size_t)idx * 64 + 16 * dt), x1 = *(const u32x4*)(OWNO + (size_t)idx * 64 + 16 * dt + 8);
            const unsigned xs[8] = {x0.x, x0.y, x0.z, x0.w, x1.x, x1.y, x1.z, x1.w};
#pragma unroll
            for (int e = 0; e < 8; ++e) { acc[2 * e] = __uint_as_float(xs[e] << 16) * a0; acc[2 * e + 1] = __uint_as_float(xs[e] & 0xffff0000u) * a0; }
        }
#pragma unroll
        for (int r = 0; r < 3; ++r) {
            if (ar[r] > 0.f) {
                const unsigned char* sp = PART + ((size_t)idx * 3 + r) * MP_PSTR + dt * 32;
#pragma unroll
                for (int e2 = 0; e2 < 4; ++e2) {
                    const u32x2 xw = *(const u32x2*)(sp + 8 * e2);
                    acc[4 * e2] += __uint_as_float(xw.x << 16) * ar[r]; acc[4 * e2 + 1] += __uint_as_float(xw.x & 0xffff0000u) * ar[r];
                    acc[4 * e2 + 2] += __uint_as_float(xw.y << 16) * ar[r]; acc[4 * e2 + 3] += __uint_as_float(xw.y & 0xffff0000u) * ar[r];
                }
            }
        }
        u32x4 y0, y1;
        y0.x = pk2(acc[0] * inv, acc[1] * inv); y0.y = pk2(acc[2] * inv, acc[3] * inv); y0.z = pk2(acc[4] * inv, acc[5] * inv); y0.w = pk2(acc[6] * inv, acc[7] * inv);
        y1.x = pk2(acc[8] * inv, acc[9] * inv); y1.y = pk2(acc[10] * inv, acc[11] * inv); y1.z = pk2(acc[12] * inv, acc[13] * inv); y1.w = pk2(acc[14] * inv, acc[15] * inv);
        bf16_t* yp = YA + ((size_t)b * S + gq) * 512 + h * 64 + 16 * dt;
        *(u32x4*)yp = y0; *(u32x4*)(yp + 8) = y1;
    }
}
#define XB_TMO      128
#define XB_XCNT(j)  (256  + 64 * (j))
#define XB_XSUB(j)  (1280 + 64 * (j))
#define XB_XGEN(j)  (2304 + 64 * (j))
#define XB_TOP      3328
#define XB_TOPGEN   3392
#define XCD_BAR_WORDS 3456
#define XB_SPIN_CAP (1u << 24)
__device__ __forceinline__ unsigned xb_ld(unsigned* p)              { return __hip_atomic_load(p, __ATOMIC_RELAXED, __HIP_MEMORY_SCOPE_AGENT); }
__device__ __forceinline__ unsigned xb_add(unsigned* p, unsigned v) { return __hip_atomic_fetch_add(p, v, __ATOMIC_RELAXED, __HIP_MEMORY_SCOPE_AGENT); }
__device__ __forceinline__ unsigned xb_xcc_id() { return (unsigned)__builtin_amdgcn_s_getreg((3 << 11) | 20) & 0xFu; }
#define XB_SPIN(cond, bar) do { unsigned _sp = 0; while (cond) { __builtin_amdgcn_s_sleep(1); \
    if ((++_sp & 255u) == 0u) { if (xb_ld(&(bar)[XB_TMO])) break; if (_sp > XB_SPIN_CAP) { atomicAdd(&(bar)[XB_TMO], 1u); break; } } } } while (0)
struct XcdBarrier { unsigned* bar; unsigned x; volatile LAS unsigned* st; };
__device__ __forceinline__ XcdBarrier xcd_barrier_post(unsigned* bar, volatile LAS unsigned* st) {
    XcdBarrier b; b.bar = bar; b.x = xb_xcc_id(); b.st = st;
    if (threadIdx.x == 0) (void)xb_add(&bar[XB_XCNT(b.x)], 1u);
    return b;
}
__device__ __forceinline__ void xcd_barrier_complete(unsigned* bar, unsigned x, unsigned& nloc, unsigned& nx) {
    const unsigned G = gridDim.x * gridDim.y * gridDim.z;
    unsigned sum, cnt, mine, sp = 0u;
    for (;;) {
        sum = 0u; cnt = 0u; mine = 0u;
#pragma unroll
        for (unsigned j = 0; j < 16; ++j) { const unsigned c = xb_ld(&bar[XB_XCNT(j)]); sum += c; cnt += (c > 0u) ? 1u : 0u; mine = (j == x) ? c : mine; }
        if (sum == G) break;
        __builtin_amdgcn_s_sleep(1);
        if ((++sp & 255u) == 0u) { if (xb_ld(&bar[XB_TMO])) break; if (sp > XB_SPIN_CAP) { atomicAdd(&bar[XB_TMO], 1u); break; } }
    }
    nloc = mine > 0u ? mine : 1u; nx = cnt > 0u ? cnt : 1u;
}
__device__ __forceinline__ void xcd_barrier(const XcdBarrier& b) {
    asm volatile("s_waitcnt vmcnt(0)" ::: "memory");
    __syncthreads();
    if (threadIdx.x == 0) {
        unsigned* bar = b.bar;
        __builtin_amdgcn_s_waitcnt(0);
        unsigned nloc = b.st[0], nx = b.st[1];
        if (nloc == 0u) { xcd_barrier_complete(bar, b.x, nloc, nx); b.st[0] = nloc; b.st[1] = nx; }
        const unsigned old = xb_add(&bar[XB_XSUB(b.x)], 1u);
        const unsigned gen = old / nloc;
        if (old + 1u == (gen + 1u) * nloc) {
            __builtin_amdgcn_fence(__ATOMIC_RELEASE, "agent");
            asm volatile("s_waitcnt vmcnt(0)" ::: "memory");
            const unsigned og = xb_add(&bar[XB_TOP], 1u);
            const unsigned tg = og / nx;
            if (og + 1u == (tg + 1u) * nx) xb_add(&bar[XB_TOPGEN], 1u);
            else XB_SPIN(xb_ld(&bar[XB_TOPGEN]) == tg, bar);
            __builtin_amdgcn_fence(__ATOMIC_ACQUIRE, "agent");
            xb_add(&bar[XB_XGEN(b.x)], 1u);
            asm volatile("s_waitcnt vmcnt(0)" ::: "memory");
        } else {
            XB_SPIN(xb_ld(&bar[XB_XGEN(b.x)]) == gen, bar);
            __builtin_amdgcn_fence(__ATOMIC_ACQUIRE, "agent");
            asm volatile("s_waitcnt vmcnt(0)" ::: "memory");
        }
    }
    __syncthreads();
}

constexpr int LDS_BYTES = 147456;
constexpr int RING_BYTES = 131072;
constexpr int MISC_OFF = 147200;
struct Params {
    const float* in[13];
    float* out;
    unsigned char* ws;
};
typedef const __attribute__((address_space(4))) unsigned char* kargp_t;
__device__ __forceinline__ unsigned char* karg(int byte_off) {
    kargp_t k = (kargp_t)__builtin_amdgcn_kernarg_segment_ptr();
    asm volatile("" : "+s"(k));
    return *(unsigned char* const __attribute__((address_space(4)))*)(k + byte_off);
}
#define WSB() (karg(112))
__device__ __forceinline__ int launder_s(int v) { asm volatile("" : "+s"(v)); return v; }
#define GRIDX() launder_s((int)gridDim.x)
#define BLKX() launder_s((int)blockIdx.x)
#define INP(i) ((const float*)karg(8 * (i)))
#define OUTP() ((float*)karg(104))
#define GSYNC() do { XcdBarrier bar_; bar_.bar = (unsigned*)WSB() + 4096; bar_.x = xb_xcc_id(); bar_.st = (volatile LAS unsigned*)((LAS unsigned char*)lds + MISC_OFF) + 8; xcd_barrier(bar_); } while (0)
extern __shared__ __attribute__((aligned(16))) unsigned char lds[];
#define L3 ((LAS unsigned char*)lds)
#define LANE ((int)(tidx() & 63))
#define WAVE (__builtin_amdgcn_readfirstlane((int)(tidx() >> 6)))
#define GTID ((size_t)bidx() * 512 + tidx())
#define GTHREADS ((size_t)gdim() * 512)
__device__ __forceinline__ void prologue_body() {
    {
        unsigned char* ws = WSB();
        const int lane = LANE, wave = WAVE;
        const int gw = bidx() * 8 + wave, NGW = gdim() * 8;
        LAS float* scr = (LAS float*)(L3 + wave * 16384);
        constexpr int I_IN = (D / 64) * (INW / 32), I_MO = (512 / 64) * (D / 32), I_RO = (D / 64) * (D / 32), I_O = I_RO, I_Q = (D / 64) * (2048 / 32);
        constexpr int PER_L = I_IN + I_MO + I_RO + I_O + I_Q;
        for (int it = gw; it < 2 * PER_L; it += NGW) {
            const int l = it / PER_L; int r = it % PER_L;
            if (r < I_IN) { p0_transpose_item<true>(INP(1) + (size_t)l * D * INW, D, INW, (bf16_t*)(ws + WS_WIN) + (size_t)l * WIN_ROWS * D, scr, r, lane); continue; } r -= I_IN;
            if (r < I_MO) { p0_transpose_item<false>(INP(2) + (size_t)l * 512 * D, 512, D, (bf16_t*)(ws + WS_WMO) + (size_t)l * D * 512, scr, r, lane); continue; } r -= I_MO;
            if (r < I_RO) { p0_transpose_item<false>(INP(3) + (size_t)l * D * D, D, D, (bf16_t*)(ws + WS_WRO) + (size_t)l * D * D, scr, r, lane); continue; } r -= I_RO;
            if (r < I_O) { p0_transpose_item<false>(INP(4) + (size_t)l * D * D, D, D, (bf16_t*)(ws + WS_WO) + (size_t)l * D * D, scr, r, lane); continue; } r -= I_O;
            p0_transpose_item<false>(INP(7) + (size_t)l * D * 2048, D, 2048, (bf16_t*)(ws + WS_WQ) + (size_t)l * 2048 * D, scr, r, lane, INP(5) + l * D);
        }
        Tables tb; tb.qdec = (float*)(ws + WS_TBL); tb.kdec = tb.qdec + 1024; tb.ropeA = (float*)(ws + WS_ROPEA); tb.ropeR = (float*)(ws + WS_ROPER); tb.ropeRT = (float*)(ws + WS_ROPERT);
        cvt_copy(INP(8), (bf16_t*)(ws + WS_KEYS), (size_t)2 * 2 * PNK * PKD, GTID, GTHREADS);
        p0_csum_part(INP(7), INP(5), INP(6), (float*)(ws + WS_TBL + TB_PARTC), (float*)(ws + WS_TBL + TB_PARTB));
        __syncthreads();
        p0_tables(tb, GTID, GTHREADS, (LAS float*)L3);
        cvt_copy(INP(0), (bf16_t*)(ws + WS_XB), (size_t)T * D, GTID, GTHREADS);
    }
}
template <int l> __device__ __forceinline__ void layer_body() {
        {
            unsigned char* ws = WSB();
            pg8::Gemm g{(bf16_t*)(ws + WS_XB), (bf16_t*)(ws + WS_WIN) + (size_t)l * WIN_ROWS * D, T, WIN_NROWS, D}; pg8::StaticOrder So; So.init(T, WIN_NROWS, GRIDX(), BLKX());
            EpiProjAll E{ws};
            pg8::gemm_phase<EpiProjAll, pg8::StaticOrder, true, true>(L3, g, So, E);
        }
        {
            unsigned char* ws = WSB();
            pg8::Gemm g{(bf16_t*)(ws + WS_WIN) + ((size_t)l * WIN_ROWS + WIN_NROWS) * D, (bf16_t*)(ws + WS_XB), WIN_SROWS, T, D}; pg8::StaticOrder So; So.init(WIN_SROWS, T, GRIDX(), BLKX());
            EpiProjS E{ws};
            pg8::gemm_phase<EpiProjS, pg8::StaticOrder, true, true>(L3, g, So, E);
        }
        GSYNC();
        {
            unsigned char* ws = WSB();
            if (l == 0) p0_csum_reduce((const float*)(ws + WS_TBL + TB_PARTC), (const float*)(ws + WS_TBL + TB_PARTB), (float*)(ws + WS_TBL + TB_CSUM), (float*)(ws + WS_TBL + TB_BQ));
            ph_moba_own((const bf16_t*)(ws + WS_QA), (const bf16_t*)(ws + WS_KA), (const bf16_t*)(ws + WS_VAT), (const float*)(ws + WS_KMP), L3, (unsigned*)(ws + WS_MSEL), (bf16_t*)(ws + WS_MOWNO), (float*)(ws + WS_MOWNML));
            ph_retkv((const bf16_t*)(ws + WS_VRT), (const bf16_t*)(ws + WS_KRT), (float*)(ws + WS_KVT), L3);
        }
        GSYNC();
        { unsigned char* ws = WSB(); ph_moba_past((const bf16_t*)(ws + WS_QA), (const bf16_t*)(ws + WS_KA), (const bf16_t*)(ws + WS_VAT), (const unsigned*)(ws + WS_MSEL), ws + WS_MPART, L3); }
        { unsigned char* ws = WSB(); ph_retscan((const float*)(ws + WS_KVT), (bf16_t*)(ws + WS_PREVT));
          ph_kc_kb(INP(8) + (size_t)l * 2 * PNK * PKD, (const float*)(ws + WS_TBL + TB_CSUM) + l * 2048, (const float*)(ws + WS_TBL + TB_BQ) + l * 2048, (float*)(ws + WS_TBL + TB_KC), (float*)(ws + WS_TBL + TB_KB)); }
        GSYNC();
        { unsigned char* ws = WSB(); ph_retout((const bf16_t*)(ws + WS_QR), (const bf16_t*)(ws + WS_KR), (const bf16_t*)(ws + WS_VRT), (const bf16_t*)(ws + WS_PREVT), (const bf16_t*)(ws + WS_GR), (bf16_t*)(ws + WS_YR), L3); }
        { unsigned char* ws = WSB(); ph_moba_merge((bf16_t*)(ws + WS_QA), (const bf16_t*)(ws + WS_MOWNO), (const float*)(ws + WS_MOWNML), (const unsigned*)(ws + WS_MSEL), ws + WS_MPART, GTID, GTHREADS); }
        GSYNC();
        {
            unsigned char* ws = WSB();
            pg8::Gemm g{(bf16_t*)(ws + WS_QA), (bf16_t*)(ws + WS_WMO) + (size_t)l * D * 512, T, D, 512}; pg8::StaticOrder So; So.init(T, D, GRIDX(), BLKX());
            EpiBranchA E{(const bf16_t*)(ws + WS_GA), (bf16_t*)(ws + WS_MERGED)};
            pg8::gemm_phase<EpiBranchA, pg8::StaticOrder, true, true>(L3, g, So, E);
        }
        {
            unsigned char* ws = WSB();
            pg8::Gemm g{(bf16_t*)(ws + WS_YR), (bf16_t*)(ws + WS_WRO) + (size_t)l * D * D, T, D, D}; pg8::StaticOrder So; So.init(T, D, GRIDX(), BLKX());
            EpiBranchR E{(const bf16_t*)(ws + WS_GRT), (bf16_t*)(ws + WS_MERGED)};
            pg8::gemm_phase<EpiBranchR, pg8::StaticOrder, true, true>(L3, g, So, E);
        }
        GSYNC();
        {
            unsigned char* ws = WSB();
            pg8::Gemm g{(bf16_t*)(ws + WS_MERGED), (bf16_t*)(ws + WS_WO) + (size_t)l * D * D, T, D, D}; pg8::StaticOrder So; So.init(T, D, GRIDX(), BLKX());
            EpiMix E{(l == 0) ? INP(0) : (const float*)OUTP(), (float*)(ws + WS_X1), (bf16_t*)(ws + WS_XB), (float*)(ws + WS_STAT)};
            pg8::gemm_phase<EpiMix, pg8::StaticOrder, true, true>(L3, g, So, E);
        }
        GSYNC();
        {
            unsigned char* ws = WSB();
            pg8::Gemm g{(bf16_t*)(ws + WS_XB), (bf16_t*)(ws + WS_WQ) + (size_t)l * 2048 * D, T, 2048, D}; pg8::StaticOrder So; So.init(T, 2048, GRIDX(), BLKX());
            EpiPlain E{(bf16_t*)(ws + WS_PQ), 2048};
            pg8::gemm_phase<EpiPlain, pg8::StaticOrder, true, true>(L3, g, So, E);
        }
        GSYNC();
        { unsigned char* ws = WSB(); ph_peer_topk((const bf16_t*)(ws + WS_PQ), (const bf16_t*)(ws + WS_KEYS) + (size_t)l * 2 * PNK * PKD, (int*)(ws + WS_PIDX), (float*)(ws + WS_PW), L3,
                                                 (const float*)(ws + WS_STAT), (const float*)(ws + WS_TBL + TB_KC), (const float*)(ws + WS_TBL + TB_KB), (float*)(ws + WS_TBL + TB_RS),
                                                 INP(9) + (size_t)l * NEXP * D, INP(10) + (size_t)l * NEXP * D, ws + WS_TABU, ws + WS_TABV, (float*)(ws + WS_SINV)); }
        GSYNC();
        { unsigned char* ws = WSB(); ph_peer_gather((const float*)(ws + WS_X1), (const int*)(ws + WS_PIDX), (const float*)(ws + WS_PW), (const unsigned char*)(ws + WS_TABU), (const unsigned char*)(ws + WS_TABV), (const float*)(ws + WS_SINV),
                                                   INP(11) + l * D, INP(12) + l * D, (l == 1) ? OUTP() : (float*)nullptr, (bf16_t*)(ws + WS_XB), L3, (const float*)(ws + WS_TBL + TB_RS), INP(5) + l * D, INP(6) + l * D); }
        GSYNC();
}
__global__ void __launch_bounds__(512, 2) mega(Params P) {
    {
        volatile LAS unsigned* MISC = (volatile LAS unsigned*)((LAS unsigned char*)lds + MISC_OFF);
        for (int u = threadIdx.x; u < 64; u += blockDim.x) MISC[u] = 0u;
        __syncthreads();
        (void)xcd_barrier_post((unsigned*)WSB() + 4096, MISC + 8);
    }
    prologue_body();
    GSYNC();

    layer_body<0>();
    layer_body<1>();
}

extern "C" void kernel_launch(void* const* d_in, const int* in_sizes, int n_in, void* d_out, int out_size, void* d_ws, size_t ws_size,
                              hipStream_t stream) {
    static int grid = 0;
    if (grid == 0) {
        if (ws_size < WS_END) { fprintf(stderr, "kernel_launch: workspace too small: need %zu, have %zu\n", (size_t)WS_END, ws_size); grid = -1; return; }
        int dev = 0, cus = 0, per_cu = 0;
        (void)hipGetDevice(&dev);
        (void)hipDeviceGetAttribute(&cus, hipDeviceAttributeMultiprocessorCount, dev);
        (void)hipFuncSetAttribute((const void*)mega, hipFuncAttributeMaxDynamicSharedMemorySize, LDS_BYTES);
        (void)hipOccupancyMaxActiveBlocksPerMultiprocessor(&per_cu, (const void*)mega, 512, LDS_BYTES);
        if (per_cu < 1) { fprintf(stderr, "occupancy query says %d blocks per CU\n", per_cu); per_cu = 1; }
        grid = cus * per_cu;
        (void)hipGetLastError();
    }
    if (grid < 0) return;
    (void)hipMemsetAsync(d_ws, 0, CTL_BYTES, stream);
    Params p{};
    for (int i = 0; i < 13; ++i) p.in[i] = (const float*)d_in[i];
    p.out = (float*)d_out; p.ws = (unsigned char*)d_ws;
    void* args[] = {&p};
    hipError_t e = hipLaunchCooperativeKernel((const void*)mega, dim3(grid), dim3(512), args, LDS_BYTES, stream);
    if (e != hipSuccess) fprintf(stderr, "cooperative launch failed: %s (grid %d)\n", hipGetErrorString(e), grid);
}
```

```cpp
#include <hip/hip_runtime.h>
#include <cstdint>
#include <cstdio>

constexpr int D = 1024, NB = 2, S = 8192, T = NB * S;
constexpr int INW = 6656;
constexpr int OFF_QA = 0, OFF_KA = 512, OFF_VA = 1024, OFF_QR = 1536, OFF_KR = 2048, OFF_VR = 2560,
              OFF_GR = 3584, OFF_GA = 4608, OFF_GRT = 5632;
constexpr int MH = 8, MD = 64, MBLK = 256, MNB = S / MBLK;
constexpr int RH = 4, RDK = 128, RDV = 256, RC = 256, RNC = S / RC;
constexpr int PH = 8, PK = 16, PNK = 128, PKD = 128;
constexpr int NEXP = 16384;
constexpr float LN_EPS = 1e-5f;
constexpr float DN_ALPHA = 1.4142135623730951f;
constexpr float NEGF = -1e30f;
constexpr int WIN_ROWS = 7168, WIN_NROWS = 5120, WIN_SROWS = 2048;

#define LAS __attribute__((address_space(3)))
typedef unsigned short bf16_t;
typedef float f32x4 __attribute__((ext_vector_type(4)));
typedef unsigned u32x4 __attribute__((ext_vector_type(4)));
typedef unsigned u32x2 __attribute__((ext_vector_type(2)));

constexpr size_t MiB = 1u << 20;
constexpr size_t WS_CTL = 0, CTL_BYTES = 65536;
constexpr size_t WS_WIN = 1 * MiB, WIN_LSTRIDE = (size_t)WIN_ROWS * D * 2;
constexpr size_t WS_WMO = 29 * MiB, WS_WRO = 31 * MiB, WS_WO = 35 * MiB, WS_WQ = 39 * MiB;
constexpr size_t WS_KEYS = 47 * MiB, WS_TBL = 48 * MiB, WS_ROPEA = 49 * MiB, WS_ROPER = 51 * MiB, WS_ROPERT = 55 * MiB, WS_KMP = 59 * MiB;
constexpr size_t WS_XB = 60 * MiB;
constexpr size_t WS_QA = 92 * MiB, WS_KA = 108 * MiB, WS_VAT = 124 * MiB, WS_QR = 140 * MiB, WS_PQ = WS_QA;
constexpr size_t WS_KR = 156 * MiB, WS_KRT = 172 * MiB;
constexpr size_t WS_VRT = 188 * MiB, WS_MERGED = WS_VRT;
constexpr size_t WS_GR = 220 * MiB, WS_GA = 252 * MiB, WS_GRT = 284 * MiB;
constexpr size_t WS_KVT = 316 * MiB, WS_YR = WS_KVT, WS_PIDX = WS_KVT, WS_PW = WS_KVT + 8 * MiB;
constexpr size_t WS_PREVT = 348 * MiB;
constexpr size_t WS_X1 = 364 * MiB;
constexpr size_t WS_MPART = WS_X1, WS_MOWNO = 428 * MiB, WS_MOWNML = 444 * MiB, WS_MSEL = 446 * MiB;
constexpr size_t WS_TABU = 428 * MiB, WS_TABV = 444 * MiB, WS_SINV = 460 * MiB;
constexpr size_t WS_STAT = 462 * MiB;
constexpr size_t WS_END = 464 * MiB;
constexpr size_t TB_CSUM = 16384, TB_BQ = 32768, TB_KC = 49152, TB_KB = 65536, TB_RS = 131072, TB_PARTC = 524288, TB_PARTB = 786432;

__device__ __forceinline__ float bf2f(bf16_t b) { return __uint_as_float(((unsigned)b) << 16); }
__device__ __forceinline__ unsigned f2bf(float f) { const unsigned u = __float_as_uint(f); return (u + 0x7fffu + ((u >> 16) & 1u)) >> 16; }
__device__ __forceinline__ unsigned pk2(float lo, float hi) { return f2bf(lo) | (f2bf(hi) << 16); }
__device__ __forceinline__ float wave_sum(float v) {
#pragma unroll
    for (int o = 32; o >= 1; o >>= 1) v += __shfl_xor(v, o);
    return v;
}
__device__ __forceinline__ float ret_logg(int h) { return (float)log(1.0 - exp2(-5.0 - (double)h)); }
__device__ __forceinline__ float gelu_tanh(float x) { return 0.5f * x * (1.0f + tanhf(0.7978845608028654f * (x + 0.044715f * x * x * x))); }
__device__ __forceinline__ float sigmoidf_(float x) { return __builtin_amdgcn_rcpf(1.0f + __expf(-x)); }
__device__ __forceinline__ unsigned tidx() { unsigned t = threadIdx.x; asm volatile("" : "+v"(t)); return t; }
__device__ __forceinline__ unsigned bidx() { unsigned t = blockIdx.x; asm volatile("" : "+s"(t)); return t; }
__device__ __forceinline__ unsigned gdim() { unsigned t = gridDim.x; asm volatile("" : "+s"(t)); return t; }
namespace pg8 {
#define PG8_LAS __attribute__((address_space(3)))
typedef unsigned short bf16_t;
typedef short bf16x8 __attribute__((ext_vector_type(8)));
typedef float f32x4 __attribute__((ext_vector_type(4)));
typedef unsigned u32x4 __attribute__((ext_vector_type(4)));
constexpr int BM = 256, BK = 64, HALF = 128, HTB = HALF * BK * 2  , STAGE_BYTES = 8 * HTB, NXCD = 8, WGM = 8;

__host__ __device__ __forceinline__ int lds_byte(int r, int c) { const int st = (r >> 4) * 2 + (c >> 5), rr = r & 15, cc = c & 31, ob = rr * 64 + cc * 2; return st * 1024 + (ob ^ (((ob >> 9) & 1) << 5)); }
__host__ __device__ __forceinline__ void stage_rc(int b, int& R, int& C) { const int st = b / 1024, sb = b % 1024, swz = sb ^ (((sb >> 9) & 1) << 5); R = (st >> 1) * 16 + swz / 64; C = (st & 1) * 32 + (swz % 64) / 2; }
__host__ __device__ __forceinline__ int perm32(int rho) { const int n = rho >> 4, i = rho & 15; return 8 * (i >> 2) + 4 * n + (i & 3); }

struct Unit { int pm, pn; };
struct Gemm { const bf16_t* A; const bf16_t* Bt; int M, N, K; };

struct StaticOrder {
    int nM, nN, nwg, G, c;
    __host__ __device__ void init(int M, int N, int G_, int c_) { nM = M / BM; nN = N / BM; nwg = nM * nN; G = G_; c = c_; }
    __host__ __device__ bool next(int i, Unit& u) const {
        const long L = (long)i * G + c; if (L >= nwg) return false;
        int wgid = (int)L; { const int q = nwg / NXCD, r = nwg % NXCD, xcd = wgid % NXCD, off = wgid / NXCD; wgid = (xcd < r ? xcd * (q + 1) : r * (q + 1) + (xcd - r) * q) + off; }
        const int nig = WGM * nN, gid = wgid / nig, fm = gid * WGM, gsz = (nM - fm) < WGM ? (nM - fm) : WGM;
        u.pm = fm + ((wgid % nig) % gsz); u.pn = (wgid % nig) / gsz; return true;
    }
    __device__ __forceinline__ void a_ready(const Unit&) const {}
    __device__ __forceinline__ void done(const Unit&) const {}
};

__device__ __forceinline__ unsigned cvt_pk_bf16(float lo, float hi) { unsigned r; asm volatile("v_cvt_pk_bf16_f32 %0, %1, %2" : "=v"(r) : "v"(lo), "v"(hi)); return r; }
typedef float f32x2 __attribute__((ext_vector_type(2)));
template <class Epi, class Sched, bool ALIGN_EPI = false, bool SP2 = false>
__device__ __forceinline__ void gemm_phase(PG8_LAS unsigned char* lds, const Gemm g, const Sched& S, const Epi& E) {
    int tid_ = threadIdx.x; asm volatile("" : "+v"(tid_));
    const int tid = tid_, wid = __builtin_amdgcn_readfirstlane(tid >> 6), lane = tid & 63, wr = wid >> 2, wc = wid & 3, fr = lane & 15, fq = lane >> 4;
    const int K = g.K, nt = K / BK;
    unsigned voffA[2], voffB[2];
#pragma unroll
    for (int i = 0; i < 2; ++i) { int R, C; stage_rc(tid * 16 + i * 8192, R, C); const int Rb = Epi::PERM ? ((R & ~31) + perm32(R & 31)) : R;
        voffA[i] = (unsigned)(R * K + C) * 2u; voffB[i] = (unsigned)(Rb * K + C) * 2u; }
    const size_t kstep = (size_t)(BK * 2);
    const size_t hstep = (size_t)HALF * K * 2;
    const size_t tstep = 2 * hstep;
    const unsigned ldsw = (unsigned)wid * 1024u;
    const int aoff = lds_byte(wr * 64 + fr, fq * 8), boff = lds_byte(wc * 32 + fr, fq * 8);
#define PG8_SA(b, h) (((b) * 2 + (h)) * HTB)
#define PG8_SB(b, h) ((4 + (b) * 2 + (h)) * HTB)
#define PG8_STAGE(bufoff, gbase, voff) do { _Pragma("unroll") for (int _i = 0; _i < 2; ++_i) \
        __builtin_amdgcn_global_load_lds((const unsigned*)((const char*)(gbase) + (voff)[_i]), (PG8_LAS unsigned*)(lds + (bufoff) + ldsw + _i * 8192), 16, 0, 0); } while (0)
#define PG8_LDA(dst, b, h) do { _Pragma("unroll") for (int m = 0; m < 4; ++m) _Pragma("unroll") for (int k = 0; k < 2; ++k) dst[m][k] = *(const PG8_LAS bf16x8*)(lds + PG8_SA(b, h) + aoff + m * 2048 + k * 1024); } while (0)
#define PG8_LDB(dst, b, h) do { _Pragma("unroll") for (int n = 0; n < 2; ++n) _Pragma("unroll") for (int k = 0; k < 2; ++k) dst[n][k] = *(const PG8_LAS bf16x8*)(lds + PG8_SB(b, h) + boff + n * 2048 + k * 1024); } while (0)
#define PG8_MMA(ai, bj, At, Bt) do { __builtin_amdgcn_s_setprio(1); _Pragma("unroll") for (int m = 0; m < 4; ++m) _Pragma("unroll") for (int n = 0; n < 2; ++n) _Pragma("unroll") for (int k = 0; k < 2; ++k) \
        acc[ai][bj][m][n] = __builtin_amdgcn_mfma_f32_16x16x32_bf16(Bt[n][k], At[m][k], acc[ai][bj][m][n], 0, 0, 0); __builtin_amdgcn_s_setprio(0); } while (0)
#define PG8_WAIT_V(n) asm volatile("s_waitcnt vmcnt(" #n ")" ::: "memory")
#define PG8_WAIT_L(n) asm volatile("s_waitcnt lgkmcnt(" #n ")" ::: "memory")
#define PG8_BAR __builtin_amdgcn_s_barrier()
#define PG8_SCHED __builtin_amdgcn_sched_barrier(0)
    Unit cur, nxt; int ui = 0;
    if (!S.next(0, cur)) return;
    f32x4 acc[2][2][4][2];
#pragma unroll
    for (int a = 0; a < 2; ++a)
#pragma unroll
        for (int b = 0; b < 2; ++b)
#pragma unroll
            for (int m = 0; m < 4; ++m)
#pragma unroll
                for (int n = 0; n < 2; ++n) acc[a][b][m][n] = (f32x4){0.f, 0.f, 0.f, 0.f};
    bf16x8 At[4][2], B0[2][2], B1[2][2];
    const char* cA = (const char*)g.A + (size_t)cur.pm * tstep; const char* cB = (const char*)g.Bt + (size_t)cur.pn * tstep;
    S.a_ready(cur);
    if constexpr (SP2) {
        PG8_STAGE(PG8_SB(0, 0), cB, voffB); PG8_STAGE(PG8_SB(0, 1), cB + hstep, voffB); PG8_STAGE(PG8_SA(0, 0), cA, voffA); PG8_STAGE(PG8_SA(0, 1), cA + hstep, voffA);
        if (wr == 1) PG8_BAR;
        PG8_WAIT_V(2); PG8_BAR;
        PG8_STAGE(PG8_SB(1, 0), cB + kstep, voffB); PG8_STAGE(PG8_SA(1, 0), cA + kstep, voffA); PG8_STAGE(PG8_SB(1, 1), cB + hstep + kstep, voffB);
        PG8_WAIT_V(6); PG8_BAR;
    } else {
        PG8_STAGE(PG8_SB(0, 0), cB, voffB); PG8_STAGE(PG8_SA(0, 0), cA, voffA); PG8_STAGE(PG8_SB(0, 1), cB + hstep, voffB); PG8_STAGE(PG8_SA(0, 1), cA + hstep, voffA);
        if (wr == 1) PG8_BAR;
        PG8_WAIT_V(4); PG8_BAR;
        PG8_STAGE(PG8_SB(1, 0), cB + kstep, voffB); PG8_STAGE(PG8_SA(1, 0), cA + kstep, voffA); PG8_STAGE(PG8_SB(1, 1), cB + hstep + kstep, voffB);
        PG8_WAIT_V(6); PG8_BAR;
    }
    for (;;) {
        const bool has_next = S.next(ui + 1, nxt);
        const char* nA = has_next ? (const char*)g.A + (size_t)nxt.pm * tstep : cA; const char* nB = has_next ? (const char*)g.Bt + (size_t)nxt.pn * tstep : cB;
        for (int t = 0; t < nt; t += 2) {
            const bool last = (t == nt - 2);
            const char* a1 = cA + (size_t)(t + 1) * kstep;
            const char* a2 = last ? nA : cA + (size_t)(t + 2) * kstep; const char* b2 = last ? nB : cB + (size_t)(t + 2) * kstep;
            const char* a3 = a2 + kstep; const char* b3 = b2 + kstep;
            if (last && has_next) S.a_ready(nxt);
            if constexpr (SP2) {
            PG8_LDB(B0, 0, 0); PG8_LDB(B1, 0, 1); PG8_SCHED; PG8_LDA(At, 0, 0); PG8_STAGE(PG8_SA(1, 1), a1 + hstep, voffA);
            PG8_WAIT_V(8); PG8_WAIT_L(0); PG8_BAR; PG8_MMA(0, 0, At, B0); PG8_MMA(0, 1, At, B1); PG8_BAR; PG8_SCHED;
            PG8_LDA(At, 0, 1); PG8_STAGE(PG8_SB(0, 0), b2, voffB); PG8_STAGE(PG8_SB(0, 1), b2 + hstep, voffB); PG8_STAGE(PG8_SA(0, 0), a2, voffA);
            PG8_WAIT_V(8); PG8_WAIT_L(0); PG8_BAR; PG8_MMA(1, 0, At, B0); PG8_MMA(1, 1, At, B1); PG8_BAR; PG8_SCHED;
            PG8_LDB(B0, 1, 0); PG8_LDB(B1, 1, 1); PG8_SCHED; PG8_LDA(At, 1, 0); PG8_STAGE(PG8_SA(0, 1), a2 + hstep, voffA);
            PG8_WAIT_V(8); PG8_WAIT_L(0); PG8_BAR; PG8_MMA(0, 0, At, B0); PG8_MMA(0, 1, At, B1); PG8_BAR; PG8_SCHED;
            PG8_LDA(At, 1, 1); PG8_STAGE(PG8_SB(1, 0), b3, voffB); PG8_STAGE(PG8_SB(1, 1), b3 + hstep, voffB); PG8_STAGE(PG8_SA(1, 0), a3, voffA);
            PG8_WAIT_V(8); PG8_WAIT_L(0); PG8_BAR; PG8_MMA(1, 0, At, B0); PG8_MMA(1, 1, At, B1); PG8_BAR; PG8_SCHED;
            } else {
            PG8_LDB(B0, 0, 0); PG8_SCHED; PG8_LDA(At, 0, 0); PG8_STAGE(PG8_SA(1, 1), a1 + hstep, voffA);
            PG8_WAIT_L(8); PG8_BAR; PG8_WAIT_L(0); PG8_MMA(0, 0, At, B0); PG8_BAR; PG8_SCHED;
            PG8_LDB(B1, 0, 1); PG8_STAGE(PG8_SB(0, 0), b2, voffB);
            PG8_BAR; PG8_WAIT_L(0); PG8_MMA(0, 1, At, B1); PG8_BAR;
            PG8_LDA(At, 0, 1); PG8_STAGE(PG8_SA(0, 0), a2, voffA);
            PG8_BAR; PG8_WAIT_L(0); PG8_MMA(1, 0, At, B0); PG8_BAR; PG8_SCHED;
            PG8_STAGE(PG8_SB(0, 1), b2 + hstep, voffB);
            PG8_WAIT_V(6); PG8_BAR; PG8_MMA(1, 1, At, B1); PG8_BAR;
            PG8_LDB(B0, 1, 0); PG8_SCHED; PG8_LDA(At, 1, 0); PG8_STAGE(PG8_SA(0, 1), a2 + hstep, voffA);
            PG8_WAIT_L(8); PG8_BAR; PG8_WAIT_L(0); PG8_MMA(0, 0, At, B0); PG8_BAR; PG8_SCHED;
            PG8_LDB(B1, 1, 1); PG8_STAGE(PG8_SB(1, 0), b3, voffB);
            PG8_BAR; PG8_WAIT_L(0); PG8_MMA(0, 1, At, B1); PG8_BAR;
            PG8_LDA(At, 1, 1); PG8_STAGE(PG8_SA(1, 0), a3, voffA);
            PG8_BAR; PG8_WAIT_L(0); PG8_MMA(1, 0, At, B0); PG8_BAR; PG8_SCHED;
            PG8_STAGE(PG8_SB(1, 1), b3 + hstep, voffB);
            PG8_WAIT_V(6); PG8_BAR; PG8_MMA(1, 1, At, B1); PG8_BAR;
            }
        }
        if constexpr (ALIGN_EPI) { if (wr == 0) PG8_BAR; }
        if constexpr (!Epi::AFTER_DRAIN) { E(acc, cur, wr, wc, fr, fq); S.done(cur); }
        if (!has_next) break;
#pragma unroll
        for (int a = 0; a < 2; ++a)
#pragma unroll
            for (int b = 0; b < 2; ++b)
#pragma unroll
                for (int m = 0; m < 4; ++m)
#pragma unroll
                    for (int n = 0; n < 2; ++n) acc[a][b][m][n] = (f32x4){0.f, 0.f, 0.f, 0.f};
        cur = nxt; cA = nA; cB = nB; ++ui;
        if constexpr (ALIGN_EPI) { if (wr == 1) PG8_BAR; }
    }
    PG8_WAIT_V(0);
    if constexpr (!ALIGN_EPI) { if (wr == 0) PG8_BAR; }
    PG8_BAR;
    if constexpr (Epi::AFTER_DRAIN) { E.fused(acc, cur, wr, wc, fr, fq, lds, wid, lane); S.done(cur); }
#undef PG8_SA
#undef PG8_SB
#undef PG8_STAGE
#undef PG8_LDA
#undef PG8_LDB
#undef PG8_MMA
#undef PG8_WAIT_V
#undef PG8_WAIT_L
#undef PG8_BAR
#undef PG8_SCHED
}
}
using pg8::Unit;
typedef float f32x2_t __attribute__((ext_vector_type(2))); typedef __bf16 bf16x2_t __attribute__((ext_vector_type(2)));
__device__ __forceinline__ unsigned cvtpk(float lo, float hi) { f32x2_t v = {lo, hi}; bf16x2_t b = __builtin_convertvector(v, bf16x2_t); return __builtin_bit_cast(unsigned, b); }
typedef pg8::f32x4 af4;
__device__ __forceinline__ void st8bf(bf16_t* p, const float (&o)[8]) {
    u32x4 w; w.x = cvtpk(o[0], o[1]); w.y = cvtpk(o[2], o[3]); w.z = cvtpk(o[4], o[5]); w.w = cvtpk(o[6], o[7]);
    *(u32x4*)p = w;
}
__device__ __forceinline__ void rot8(const af4& v0, const af4& v1, const float4& r0, const float4& r1, float (&o)[8]) {
    o[0] = v0[0] * r0.x - v0[1] * r0.y; o[1] = v0[1] * r0.x + v0[0] * r0.y;
    o[2] = v0[2] * r0.z - v0[3] * r0.w; o[3] = v0[3] * r0.z + v0[2] * r0.w;
    o[4] = v1[0] * r1.x - v1[1] * r1.y; o[5] = v1[1] * r1.x + v1[0] * r1.y;
    o[6] = v1[2] * r1.z - v1[3] * r1.w; o[7] = v1[3] * r1.z + v1[2] * r1.w;
}

__device__ __forceinline__ void st8v(bf16_t* p, const af4& a, const af4& b) {
    u32x4 w; w.x = cvtpk(a[0], a[1]); w.y = cvtpk(a[2], a[3]); w.z = cvtpk(b[0], b[1]); w.w = cvtpk(b[2], b[3]);
    *(u32x4*)p = w;
}
__device__ __forceinline__ af4 rot4(const af4& v, const float4& r) {
    af4 o; o[0] = v[0] * r.x - v[1] * r.y; o[1] = v[1] * r.x + v[0] * r.y; o[2] = v[2] * r.z - v[3] * r.w; o[3] = v[3] * r.z + v[2] * r.w; return o;
}
__device__ __forceinline__ af4 red16(af4 v) {
#pragma unroll
    for (int e = 0; e < 4; ++e) { float x = v[e]; x += __shfl_xor(x, 1); x += __shfl_xor(x, 2); x += __shfl_xor(x, 4); x += __shfl_xor(x, 8); v[e] = x; }
    return v;
}
struct EpiMobaQK {
    static constexpr bool PERM = true, AFTER_DRAIN = false;
    unsigned char* ws;
    __device__ __forceinline__ void operator()(const af4 (&acc)[2][2][4][2], const Unit& u, int wr, int wc, int fr, int fq) const {
        const float* const ropeA = (const float*)(ws + WS_ROPEA);
        const int pn = u.pn;
        const int row0 = u.pm * 256 + wr * 64 + fr;
        const int c0 = (pn & 1) * 256 + wc * 32 + 8 * fq;
        const float* rbase = ropeA + ((c0 & 63) >> 1) * 2;
        if (pn < 2) {
            bf16_t* const QA = (bf16_t*)(ws + WS_QA);
            float4 rr[2][2];
            { const float4* rp = (const float4*)(rbase + (size_t)(row0 & (S - 1)) * 64); rr[0][0] = rp[0]; rr[0][1] = rp[1]; }
#pragma unroll
            for (int it = 0; it < 8; ++it) {
                const int ai = it >> 2, m = it & 3;
                const int row = row0 + ai * 128 + m * 16;
                if (it < 7) { const int nrow = row0 + ((it + 1) >> 2) * 128 + ((it + 1) & 3) * 16; const float4* rp = (const float4*)(rbase + (size_t)(nrow & (S - 1)) * 64); rr[(it + 1) & 1][0] = rp[0]; rr[(it + 1) & 1][1] = rp[1]; }
                asm volatile("" ::: "memory");
                const float4 r0 = rr[it & 1][0], r1 = rr[it & 1][1];
#pragma unroll
                for (int bj = 0; bj < 2; ++bj) {
                    const af4 o0 = rot4(acc[ai][bj][m][0], r0) * 0.125f, o1 = rot4(acc[ai][bj][m][1], r1) * 0.125f;
                    st8v(QA + (size_t)row * 512 + c0 + bj * 128, o0, o1);
                }
            }
        } else {
            bf16_t* const KA = (bf16_t*)(ws + WS_KA);
            af4 k00 = {0.f, 0.f, 0.f, 0.f}, k01 = k00, k10 = k00, k11 = k00;
#pragma unroll
            for (int it = 0; it < 8; ++it) {
                const int ai = it >> 2, m = it & 3;
                const int row = row0 + ai * 128 + m * 16;
                asm volatile("" ::: "memory");
                const float4* rp = (const float4*)(rbase + (size_t)(row & (S - 1)) * 64);
                const float4 r0 = rp[0], r1 = rp[1];
                const af4 a0 = rot4(acc[ai][0][m][0], r0), a1 = rot4(acc[ai][0][m][1], r1);
                const af4 b0 = rot4(acc[ai][1][m][0], r0), b1 = rot4(acc[ai][1][m][1], r1);
                k00 += a0; k01 += a1; k10 += b0; k11 += b1;
                st8v(KA + (size_t)row * 512 + c0, a0, a1);
                st8v(KA + (size_t)row * 512 + c0 + 128, b0, b1);
            }
            k00 = red16(k00); k01 = red16(k01); k10 = red16(k10); k11 = red16(k11);
            if (fr == 0) {
                float* kp = (float*)(ws + WS_KMP) + ((size_t)(u.pm * 2 + wr)) * 512 + c0;
                *(af4*)kp = k00; *(af4*)(kp + 4) = k01; *(af4*)(kp + 128) = k10; *(af4*)(kp + 132) = k11;
            }
        }
    }
};
struct EpiRetQK {
    static constexpr bool PERM = true, AFTER_DRAIN = false;
    unsigned char* ws;
    __device__ __forceinline__ void operator()(const af4 (&acc)[2][2][4][2], const Unit& u, int wr, int wc, int fr, int fq) const {
        const float* const ropeR = (const float*)(ws + WS_ROPER);
        const int pn = u.pn;
        const bool isK = pn >= 2;
        bf16_t* const dst = (bf16_t*)(ws + (isK ? WS_KR : WS_QR));
        const float* const tab = (const float*)(ws + WS_TBL) + (isK ? 1024 : 0);
        const int row0 = u.pm * 256 + wr * 64 + fr;
        const int c0 = (pn & 1) * 256 + wc * 32 + 8 * fq;
        const int h0 = c0 >> 7;
        const float* rbase = ropeR + ((c0 & 127) >> 1) * 2;
        float4 rr[2][2]; float dd[2][2];
        { const int s = row0 & (S - 1); const float4* rp = (const float4*)(rbase + (size_t)s * 128); rr[0][0] = rp[0]; rr[0][1] = rp[1]; dd[0][0] = tab[h0 * 256 + (s & 255)]; dd[0][1] = tab[(h0 + 1) * 256 + (s & 255)]; }
#pragma unroll
        for (int it = 0; it < 8; ++it) {
            const int ai = it >> 2, m = it & 3;
            const int row = row0 + ai * 128 + m * 16;
            if (it < 7) {
                const int s = (row0 + ((it + 1) >> 2) * 128 + ((it + 1) & 3) * 16) & (S - 1);
                const float4* rp = (const float4*)(rbase + (size_t)s * 128);
                rr[(it + 1) & 1][0] = rp[0]; rr[(it + 1) & 1][1] = rp[1]; dd[(it + 1) & 1][0] = tab[h0 * 256 + (s & 255)]; dd[(it + 1) & 1][1] = tab[(h0 + 1) * 256 + (s & 255)];
            }
            asm volatile("" ::: "memory");
            const float4 r0 = rr[it & 1][0], r1 = rr[it & 1][1];
#pragma unroll
            for (int bj = 0; bj < 2; ++bj) {
                const float dec = dd[it & 1][bj];
                const af4 o0 = rot4(acc[ai][bj][m][0], r0) * dec, o1 = rot4(acc[ai][bj][m][1], r1) * dec;
                st8v(dst + (size_t)row * 512 + c0 + bj * 128, o0, o1);
            }
        }
    }
};
struct EpiGates {
    static constexpr bool PERM = true, AFTER_DRAIN = false;
    unsigned char* ws;
    __device__ __forceinline__ void operator()(const af4 (&acc)[2][2][4][2], const Unit& u, int wr, int wc, int fr, int fq) const {
        const int pn = u.pn, seg = pn >> 2;
        bf16_t* const dst = (bf16_t*)(ws + (seg == 0 ? WS_GR : (seg == 1 ? WS_GA : WS_GRT)));
        const int row0 = u.pm * 256 + wr * 64 + fr;
        const int c0 = (pn & 3) * 256 + wc * 32 + 8 * fq;
#pragma unroll
        for (int ai = 0; ai < 2; ++ai)
#pragma unroll
            for (int m = 0; m < 4; ++m) {
                asm volatile("" ::: "memory");
                const int row = row0 + ai * 128 + m * 16;
#pragma unroll
                for (int bj = 0; bj < 2; ++bj) {
                    af4 o0 = acc[ai][bj][m][0], o1 = acc[ai][bj][m][1];
#pragma unroll
                    for (int e = 0; e < 4; ++e) {
                        const float s0 = sigmoidf_(o0[e]), s1 = sigmoidf_(o1[e]);
                        o0[e] = seg == 0 ? o0[e] * s0 : s0; o1[e] = seg == 0 ? o1[e] * s1 : s1;
                    }
                    if (seg == 0) st8v(dst + (size_t)row * 1024 + c0 + bj * 128, o0, o1);
                    else {
                        u32x2 w;
                        w.x = (unsigned)(o0[0] * 255.0f + 0.5f) | ((unsigned)(o0[1] * 255.0f + 0.5f) << 8) | ((unsigned)(o0[2] * 255.0f + 0.5f) << 16) | ((unsigned)(o0[3] * 255.0f + 0.5f) << 24);
                        w.y = (unsigned)(o1[0] * 255.0f + 0.5f) | ((unsigned)(o1[1] * 255.0f + 0.5f) << 8) | ((unsigned)(o1[2] * 255.0f + 0.5f) << 16) | ((unsigned)(o1[3] * 255.0f + 0.5f) << 24);
                        *(u32x2*)((unsigned char*)dst + (size_t)row * 1024 + c0 + bj * 128) = w;
                    }
                }
            }
    }
};

struct EpiProjAll {
    static constexpr bool PERM = true, AFTER_DRAIN = false;
    unsigned char* ws;
    __device__ __forceinline__ void operator()(const af4 (&acc)[2][2][4][2], const Unit& u, int wr, int wc, int fr, int fq) const {
        if (u.pn < 4) { const Unit v{u.pm, u.pn}; EpiMobaQK{ws}(acc, v, wr, wc, fr, fq); }
        else if (u.pn < 8) { const Unit v{u.pm, u.pn - 4}; EpiRetQK{ws}(acc, v, wr, wc, fr, fq); }
        else { const Unit v{u.pm, u.pn - 8}; EpiGates{ws}(acc, v, wr, wc, fr, fq); }
    }
};
struct EpiProjS {
    static constexpr bool PERM = true, AFTER_DRAIN = false;
    unsigned char* ws;
    __device__ __forceinline__ void operator()(const af4 (&acc)[2][2][4][2], const Unit& u, int wr, int wc, int fr, int fq) const {
        bf16_t* const VAT = (bf16_t*)(ws + WS_VAT); bf16_t* const VRT = (bf16_t*)(ws + WS_VRT); bf16_t* const KRT = (bf16_t*)(ws + WS_KRT);
        const float* const ropeRT = (const float*)(ws + WS_ROPERT); const float* const kdec = (const float*)(ws + WS_TBL) + 1024;
        const int pm = u.pm;
        const int f0 = pm * 256 + wr * 64 + fr;
        const int t00 = u.pn * 256 + wc * 32 + 8 * fq;
#pragma unroll
        for (int ai = 0; ai < 2; ++ai)
#pragma unroll
            for (int m = 0; m < 4; ++m) {
                asm volatile("" ::: "memory");
                const int f = f0 + ai * 128 + m * 16;
#pragma unroll
                for (int bj = 0; bj < 2; ++bj) {
                    const int t0 = t00 + bj * 128, b = t0 >> 13, s0 = t0 & (S - 1);
                    float o[8];
#pragma unroll
                    for (int e = 0; e < 4; ++e) { o[e] = acc[ai][bj][m][0][e]; o[4 + e] = acc[ai][bj][m][1][e]; }
                    if (pm < 2) {
                        const int h = f >> 6, d = f & 63;
                        st8bf(VAT + ((((size_t)(b * 8 + h) * 128 + (s0 >> 6)) * 64 + d) * 64 + (s0 & 63)), o);
                    } else if (pm < 6) {
                        const int fe = f - 512, h = fe >> 8, e2 = fe & 255;
                        st8bf(VRT + (((size_t)(b * 4 + h) * 256 + e2) * S + s0), o);
                    } else {
                        const int fk = f - 1536, h = fk >> 7, d = fk & 127, j = d >> 1;
                        const float sgn = (d & 1) ? 1.0f : -1.0f;
                        const float4* rp = (const float4*)(ropeRT + ((size_t)j * S + s0) * 2);
                        const float4* dp = (const float4*)(kdec + h * 256 + (s0 & 255));
                        const float4 r0 = rp[0], r1 = rp[1], r2 = rp[2], r3 = rp[3], d0 = dp[0], d1 = dp[1];
                        const float cs[8] = {r0.x, r0.z, r1.x, r1.z, r2.x, r2.z, r3.x, r3.z};
                        const float sn[8] = {r0.y, r0.w, r1.y, r1.w, r2.y, r2.w, r3.y, r3.w};
                        const float dc[8] = {d0.x, d0.y, d0.z, d0.w, d1.x, d1.y, d1.z, d1.w};
#pragma unroll
                        for (int e = 0; e < 8; ++e) {
                            const float part = __shfl_xor(o[e], 1);
                            o[e] = (o[e] * cs[e] + sgn * part * sn[e]) * dc[e];
                        }
                        st8bf(KRT + (((size_t)(b * 4 + h) * 128 + d) * S + s0), o);
                    }
                }
            }
    }
};

struct EpiXch {
    LAS unsigned char* sc; int wpos, rpos, frx, fqx;
    __device__ __forceinline__ void init(LAS unsigned char* xch, int wr, int wc, int fr, int fq) {
        const int lane = 16 * fq + fr;
        frx = lane >> 2; fqx = lane & 3;
        sc = xch + (wr * 4 + wc) * 2048;
        wpos = ((4 * fr + fq) ^ ((fr >> 1) & 3)) * 16; rpos = (lane ^ ((lane >> 3) & 3)) * 16;
    }
    __device__ __forceinline__ void to_mem(u32x4& a, u32x4& b) const {
        *(LAS u32x4*)(sc + wpos) = a; *(LAS u32x4*)(sc + 1024 + wpos) = b;
        asm volatile("s_waitcnt lgkmcnt(0)" ::: "memory");
        a = *(const LAS u32x4*)(sc + rpos); b = *(const LAS u32x4*)(sc + 1024 + rpos);
        asm volatile("s_waitcnt lgkmcnt(0)" ::: "memory");
    }
    __device__ __forceinline__ void to_acc(u32x4& a, u32x4& b) const {
        *(LAS u32x4*)(sc + rpos) = a; *(LAS u32x4*)(sc + 1024 + rpos) = b;
        asm volatile("s_waitcnt lgkmcnt(0)" ::: "memory");
        a = *(const LAS u32x4*)(sc + wpos); b = *(const LAS u32x4*)(sc + 1024 + wpos);
        asm volatile("s_waitcnt lgkmcnt(0)" ::: "memory");
    }
};
constexpr int EPI_XCH_OFF = 131072;
struct EpiBranchA {
    static constexpr bool PERM = true, AFTER_DRAIN = false;
    const bf16_t* GA; bf16_t* MG; LAS unsigned char* xch;
    __device__ __forceinline__ void operator()(const af4 (&acc)[2][2][4][2], const Unit& u, int wr, int wc, int fr, int fq) const {
        EpiXch X; X.init(xch, wr, wc, fr, fq);
        const int row0 = u.pm * 256 + wr * 64 + fr, col0 = u.pn * 256 + wc * 32 + 8 * fq;
        const int rowx0 = u.pm * 256 + wr * 64 + X.frx, colx0 = u.pn * 256 + wc * 32 + 8 * X.fqx;
#pragma unroll
        for (int ai = 0; ai < 2; ++ai)
#pragma unroll
            for (int m = 0; m < 4; ++m) {
                u32x4 wv[2];
#pragma unroll
                for (int bj = 0; bj < 2; ++bj) {
                    const size_t off = (size_t)(row0 + ai * 128 + m * 16) * 1024 + col0 + bj * 128;
                    const u32x2 g = *(const u32x2*)((const unsigned char*)GA + off);
                    float o[8];
#pragma unroll
                    for (int e = 0; e < 4; ++e) { o[e] = acc[ai][bj][m][0][e]; o[4 + e] = acc[ai][bj][m][1][e]; }
#pragma unroll
                    for (int e = 0; e < 4; ++e) { o[e] *= (float)((g.x >> (8 * e)) & 255u) * (1.0f / 255.0f); o[4 + e] *= (float)((g.y >> (8 * e)) & 255u) * (1.0f / 255.0f); }
                    wv[bj].x = cvtpk(o[0], o[1]); wv[bj].y = cvtpk(o[2], o[3]); wv[bj].z = cvtpk(o[4], o[5]); wv[bj].w = cvtpk(o[6], o[7]);
                }
                X.to_mem(wv[0], wv[1]);
                bf16_t* op = MG + (size_t)(rowx0 + ai * 128 + m * 16) * 1024 + colx0;
                *(u32x4*)op = wv[0]; *(u32x4*)(op + 128) = wv[1];
            }
    }
};
struct EpiBranchR {
    static constexpr bool PERM = true, AFTER_DRAIN = false;
    const bf16_t* GRT; bf16_t* MG; LAS unsigned char* xch;
    __device__ __forceinline__ void operator()(const af4 (&acc)[2][2][4][2], const Unit& u, int wr, int wc, int fr, int fq) const {
        EpiXch X; X.init(xch, wr, wc, fr, fq);
        const int row0 = u.pm * 256 + wr * 64 + fr, col0 = u.pn * 256 + wc * 32 + 8 * fq;
        const int rowx0 = u.pm * 256 + wr * 64 + X.frx, colx0 = u.pn * 256 + wc * 32 + 8 * X.fqx;
#pragma unroll
        for (int ai = 0; ai < 2; ++ai)
#pragma unroll
            for (int m = 0; m < 4; ++m) {
                bf16_t* op = MG + (size_t)(rowx0 + ai * 128 + m * 16) * 1024 + colx0;
                u32x4 tv[2]; tv[0] = *(const u32x4*)op; tv[1] = *(const u32x4*)(op + 128);
                X.to_acc(tv[0], tv[1]);
                u32x4 wv[2];
#pragma unroll
                for (int bj = 0; bj < 2; ++bj) {
                    const size_t off = (size_t)(row0 + ai * 128 + m * 16) * 1024 + col0 + bj * 128;
                    const u32x2 g = *(const u32x2*)((const unsigned char*)GRT + off);
                    float o[8];
#pragma unroll
                    for (int e = 0; e < 4; ++e) { o[e] = acc[ai][bj][m][0][e]; o[4 + e] = acc[ai][bj][m][1][e]; }
#pragma unroll
                    for (int e = 0; e < 8; ++e) {
                        const unsigned twe = (e >> 1) == 0 ? tv[bj].x : (e >> 1) == 1 ? tv[bj].y : (e >> 1) == 2 ? tv[bj].z : tv[bj].w;
                        const float gv = (float)(((e < 4 ? g.x : g.y) >> (8 * (e & 3))) & 255u) * (1.0f / 255.0f);
                        const float tvv = (e & 1) ? __uint_as_float(twe & 0xffff0000u) : __uint_as_float(twe << 16);
                        o[e] = o[e] * gv + tvv;
                    }
                    wv[bj].x = cvtpk(o[0], o[1]); wv[bj].y = cvtpk(o[2], o[3]); wv[bj].z = cvtpk(o[4], o[5]); wv[bj].w = cvtpk(o[6], o[7]);
                }
                X.to_mem(wv[0], wv[1]);
                *(u32x4*)op = wv[0]; *(u32x4*)(op + 128) = wv[1];
            }
    }
};
struct EpiMix {
    static constexpr bool PERM = true, AFTER_DRAIN = false;
    const float* X; float* X1; bf16_t* XBo; float* STAT; LAS unsigned char* xch;
    __device__ __forceinline__ void operator()(const af4 (&acc)[2][2][4][2], const Unit& u, int wr, int wc, int fr, int fq) const {
        EpiXch XC; XC.init(xch, wr, wc, fr, fq);
        const int row0 = u.pm * 256 + wr * 64 + fr;
        const int rowx0 = u.pm * 256 + wr * 64 + XC.frx, colx0 = u.pn * 256 + wc * 32 + 8 * XC.fqx;
#pragma unroll
        for (int ai = 0; ai < 2; ++ai)
#pragma unroll
            for (int m = 0; m < 4; ++m) {
                const int row = row0 + ai * 128 + m * 16;
                bf16_t* xp = XBo + (size_t)(rowx0 + ai * 128 + m * 16) * 1024 + colx0;
                u32x4 xv[2]; xv[0] = *(const u32x4*)xp; xv[1] = *(const u32x4*)(xp + 128);
                XC.to_acc(xv[0], xv[1]);
                float s1 = 0.f, s2 = 0.f;
                u32x4 wv[2];
#pragma unroll
                for (int bj = 0; bj < 2; ++bj) {
                    const u32x4 xw = xv[bj];
                    const f32x4 x0 = (f32x4){__uint_as_float(xw.x << 16), __uint_as_float(xw.x & 0xffff0000u), __uint_as_float(xw.y << 16), __uint_as_float(xw.y & 0xffff0000u)};
                    const f32x4 x1 = (f32x4){__uint_as_float(xw.z << 16), __uint_as_float(xw.z & 0xffff0000u), __uint_as_float(xw.w << 16), __uint_as_float(xw.w & 0xffff0000u)};
                    const af4 p0 = x0 * DN_ALPHA + acc[ai][bj][m][0], p1 = x1 * DN_ALPHA + acc[ai][bj][m][1];
                    wv[bj].x = cvtpk(p0[0], p0[1]); wv[bj].y = cvtpk(p0[2], p0[3]); wv[bj].z = cvtpk(p1[0], p1[1]); wv[bj].w = cvtpk(p1[2], p1[3]);
                    s1 += (p0[0] + p0[1]) + (p0[2] + p0[3]) + (p1[0] + p1[1]) + (p1[2] + p1[3]);
                    s2 += (p0[0] * p0[0] + p0[1] * p0[1]) + (p0[2] * p0[2] + p0[3] * p0[3]) + (p1[0] * p1[0] + p1[1] * p1[1]) + (p1[2] * p1[2] + p1[3] * p1[3]);
                }
                XC.to_mem(wv[0], wv[1]);
                *(u32x4*)xp = wv[0]; *(u32x4*)(xp + 128) = wv[1];
                s1 += __shfl_xor(s1, 16); s1 += __shfl_xor(s1, 32); s2 += __shfl_xor(s2, 16); s2 += __shfl_xor(s2, 32);
                if (fq == 0) *(float2*)(STAT + ((size_t)row * 16 + u.pn * 4 + wc) * 2) = make_float2(s1, s2);
            }
    }
};
struct EpiPlain {
    static constexpr bool PERM = true, AFTER_DRAIN = false;
    bf16_t* O; int ldc; LAS unsigned char* xch;
    __device__ __forceinline__ void operator()(const af4 (&acc)[2][2][4][2], const Unit& u, int wr, int wc, int fr, int fq) const {
        EpiXch X; X.init(xch, wr, wc, fr, fq);
        const int rowx0 = u.pm * 256 + wr * 64 + X.frx, colx0 = u.pn * 256 + wc * 32 + 8 * X.fqx;
#pragma unroll
        for (int ai = 0; ai < 2; ++ai)
#pragma unroll
            for (int m = 0; m < 4; ++m) {
                u32x4 wv[2];
#pragma unroll
                for (int bj = 0; bj < 2; ++bj) {
                    wv[bj].x = cvtpk(acc[ai][bj][m][0][0], acc[ai][bj][m][0][1]); wv[bj].y = cvtpk(acc[ai][bj][m][0][2], acc[ai][bj][m][0][3]);
                    wv[bj].z = cvtpk(acc[ai][bj][m][1][0], acc[ai][bj][m][1][1]); wv[bj].w = cvtpk(acc[ai][bj][m][1][2], acc[ai][bj][m][1][3]);
                }
                X.to_mem(wv[0], wv[1]);
                bf16_t* op = O + (size_t)(rowx0 + ai * 128 + m * 16) * ldc + colx0;
                *(u32x4*)op = wv[0]; *(u32x4*)(op + 128) = wv[1];
            }
    }
};
__device__ __forceinline__ int win_dest_row(int n) {
    if (n < 1024) { const int seg = n >> 9, r = n & 511, h = r >> 6, d = r & 63; const int pd = d < 32 ? 2 * d : 2 * (d - 32) + 1; return seg * 512 + h * 64 + pd; }
    if (n < 1536) return WIN_NROWS + (n - 1024);
    if (n < 2048) return 1024 + (n - 1536);
    if (n < 2560) return 1536 + (n - 2048);
    if (n < 3584) return WIN_NROWS + 512 + (n - 2560);
    return 2048 + (n - 3584);
}
template <bool WIN>
__device__ __forceinline__ void p0_transpose_item(const float* W, int K, int N, bf16_t* WT, LAS float* scr, int item, int lane, const float* rowscale = nullptr) {
    const int nblk = N / 32, kb = item / nblk, nb = item % nblk, k0 = 64 * kb, n0 = 32 * nb;
    float tv[32];
#pragma unroll
    for (int i = 0; i < 32; ++i) tv[i] = W[(size_t)(k0 + 2 * i + (lane >> 5)) * N + n0 + (lane & 31)];
#pragma unroll
    for (int i = 0; i < 32; ++i) { const int kk = 2 * i + (lane >> 5); scr[kk * 33 + (lane & 31)] = rowscale ? tv[i] * rowscale[k0 + kk] : tv[i]; }
    asm volatile("s_waitcnt lgkmcnt(0)" ::: "memory");
    const int c = lane & 7;
#pragma unroll
    for (int j = 0; j < 4; ++j) {
        const int n = (lane >> 3) + 8 * j; const LAS float* s = scr + (8 * c) * 33 + n;
        u32x4 o; o.x = pk2(s[0 * 33], s[1 * 33]); o.y = pk2(s[2 * 33], s[3 * 33]); o.z = pk2(s[4 * 33], s[5 * 33]); o.w = pk2(s[6 * 33], s[7 * 33]);
        const int nl = n0 + n;
        const int row = WIN ? win_dest_row(nl) : nl;
        *(u32x4*)(WT + (size_t)row * K + k0 + 8 * c) = o;
        if (WIN && nl >= OFF_KR && nl < OFF_VR) *(u32x4*)(WT + (size_t)(WIN_NROWS + 1536 + (nl - OFF_KR)) * K + k0 + 8 * c) = o;
    }
    asm volatile("s_waitcnt lgkmcnt(0)" ::: "memory");
}
__device__ __forceinline__ void cvt_copy(const float* src, bf16_t* dst, size_t n, size_t gtid, size_t gthreads) {
    size_t i = gtid * 8;
    for (; i + 3 * gthreads * 8 < n; i += 4 * gthreads * 8) {
        f32x4 a[4], b[4];
#pragma unroll
        for (int q = 0; q < 4; ++q) { a[q] = *(const f32x4*)(src + i + q * gthreads * 8); b[q] = *(const f32x4*)(src + i + q * gthreads * 8 + 4); }
#pragma unroll
        for (int q = 0; q < 4; ++q) {
            u32x4 w; w.x = pk2(a[q][0], a[q][1]); w.y = pk2(a[q][2], a[q][3]); w.z = pk2(b[q][0], b[q][1]); w.w = pk2(b[q][2], b[q][3]);
            *(u32x4*)(dst + i + q * gthreads * 8) = w;
        }
    }
    for (; i < n; i += gthreads * 8) {
        const f32x4 a = *(const f32x4*)(src + i), b = *(const f32x4*)(src + i + 4);
        u32x4 w; w.x = pk2(a[0], a[1]); w.y = pk2(a[2], a[3]); w.z = pk2(b[0], b[1]); w.w = pk2(b[2], b[3]);
        *(u32x4*)(dst + i) = w;
    }
}
struct Tables { float* ropeA; float* ropeR; float* ropeRT; float* qdec; float* kdec; };
__device__ __forceinline__ void p0_tables(const Tables& tb, size_t gtid, size_t gthreads, LAS float* invL) {
    const int t_ = (int)tidx();
    if (t_ < 32) invL[t_] = (float)pow(10000.0, -(double)t_ / 32.0);
    else if (t_ < 96) invL[t_] = (float)(1.0 / pow(10000.0, (double)(t_ - 32) / 63.0));
    __syncthreads();
    for (size_t i = gtid; i < (size_t)S * 32; i += gthreads) {
        const int s = (int)(i >> 5), j = (int)(i & 31);
        const float ang = (float)s * invL[j];
        float sn, c; sincosf(ang, &sn, &c);
        tb.ropeA[i * 2] = c; tb.ropeA[i * 2 + 1] = sn;
    }
    for (size_t i = gtid; i < (size_t)S * 64; i += gthreads) {
        const int s = (int)(i >> 6), j = (int)(i & 63);
        const float ang = (float)s * invL[32 + j];
        float sn, c; sincosf(ang, &sn, &c);
        tb.ropeR[i * 2] = c; tb.ropeR[i * 2 + 1] = sn;
        tb.ropeRT[((size_t)j * S + s) * 2] = c; tb.ropeRT[((size_t)j * S + s) * 2 + 1] = sn;
    }
    for (size_t i = gtid; i < 4 * 256; i += gthreads) {
        const int h = (int)(i >> 8), c = (int)(i & 255);
        const float lg = ret_logg(h);
        tb.qdec[i] = expf(lg * (float)c);
        tb.kdec[i] = 0.08838834764831845f * expf(-lg * (float)c);
    }
    __syncthreads();
}

__device__ __forceinline__ void ph_retscan(const float* KVT, bf16_t* PREVT) {
    const int tx_ = (int)tidx(), bx_ = (int)bidx(), gx_ = (int)gdim();
    const int n = 8 * RDV * RDK;
    for (int idx = bx_ * 512 + tx_; idx < n; idx += gx_ * 512) {
        const int ed = idx & 32767, bh = idx >> 15, h = bh & 3;
        const float lg = ret_logg(h);
        const float g1 = expf(lg), cd = expf(lg * 256.0f), g255 = expf(lg * 255.0f);
        float kvv[RNC];
#pragma unroll
        for (int nc = 0; nc < RNC; ++nc) kvv[nc] = KVT[((size_t)(bh * RNC + nc) << 15) + ed];
        float st = 0.f;
#pragma unroll
        for (int nc = 0; nc < RNC; ++nc) {
            PREVT[((size_t)(bh * RNC + nc) << 15) + ed] = (bf16_t)f2bf(st * g1);
            st = st * cd + g255 * kvv[nc];
        }
    }
}
__device__ __forceinline__ void p0_csum_part(const float* Wq, const float* g1, const float* b1, float* PARTC, float* PARTB) {
    const int tx_ = (int)tidx(), bx_ = (int)bidx(), gx_ = (int)gdim();
    for (int idx = bx_ * 512 + tx_; idx < 2 * 16 * 2048; idx += gx_ * 512) {
        const int l = idx >> 15, kq = (idx >> 11) & 15, n = idx & 2047;
        const float* w = Wq + (size_t)l * D * 2048 + (size_t)(64 * kq) * 2048 + n;
        float s = 0.f, t = 0.f;
#pragma unroll 32
        for (int k = 0; k < 64; ++k) { const float wv = w[(size_t)k * 2048]; s += g1[l * D + 64 * kq + k] * wv; t += b1[l * D + 64 * kq + k] * wv; }
        PARTC[idx] = s; PARTB[idx] = t;
    }
}
__device__ __forceinline__ void p0_csum_reduce(const float* PARTC, const float* PARTB, float* CSUM, float* BQ) {
    const int tx_ = (int)tidx(), bx_ = (int)bidx(), gx_ = (int)gdim();
    for (int idx = bx_ * 512 + tx_; idx < 2 * 2048; idx += gx_ * 512) {
        const int l = idx >> 11, n = idx & 2047;
        float s = 0.f, t = 0.f;
#pragma unroll
        for (int kq = 0; kq < 16; ++kq) { s += PARTC[(l * 16 + kq) * 2048 + n]; t += PARTB[(l * 16 + kq) * 2048 + n]; }
        CSUM[idx] = s; BQ[idx] = t;
    }
}
__device__ __forceinline__ void ph_kc_kb(const float* keys, const float* CSUM, const float* BQ, float* KC, float* KB) {
    const int tx_ = (int)tidx(), bx_ = (int)bidx(), gx_ = (int)gdim();
    const int lane = tx_ & 63;
    for (int idx = bx_ * 8 + (tx_ >> 6); idx < 2048; idx += gx_ * 8) {
        const int key = idx & 127, pp = (idx >> 7) & 1, hh = idx >> 8;
        const float* kp = keys + ((size_t)pp * PNK + key) * PKD;
        const float* cp = CSUM + hh * 256 + pp * 128; const float* bp = BQ + hh * 256 + pp * 128;
        const float k0 = kp[lane], k1 = kp[lane + 64];
        const float s = wave_sum(k0 * cp[lane] + k1 * cp[lane + 64]), t = wave_sum(k0 * bp[lane] + k1 * bp[lane + 64]);
        if (lane == 0) { KC[idx] = s; KB[idx] = t; }
    }
}
typedef short bf16x8_t __attribute__((ext_vector_type(8)));
template <int NR> struct CvtRowsT { f32x4 v[NR][4]; };
typedef CvtRowsT<2> CvtRows;
template <int NR> __device__ __forceinline__ void cvt2_issue(CvtRowsT<NR>& c, const float* srcU, const float* srcV, int row, int lane) {
#pragma unroll
    for (int r = 0; r < NR; ++r) {
        const int rr = row + r;
        const float* p = (rr < NEXP ? srcU + (size_t)rr * D : srcV + (size_t)(rr - NEXP) * D) + lane * 16;
#pragma unroll
        for (int q = 0; q < 4; ++q) c.v[r][q] = *(const f32x4*)(p + 4 * q);
    }
}
template <int NR> __device__ __forceinline__ void cvt2_finish(const CvtRowsT<NR>& c, unsigned char* dstU, unsigned char* dstV, float* sinv, int row, int lane) {
#pragma unroll
    for (int r = 0; r < NR; ++r) {
        const int rr = row + r;
        float m = 0.f;
#pragma unroll
        for (int q = 0; q < 4; ++q)
#pragma unroll
            for (int i = 0; i < 4; ++i) m = fmaxf(m, fabsf(c.v[r][q][i]));
#pragma unroll
        for (int o = 32; o >= 1; o >>= 1) m = fmaxf(m, __shfl_xor(m, o));
        const int er = rr < NEXP ? rr : rr - NEXP, which = rr < NEXP ? 0 : 1;
        {
            const float sc4 = m > 0.f ? 6.0f / m : 1.0f;
            unsigned d0 = 0u, d1 = 0u;
            d0 = __builtin_amdgcn_cvt_scalef32_pk_fp4_f32(d0, c.v[r][0][0] * sc4, c.v[r][0][1] * sc4, 1.0f, 0); d0 = __builtin_amdgcn_cvt_scalef32_pk_fp4_f32(d0, c.v[r][0][2] * sc4, c.v[r][0][3] * sc4, 1.0f, 1);
            d0 = __builtin_amdgcn_cvt_scalef32_pk_fp4_f32(d0, c.v[r][1][0] * sc4, c.v[r][1][1] * sc4, 1.0f, 2); d0 = __builtin_amdgcn_cvt_scalef32_pk_fp4_f32(d0, c.v[r][1][2] * sc4, c.v[r][1][3] * sc4, 1.0f, 3);
            d1 = __builtin_amdgcn_cvt_scalef32_pk_fp4_f32(d1, c.v[r][2][0] * sc4, c.v[r][2][1] * sc4, 1.0f, 0); d1 = __builtin_amdgcn_cvt_scalef32_pk_fp4_f32(d1, c.v[r][2][2] * sc4, c.v[r][2][3] * sc4, 1.0f, 1);
            d1 = __builtin_amdgcn_cvt_scalef32_pk_fp4_f32(d1, c.v[r][3][0] * sc4, c.v[r][3][1] * sc4, 1.0f, 2); d1 = __builtin_amdgcn_cvt_scalef32_pk_fp4_f32(d1, c.v[r][3][2] * sc4, c.v[r][3][3] * sc4, 1.0f, 3);
            u32x2 w2; w2.x = d0; w2.y = d1;
            *(u32x2*)((which ? dstV : dstU) + (size_t)er * (D / 2) + (which ? (lane >> 5) * 256 + (lane & 15) * 16 + ((lane >> 4) & 1) * 8 : lane * 8)) = w2;
            if (lane == 0) sinv[(size_t)er * 2 + which] = 1.0f / sc4;
        }
    }
}
__device__ __forceinline__ unsigned ord_key(float s) { unsigned u = __float_as_uint(s); return u ^ ((unsigned)((int)u >> 31) | 0x80000000u); }
__device__ __forceinline__ float ord_val(unsigned k) { const unsigned v = (k >> 31) ? (k ^ 0x80000000u) : ~k; return __uint_as_float(v); }
template <int N> __device__ __forceinline__ void bitonic_sort_desc(unsigned (&k)[N]) {
#pragma unroll
    for (int size = 2; size <= N; size <<= 1)
#pragma unroll
        for (int stride = size >> 1; stride > 0; stride >>= 1)
#pragma unroll
            for (int i = 0; i < N; ++i) {
                const int j = i ^ stride;
                if (j > i) {
                    const unsigned a = k[i], b = k[j], hi = a > b ? a : b, lo = a > b ? b : a;
                    const bool desc = (i & size) == 0;
                    k[i] = desc ? hi : lo; k[j] = desc ? lo : hi;
                }
            }
}
template <int N> __device__ __forceinline__ void bitonic_merge_desc(unsigned (&k)[N]) {
#pragma unroll
    for (int stride = N >> 1; stride > 0; stride >>= 1)
#pragma unroll
        for (int i = 0; i < N; ++i) {
            const int j = i ^ stride;
            if (j > i) { const unsigned a = k[i], b = k[j]; k[i] = a > b ? a : b; k[j] = a > b ? b : a; }
        }
}
constexpr int PK_PITCH = 272;
__device__ __forceinline__ void ph_peer_topk(const bf16_t* PQ, const bf16_t* KEYS, int* PIDX, float* PW, LAS unsigned char* l3,
                                             const float* STAT, const float* KC, const float* KB, float* RS,
                                             const float* srcU, const float* srcV, unsigned char* dstU, unsigned char* dstV, float* sinv) {
    const int tid = (int)tidx(), lane = tid & 63, g = lane >> 4, tk = lane & 15;
    const int wave = __builtin_amdgcn_readfirstlane(tid >> 6);
    for (int i = tid; i < 4096; i += 512) {
        const int row = i >> 4, ch = i & 15;
        const u32x4 v = *(const u32x4*)(KEYS + (size_t)row * 128 + ch * 8);
        *(LAS u32x4*)(l3 + row * PK_PITCH + ch * 16) = v;
    }
    __syncthreads();
    const int ntask = (T / 16) * 2;
    for (int task = (int)bidx() * 8 + wave; task < ntask; task += (int)gdim() * 8) {
        const int lane = (int)tidx() & 63, g = lane >> 4, tk = lane & 15;
        const int tg = task >> 1, hq = task & 1;
        const int tok = tg * 16 + tk;
        float mu, rstd;
        {
            float s1 = 0.f, s2 = 0.f;
#pragma unroll
            for (int q = 0; q < 4; ++q) { const float2 v = *(const float2*)(STAT + ((size_t)tok * 16 + 4 * g + q) * 2); s1 += v.x; s2 += v.y; }
            s1 += __shfl_xor(s1, 16); s1 += __shfl_xor(s1, 32); s2 += __shfl_xor(s2, 16); s2 += __shfl_xor(s2, 32);
            mu = s1 * (1.0f / D);
            rstd = 1.0f / sqrtf(fmaxf(s2 * (1.0f / D) - mu * mu, 0.f) + LN_EPS);
            if (hq == 0 && g == 0) *(float2*)(RS + (size_t)tok * 2) = make_float2(mu, rstd);
        }
        float sv0[16], sv1[16]; int si0[16], si1[16];
#pragma unroll
        for (int r = 0; r < 16; ++r) { sv0[r] = 0.f; sv1[r] = 0.f; si0[r] = 0; si1[r] = 0; }
        CvtRowsT<1> cvB;
        for (int hh = 0; hh < 4; ++hh) {
            const int h = hq * 4 + hh;
            const bool mine = (g == hh);
#pragma unroll
            for (int p = 0; p < 2; ++p) {
                const int crow = task * 16 + (hh * 2 + p) * 2;
                if (hh + p > 0) cvt2_finish(cvB, dstU, dstV, sinv, crow - 1, lane);
                CvtRowsT<1> cvA; cvt2_issue(cvA, srcU, srcV, crow, lane);
                f32x4 acc[8];
#pragma unroll
                for (int kt = 0; kt < 8; ++kt) acc[kt] = (f32x4){0.f, 0.f, 0.f, 0.f};
                const bf16_t* qp = PQ + (size_t)tok * 2048 + h * 256 + p * 128 + 8 * g;
#pragma unroll
                for (int ks = 0; ks < 4; ++ks) {
                    asm volatile("" ::: "memory");
                    const bf16x8_t qf = *(const bf16x8_t*)(qp + 32 * ks);
#pragma unroll
                    for (int kt = 0; kt < 8; ++kt) {
                        const bf16x8_t kf = *(const LAS bf16x8_t*)(l3 + (p * 128 + 16 * kt + tk) * PK_PITCH + (32 * ks + 8 * g) * 2);
                        acc[kt] = __builtin_amdgcn_mfma_f32_16x16x32_bf16(kf, qf, acc[kt], 0, 0, 0);
                    }
                }
                cvt2_finish(cvA, dstU, dstV, sinv, crow, lane);
                cvt2_issue(cvB, srcU, srcV, crow + 1, lane);
                f32x4 kc4[8], kb4[8];
#pragma unroll
                for (int kt = 0; kt < 8; ++kt) { kc4[kt] = *(const f32x4*)(KC + h * 256 + p * 128 + 16 * kt + 4 * g); kb4[kt] = *(const f32x4*)(KB + h * 256 + p * 128 + 16 * kt + 4 * g); }
                unsigned k[32];
#pragma unroll
                for (int kt = 0; kt < 8; ++kt)
#pragma unroll
                    for (int r = 0; r < 4; ++r) k[kt * 4 + r] = (ord_key(rstd * (acc[kt][r] - mu * kc4[kt][r]) + kb4[kt][r]) & ~127u) | (unsigned)(127 - (16 * kt + 4 * g + r));
                bitonic_sort_desc<32>(k);
                unsigned t16[16];
#pragma unroll
                for (int r = 0; r < 16; ++r) t16[r] = k[r];
#pragma unroll
                for (int o = 16; o <= 32; o <<= 1) {
                    unsigned ob[16];
#pragma unroll
                    for (int r = 0; r < 16; ++r) ob[r] = (unsigned)__shfl_xor((int)t16[r], o);
#pragma unroll
                    for (int r = 0; r < 16; ++r) t16[r] = t16[r] > ob[15 - r] ? t16[r] : ob[15 - r];
                    bitonic_merge_desc<16>(t16);
                }
#pragma unroll
                for (int r = 0; r < 16; ++r) {
                    const float val = ord_val(t16[r] & ~127u); const int idx = 127 - (int)(t16[r] & 127u);
                    if (p == 0) { sv0[r] = mine ? val : sv0[r]; si0[r] = mine ? idx : si0[r]; }
                    else        { sv1[r] = mine ? val : sv1[r]; si1[r] = mine ? idx : si1[r]; }
                }
            }
        }
        cvt2_finish(cvB, dstU, dstV, sinv, task * 16 + 15, lane);
        unsigned c[64];
        {
            int n = 0;
#pragma unroll
            for (int a = 0; a < 16; ++a)
#pragma unroll
                for (int b = 0; b < 16; ++b)
                    if ((a + 1) * (b + 1) <= 16) { c[n] = (ord_key(sv0[a] + sv1[b]) & ~255u) | (unsigned)(255 - (a * 16 + b)); ++n; }
#pragma unroll
            for (int j = 50; j < 64; ++j) c[j] = 0u;
        }
        bitonic_sort_desc<64>(c);
        float fs[16]; int fe[16];
#pragma unroll
        for (int r = 0; r < 16; ++r) {
            const unsigned m = c[r];
            const int pos = 255 - (int)(m & 255u), a = pos >> 4, b = pos & 15;
            fs[r] = ord_val(m & ~255u);
            int ea = si0[0], eb = si1[0];
#pragma unroll
            for (int j = 1; j < 16; ++j) { ea = (a == j) ? si0[j] : ea; eb = (b == j) ? si1[j] : eb; }
            fe[r] = ea * PNK + eb;
        }
        float sum = 0.f; const float fmx = fs[0];
#pragma unroll
        for (int r = 0; r < 16; ++r) { fs[r] = __expf(fs[r] - fmx); sum += fs[r]; }
        const float inv = 1.0f / sum;
        const int lane2 = (int)tidx() & 63;
        const unsigned oo = (unsigned)(tg * 16 + (lane2 & 15)) * 128u + (unsigned)((hq * 4 + (lane2 >> 4)) * 16);
        int* ip = PIDX + oo;
        float* wp = PW + oo;
#pragma unroll
        for (int r = 0; r < 16; r += 4) {
            *(int4*)(ip + r) = make_int4(fe[r], fe[r + 1], fe[r + 2], fe[r + 3]);
            *(float4*)(wp + r) = make_float4(fs[r] * inv, fs[r + 1] * inv, fs[r + 2] * inv, fs[r + 3] * inv);
        }
    }
    __syncthreads();
}
typedef __bf16 bf16x2v __attribute__((ext_vector_type(2)));
__device__ __forceinline__ float dot2bf(unsigned a, unsigned b, float c) {
    return __builtin_amdgcn_fdot2_f32_bf16(__builtin_bit_cast(bf16x2v, a), __builtin_bit_cast(bf16x2v, b), c, false);
}
__device__ __forceinline__ float gelu_fast(float x) {
    const float z = 1.5957691216057308f * (x + 0.044715f * x * x * x);
    return x * __builtin_amdgcn_rcpf(1.0f + __expf(-z));
}
constexpr int GNT = 4;
constexpr int G_LDS_WAVE = 14848;
typedef float f32x2v __attribute__((ext_vector_type(2)));
typedef int v8i32 __attribute__((ext_vector_type(8)));
__device__ __forceinline__ float row_sum16(float v) {
    v += __builtin_bit_cast(float, __builtin_amdgcn_update_dpp(0, __builtin_bit_cast(int, v), 0xB1, 0xF, 0xF, false));
    v += __builtin_bit_cast(float, __builtin_amdgcn_update_dpp(0, __builtin_bit_cast(int, v), 0x4E, 0xF, 0xF, false));
    v += __builtin_bit_cast(float, __builtin_amdgcn_update_dpp(0, __builtin_bit_cast(int, v), 0x141, 0xF, 0xF, false));
    v += __builtin_bit_cast(float, __builtin_amdgcn_update_dpp(0, __builtin_bit_cast(int, v), 0x140, 0xF, 0xF, false));
    return v;
}
#define G_LD2(dst, base) do { _Pragma("unroll") for (int k_ = 0; k_ < 2; ++k_) (dst)[k_] = *(const u32x4*)((base) + rowoff + 256 * k_); } while (0)
#define G_ACC8(dw, xi) do { acc[(xi)] += __builtin_amdgcn_cvt_scalef32_pk_f32_fp4((dw), 1.0f, 0) * ww_; acc[(xi) + 1] += __builtin_amdgcn_cvt_scalef32_pk_f32_fp4((dw), 1.0f, 1) * ww_; \
                                acc[(xi) + 2] += __builtin_amdgcn_cvt_scalef32_pk_f32_fp4((dw), 1.0f, 2) * ww_; acc[(xi) + 3] += __builtin_amdgcn_cvt_scalef32_pk_f32_fp4((dw), 1.0f, 3) * ww_; } while (0)
__device__ __forceinline__ f32x4 ldpre4(const bf16_t* p) { const u32x2 w = *(const u32x2*)p; return (f32x4){__uint_as_float(w.x << 16), __uint_as_float(w.x & 0xffff0000u), __uint_as_float(w.y << 16), __uint_as_float(w.y & 0xffff0000u)}; }
constexpr int GRING = 3;
__device__ __forceinline__ void ph_peer_gather(const float* X1, const int* PIDX, const float* PW, const unsigned char* TU, const unsigned char* TV, const float* SINV,
                                               const float* lg, const float* lb, float* OUT, bf16_t* XB, LAS unsigned char* l3, const float* RS, const float* g1, const float* b1) {
    const int tid = (int)tidx(), lane = tid & 63, tj = lane >> 4, li = lane & 15;
    const int wave = __builtin_amdgcn_readfirstlane(tid >> 6);
    LAS unsigned* keyL = (LAS unsigned*)(l3 + wave * G_LDS_WAVE);
    LAS float* wL = (LAS float*)(l3 + wave * G_LDS_WAVE + 2048);
    const int ebase = tj * 128;
    const int ngrp = T / GNT;
#pragma unroll 1
    for (int grp = (int)bidx() * 8 + wave; grp < ngrp; grp += (int)gdim() * 8) {
        const int tbase = grp * GNT;
        const int lane = (int)tidx() & 63, tj = lane >> 4, li = lane & 15, ebase = tj * 128;
#pragma unroll
        for (int i = 0; i < 8; ++i) {
            const int e = lane + 64 * i;
            keyL[e] = ((unsigned)(e >> 7) << 23) | ((unsigned)PIDX[(size_t)tbase * 128 + e] << 9) | (unsigned)e;
            wL[e] = PW[(size_t)tbase * 128 + e];
        }
        asm volatile("s_waitcnt lgkmcnt(0)" ::: "memory");
#pragma unroll 1
        for (int k = 2; k <= 128; k <<= 1)
#pragma unroll 1
            for (int j = k >> 1; j > 0; j >>= 1) {
#pragma unroll
                for (int i = 0; i < 4; ++i) {
                    const int q = lane + 64 * i;
                    const int x = ((q & ~(j - 1)) << 1) | (q & (j - 1)), y = x | j;
                    const unsigned a = keyL[x], b = keyL[y];
                    const bool asc = (k == 128) || ((x & k) == 0);
                    const bool sw = asc ? (a > b) : (a < b);
                    keyL[x] = sw ? b : a; keyL[y] = sw ? a : b;
                }
                asm volatile("s_waitcnt lgkmcnt(0)" ::: "memory");
            }
        const size_t ro = (size_t)(tbase + tj) * D + 16 * li;
        size_t rowoff;
        const float2 rs2 = *(const float2*)(RS + (size_t)(tbase + tj) * 2); const float mu1 = rs2.x, rs1 = rs2.y;
        {
            LAS float* hL = (LAS float*)(l3 + wave * G_LDS_WAVE + 4608);
            LAS unsigned char* xbL = l3 + wave * G_LDS_WAVE + 6656;
#pragma unroll
            for (int k = 0; k < 4; ++k) {
                float xv[16];
#pragma unroll
                for (int c = 0; c < 4; ++c) {
                    const f32x4 gg = *(const f32x4*)(g1 + 256 * k + 16 * li + 4 * c), bb = *(const f32x4*)(b1 + 256 * k + 16 * li + 4 * c);
                    const f32x4 a = (ldpre4(XB + ro + 256 * k + 4 * c) - mu1) * rs1 * gg + bb;
                    xv[4 * c] = a[0]; xv[4 * c + 1] = a[1]; xv[4 * c + 2] = a[2]; xv[4 * c + 3] = a[3];
                }
#pragma unroll
                for (int n = 0; n < 4; ++n) {
                    const float sn = n == 0 ? 2.0f : n == 1 ? 0.5f : n == 2 ? 0.125f : 0.03125f, isn = 1.0f / sn;
                    unsigned d0 = 0u, d1 = 0u;
                    d0 = __builtin_amdgcn_cvt_scalef32_pk_fp4_f32(d0, xv[0] * isn, xv[1] * isn, 1.0f, 0);
                    d0 = __builtin_amdgcn_cvt_scalef32_pk_fp4_f32(d0, xv[2] * isn, xv[3] * isn, 1.0f, 1);
                    d0 = __builtin_amdgcn_cvt_scalef32_pk_fp4_f32(d0, xv[4] * isn, xv[5] * isn, 1.0f, 2);
                    d0 = __builtin_amdgcn_cvt_scalef32_pk_fp4_f32(d0, xv[6] * isn, xv[7] * isn, 1.0f, 3);
                    d1 = __builtin_amdgcn_cvt_scalef32_pk_fp4_f32(d1, xv[8] * isn, xv[9] * isn, 1.0f, 0);
                    d1 = __builtin_amdgcn_cvt_scalef32_pk_fp4_f32(d1, xv[10] * isn, xv[11] * isn, 1.0f, 1);
                    d1 = __builtin_amdgcn_cvt_scalef32_pk_fp4_f32(d1, xv[12] * isn, xv[13] * isn, 1.0f, 2);
                    d1 = __builtin_amdgcn_cvt_scalef32_pk_fp4_f32(d1, xv[14] * isn, xv[15] * isn, 1.0f, 3);
                    { const f32x2v q = __builtin_amdgcn_cvt_scalef32_pk_f32_fp4(d0, 1.0f, 0); xv[0] -= q.x * sn; xv[1] -= q.y * sn; }
                    { const f32x2v q = __builtin_amdgcn_cvt_scalef32_pk_f32_fp4(d0, 1.0f, 1); xv[2] -= q.x * sn; xv[3] -= q.y * sn; }
                    { const f32x2v q = __builtin_amdgcn_cvt_scalef32_pk_f32_fp4(d0, 1.0f, 2); xv[4] -= q.x * sn; xv[5] -= q.y * sn; }
                    { const f32x2v q = __builtin_amdgcn_cvt_scalef32_pk_f32_fp4(d0, 1.0f, 3); xv[6] -= q.x * sn; xv[7] -= q.y * sn; }
                    { const f32x2v q = __builtin_amdgcn_cvt_scalef32_pk_f32_fp4(d1, 1.0f, 0); xv[8] -= q.x * sn; xv[9] -= q.y * sn; }
                    { const f32x2v q = __builtin_amdgcn_cvt_scalef32_pk_f32_fp4(d1, 1.0f, 1); xv[10] -= q.x * sn; xv[11] -= q.y * sn; }
                    { const f32x2v q = __builtin_amdgcn_cvt_scalef32_pk_f32_fp4(d1, 1.0f, 2); xv[12] -= q.x * sn; xv[13] -= q.y * sn; }
                    { const f32x2v q = __builtin_amdgcn_cvt_scalef32_pk_f32_fp4(d1, 1.0f, 3); xv[14] -= q.x * sn; xv[15] -= q.y * sn; }
                    u32x2 w2; w2.x = d0; w2.y = d1;
                    *(LAS u32x2*)(xbL + tj * 2048 + n * 512 + 128 * k + 8 * li) = w2;
                }
            }
            asm volatile("s_waitcnt lgkmcnt(0)" ::: "memory");
            const float colw = li == 0 ? 2.0f : li == 1 ? 0.5f : li == 2 ? 0.125f : li == 3 ? 0.03125f : 0.f;
            u32x4 af[2][8];
            const int psrc = (4 * li + tj) * 4;
            u32x4 bf[8];
#define GU_LOADA(buf, q_) do { const unsigned key_ = keyL[((q_) & 3) * 128 + 16 * ((q_) >> 2) + (lane >> 2)]; const unsigned char* ap_ = TU + (size_t)((key_ >> 9) & 16383u) * (D / 2) + 16 * (lane & 3); \
                               _Pragma("unroll") for (int s_ = 0; s_ < 8; ++s_) af[buf][s_] = *(const u32x4*)(ap_ + 64 * s_); } while (0)
#define GU_GROUP(buf, q_) do { f32x4 c0_ = (f32x4){0.f, 0.f, 0.f, 0.f}, c1_ = (f32x4){0.f, 0.f, 0.f, 0.f}; \
                               { const LAS unsigned char* bp_ = xbL + ((q_) & 3) * 2048 + (li & 3) * 512 + 16 * tj; _Pragma("unroll") for (int s_ = 0; s_ < 8; ++s_) bf[s_] = *(const LAS u32x4*)(bp_ + 64 * s_); } \
                               u32x4 ap8_[8]; _Pragma("unroll") for (int s_ = 0; s_ < 8; ++s_) { ap8_[s_].x = (unsigned)__builtin_amdgcn_ds_bpermute(psrc, (int)af[buf][s_].x); ap8_[s_].y = (unsigned)__builtin_amdgcn_ds_bpermute(psrc, (int)af[buf][s_].y); ap8_[s_].z = (unsigned)__builtin_amdgcn_ds_bpermute(psrc, (int)af[buf][s_].z); ap8_[s_].w = (unsigned)__builtin_amdgcn_ds_bpermute(psrc, (int)af[buf][s_].w); } \
                               _Pragma("unroll") for (int s_ = 0; s_ < 8; s_ += 2) { \
                                   c0_ = __builtin_amdgcn_mfma_scale_f32_16x16x128_f8f6f4((v8i32){(int)ap8_[s_].x, (int)ap8_[s_].y, (int)ap8_[s_].z, (int)ap8_[s_].w, 0, 0, 0, 0}, (v8i32){(int)bf[s_].x, (int)bf[s_].y, (int)bf[s_].z, (int)bf[s_].w, 0, 0, 0, 0}, c0_, 4, 4, 0, 0x7F7F7F7F, 0, 0x7F7F7F7F); \
                                   c1_ = __builtin_amdgcn_mfma_scale_f32_16x16x128_f8f6f4((v8i32){(int)ap8_[s_ + 1].x, (int)ap8_[s_ + 1].y, (int)ap8_[s_ + 1].z, (int)ap8_[s_ + 1].w, 0, 0, 0, 0}, (v8i32){(int)bf[s_ + 1].x, (int)bf[s_ + 1].y, (int)bf[s_ + 1].z, (int)bf[s_ + 1].w, 0, 0, 0, 0}, c1_, 4, 4, 0, 0x7F7F7F7F, 0, 0x7F7F7F7F); } \
                               c0_ = c0_ + c1_; f32x4 hs_; \
                               _Pragma("unroll") for (int i_ = 0; i_ < 4; ++i_) hs_[i_] = row_sum16(c0_[i_] * colw); \
                               if (li == 0) *(LAS f32x4*)(hL + ((q_) & 3) * 128 + 16 * ((q_) >> 2) + 4 * tj) = hs_; } while (0)
            GU_LOADA(0, 0);
#pragma unroll 1
            for (int q2 = 0; q2 < 16; ++q2) {
                GU_LOADA(1, 2 * q2 + 1);
                GU_GROUP(0, 2 * q2);
                { const int qn = (2 * q2 + 2) < 32 ? (2 * q2 + 2) : 31; GU_LOADA(0, qn); }
                GU_GROUP(1, 2 * q2 + 1);
            }
#undef GU_LOADA
#undef GU_GROUP
            asm volatile("s_waitcnt lgkmcnt(0)" ::: "memory");
#pragma unroll
            for (int i = 0; i < 8; ++i) {
                const int e = lane + 64 * i;
                const unsigned key_ = keyL[e]; const unsigned ex_ = (key_ >> 9) & 16383u;
                const f32x2v si = *(const f32x2v*)(SINV + 2 * ex_);
                const float d_ = hL[e] * si.x;
                wL[key_ & 511u] = wL[key_ & 511u] * si.y * gelu_fast(d_);
            }
        }
        asm volatile("s_waitcnt lgkmcnt(0)" ::: "memory");
        f32x2v acc[32];
#pragma unroll
        for (int i = 0; i < 32; ++i) acc[i] = (f32x2v){0.f, 0.f};
        {
            u32x4 vb[GRING][2]; float mw[GRING];
#pragma unroll
            for (int r = 0; r < GRING; ++r) {
                const unsigned key_ = keyL[ebase + r];
                mw[r] = wL[key_ & 511u];
                rowoff = (size_t)((key_ >> 9) & 16383u) * (D / 2) + 16 * li;
                G_LD2(vb[r], TV);
            }
#pragma unroll 1
            for (int st = 0; st < 126 + GRING; st += GRING) {
#pragma unroll
                for (int r = 0; r < GRING; ++r) {
                    const float ww_ = mw[r];
#pragma unroll
                    for (int s_ = 0; s_ < 2; ++s_) { __builtin_amdgcn_sched_barrier(0); G_ACC8(vb[r][s_].x, 16 * s_ + 0); G_ACC8(vb[r][s_].y, 16 * s_ + 4); G_ACC8(vb[r][s_].z, 16 * s_ + 8); G_ACC8(vb[r][s_].w, 16 * s_ + 12); }
                    const bool more = (st + r + GRING) < 128;
                    const int nx = more ? (st + r + GRING) : 127;
                    const unsigned key_ = keyL[ebase + nx];
                    mw[r] = more ? wL[key_ & 511u] : 0.f;
                    rowoff = (size_t)((key_ >> 9) & 16383u) * (D / 2) + 16 * li;
                    asm volatile("" ::: "memory");
                    G_LD2(vb[r], TV);
                    asm volatile("" ::: "memory");
                }
            }
        }
        {
            const int lane_e = (int)tidx() & 63, tj = lane_e >> 4, li = lane_e & 15;
            const size_t ro = (size_t)(tbase + tj) * D + 16 * li;
            const float2 rs2e = *(const float2*)(RS + (size_t)(tbase + tj) * 2); const float mu1 = rs2e.x, rs1 = rs2e.y;
            float sum = 0.f;
#pragma unroll
            for (int k = 0; k < 4; ++k)
#pragma unroll
                for (int c = 0; c < 4; ++c) {
                    if (c == 0) asm volatile("" ::: "memory");
                    const f32x4 gg = *(const f32x4*)(g1 + 256 * k + 16 * li + 4 * c), bb = *(const f32x4*)(b1 + 256 * k + 16 * li + 4 * c);
                    const f32x4 a = (ldpre4(XB + ro + 256 * k + 4 * c) - mu1) * rs1 * gg + bb;
                    acc[8 * k + 2 * c] += (f32x2v){a[0], a[1]} * DN_ALPHA; acc[8 * k + 2 * c + 1] += (f32x2v){a[2], a[3]} * DN_ALPHA;
                }
#pragma unroll
            for (int i = 0; i < 32; ++i) sum += acc[i].x + acc[i].y;
            const float mu = row_sum16(sum) * (1.0f / D);
            float sq = 0.f;
#pragma unroll
            for (int i = 0; i < 32; ++i) { acc[i] = acc[i] - mu; sq += acc[i].x * acc[i].x + acc[i].y * acc[i].y; }
            const float rsd = 1.0f / sqrtf(row_sum16(sq) * (1.0f / D) + LN_EPS);
#pragma unroll
            for (int k = 0; k < 4; ++k)
#pragma unroll
                for (int c = 0; c < 4; c += 2) {
                    asm volatile("" ::: "memory");
                    const size_t off = 256 * k + 16 * li + 4 * c;
                    const f32x4 g0 = *(const f32x4*)(lg + off), g1 = *(const f32x4*)(lg + off + 4), c0 = *(const f32x4*)(lb + off), c1 = *(const f32x4*)(lb + off + 4);
                    const f32x2v a0 = acc[8 * k + 2 * c], a1 = acc[8 * k + 2 * c + 1], a2 = acc[8 * k + 2 * c + 2], a3 = acc[8 * k + 2 * c + 3];
                    f32x4 o0, o1;
                    o0[0] = a0.x * rsd * g0[0] + c0[0]; o0[1] = a0.y * rsd * g0[1] + c0[1]; o0[2] = a1.x * rsd * g0[2] + c0[2]; o0[3] = a1.y * rsd * g0[3] + c0[3];
                    o1[0] = a2.x * rsd * g1[0] + c1[0]; o1[1] = a2.y * rsd * g1[1] + c1[1]; o1[2] = a3.x * rsd * g1[2] + c1[2]; o1[3] = a3.y * rsd * g1[3] + c1[3];
                    if (OUT) { float* op = OUT + (size_t)(tbase + tj) * D + off; *(f32x4*)op = o0; *(f32x4*)(op + 4) = o1; }
                    u32x4 w; w.x = pk2(o0[0], o0[1]); w.y = pk2(o0[2], o0[3]); w.z = pk2(o1[0], o1[1]); w.w = pk2(o1[2], o1[3]);
                    *(u32x4*)(XB + (size_t)(tbase + tj) * D + off) = w;
                }
        }
        asm volatile("s_waitcnt lgkmcnt(0)" ::: "memory");
    }
}
typedef short bf16x4_t __attribute__((ext_vector_type(4)));
__device__ __forceinline__ bf16x8_t ld8(const bf16_t* p) { return *(const bf16x8_t*)p; }
__device__ __forceinline__ bf16x8_t cat44(const bf16_t* p0, const bf16_t* p1) {
    const bf16x4_t a = *(const bf16x4_t*)p0, b = *(const bf16x4_t*)p1;
    return (bf16x8_t){a[0], a[1], a[2], a[3], b[0], b[1], b[2], b[3]};
}
__device__ __forceinline__ void ph_retkv(const bf16_t* VRT, const bf16_t* KRT, float* KVT, LAS unsigned char* l3) {
    const int tid = (int)tidx(), lane = tid & 63, g = lane >> 4, li = lane & 15;
    const int wave = __builtin_amdgcn_readfirstlane(tid >> 6);
    const int gd_ = (int)gdim(), bx0_ = (int)bidx();
    const int vcu = (gd_ % 8 == 0) ? (bx0_ % 8) * (gd_ / 8) + bx0_ / 8 : bx0_;
#pragma unroll 1
    for (int item = vcu; item < 8 * RNC; item += gd_) {
        const int bh = item >> 5, n = item & 31;
        {
            const bf16_t* kg = KRT + ((size_t)bh * 128) * S + n * 256;
#pragma unroll
            for (int q = 0; q < 8; ++q) {
                const int c = tid + 512 * q, d = c >> 5, ch = c & 31;
                const u32x4 v = *(const u32x4*)(kg + (size_t)d * S + ch * 8);
                *(LAS u32x4*)(l3 + d * 512 + ((ch ^ (d & 31)) * 16)) = v;
            }
        }
        const bf16_t* vb = VRT + ((size_t)bh * 256 + 32 * wave + li) * S + n * 256 + 8 * g;
        bf16x8_t a0[8], a1[8];
#pragma unroll
        for (int s = 0; s < 8; ++s) { a0[s] = ld8(vb + 32 * s); a1[s] = ld8(vb + (size_t)16 * S + 32 * s); }
        __syncthreads();
        f32x4 acc[2][8];
#pragma unroll
        for (int a = 0; a < 2; ++a)
#pragma unroll
            for (int d = 0; d < 8; ++d) acc[a][d] = (f32x4){0.f, 0.f, 0.f, 0.f};
#pragma unroll
        for (int s = 0; s < 8; ++s) {
#pragma unroll
            for (int dt = 0; dt < 8; ++dt) {
                const int d = 16 * dt + li;
                const bf16x8_t kf = *(const LAS bf16x8_t*)(l3 + d * 512 + (((4 * s + g) ^ (d & 31)) * 16));
                acc[0][dt] = __builtin_amdgcn_mfma_f32_16x16x32_bf16(a0[s], kf, acc[0][dt], 0, 0, 0);
                acc[1][dt] = __builtin_amdgcn_mfma_f32_16x16x32_bf16(a1[s], kf, acc[1][dt], 0, 0, 0);
            }
        }
        float* ob = KVT + (((size_t)item) << 15);
#pragma unroll
        for (int a = 0; a < 2; ++a)
#pragma unroll
            for (int dt = 0; dt < 8; ++dt)
#pragma unroll
                for (int r = 0; r < 4; ++r) ob[(size_t)(32 * wave + 16 * a + 4 * g + r) * 128 + 16 * dt + li] = acc[a][dt][r];
        __syncthreads();
    }
}
constexpr int RO_PREV = 0, RO_K = 65536, RO_V = RO_K + 2 * 8192, RO_END = RO_V + 2 * 16384;
static_assert(RO_END <= 131072, "retout LDS map");
__device__ __forceinline__ void ph_retout(const bf16_t* QR, const bf16_t* KR, const bf16_t* VRT, const bf16_t* PREVT, const bf16_t* GR, bf16_t* YR, LAS unsigned char* l3) {
    const int tid = (int)tidx(), lane = tid & 63, g = lane >> 4, li = lane & 15;
    const int wave = __builtin_amdgcn_readfirstlane(tid >> 6);
    const int gd_ = (int)gdim(), bx0_ = (int)bidx();
    const int vcu = (gd_ % 8 == 0) ? (bx0_ % 8) * (gd_ / 8) + bx0_ / 8 : bx0_;
#pragma unroll 1
    for (int item = vcu; item < 8 * RNC; item += gd_) {
        const int bh = item >> 5, n = item & 31, b = bh >> 2, h = bh & 3;
        const size_t tok0 = (size_t)b * S + n * 256;
        {
            const bf16_t* pg = PREVT + (((size_t)item) << 15);
#pragma unroll
            for (int q = 0; q < 8; ++q) {
                const int c = tid + 512 * q, e = c >> 4, ch = c & 15;
                const u32x4 v = *(const u32x4*)(pg + (size_t)c * 8);
                *(LAS u32x4*)(l3 + RO_PREV + e * 256 + ((ch ^ (e & 15)) * 16)) = v;
            }
        }
        u32x4 kreg, vreg[2];
        const int krow = tid >> 4, kch = tid & 15;
#pragma unroll 1
        for (int hf = 0; hf < 2; ++hf) {
            const int tg = hf == 0 ? wave : 15 - wave, nstep = hf == 0 ? 4 : 8;
            const int c = 16 * tg + li;
            kreg = *(const u32x4*)(KR + (tok0 + krow) * 512 + h * 128 + kch * 8);
#pragma unroll
            for (int q = 0; q < 2; ++q) { const int cx = tid + 512 * q, e = cx >> 2, ch = cx & 3; vreg[q] = *(const u32x4*)(VRT + ((size_t)bh * 256 + e) * S + n * 256 + ch * 8); }
            bf16x8_t qf[4];
            {
                const bf16_t* qp = QR + (tok0 + c) * 512 + h * 128 + 8 * g;
#pragma unroll
                for (int ks = 0; ks < 4; ++ks) qf[ks] = ld8(qp + 32 * ks);
            }
            *(LAS u32x4*)(l3 + RO_K + krow * 256 + ((kch ^ (krow & 15)) * 16)) = kreg;
#pragma unroll
            for (int q = 0; q < 2; ++q) { const int cx = tid + 512 * q, e = cx >> 2, ch = cx & 3; *(LAS u32x4*)(l3 + RO_V + e * 64 + ((ch ^ ((e >> 1) & 3)) * 16)) = vreg[q]; }
            __syncthreads();
            f32x4 y[16];
#pragma unroll
            for (int et = 0; et < 16; ++et) {
                f32x4 a0 = (f32x4){0.f, 0.f, 0.f, 0.f};
                const int e = 16 * et + li;
#pragma unroll
                for (int ks = 0; ks < 4; ++ks) {
                    const bf16x8_t pf = *(const LAS bf16x8_t*)(l3 + RO_PREV + e * 256 + (((4 * ks + g) ^ (e & 15)) * 16));
                    a0 = __builtin_amdgcn_mfma_f32_16x16x32_bf16(pf, qf[ks], a0, 0, 0, 0);
                }
                y[et] = a0;
            }
#pragma unroll 1
            for (int s = 0; s < nstep; ++s) {
                const int buf = s & 1;
                if (s + 1 < nstep) {
                    kreg = *(const u32x4*)(KR + (tok0 + 32 * (s + 1) + krow) * 512 + h * 128 + kch * 8);
#pragma unroll
                    for (int q = 0; q < 2; ++q) { const int cx = tid + 512 * q, e = cx >> 2, ch = cx & 3; vreg[q] = *(const u32x4*)(VRT + ((size_t)bh * 256 + e) * S + n * 256 + 32 * (s + 1) + ch * 8); }
                }
                if (2 * s <= tg) {
                    f32x4 s0 = (f32x4){0.f, 0.f, 0.f, 0.f}, s1 = s0;
#pragma unroll
                    for (int ks = 0; ks < 4; ++ks) {
                        const bf16x8_t k0 = *(const LAS bf16x8_t*)(l3 + RO_K + buf * 8192 + li * 256 + (((4 * ks + g) ^ li) * 16));
                        const bf16x8_t k1 = *(const LAS bf16x8_t*)(l3 + RO_K + buf * 8192 + (16 + li) * 256 + (((4 * ks + g) ^ li) * 16));
                        s0 = __builtin_amdgcn_mfma_f32_16x16x32_bf16(k0, qf[ks], s0, 0, 0, 0);
                        s1 = __builtin_amdgcn_mfma_f32_16x16x32_bf16(k1, qf[ks], s1, 0, 0, 0);
                    }
                    const int m0 = 32 * s + 4 * g;
                    float p0[4], p1[4];
#pragma unroll
                    for (int r = 0; r < 4; ++r) { p0[r] = (m0 + r <= c) ? s0[r] : 0.f; p1[r] = (m0 + 16 + r <= c) ? s1[r] : 0.f; }
                    const bf16x8_t pf = __builtin_bit_cast(bf16x8_t, (u32x4){pk2(p0[0], p0[1]), pk2(p0[2], p0[3]), pk2(p1[0], p1[1]), pk2(p1[2], p1[3])});
#pragma unroll
                    for (int et = 0; et < 16; ++et) {
                        const int e = 16 * et + li, sw = (e >> 1) & 3;
                        const LAS unsigned char* vrow = l3 + RO_V + buf * 16384 + e * 64 + 8 * (g & 1);
                        const bf16x4_t a = *(const LAS bf16x4_t*)(vrow + (((g >> 1) ^ sw) * 16)), cq = *(const LAS bf16x4_t*)(vrow + ((((g >> 1) + 2) ^ sw) * 16));
                        const bf16x8_t vf = (bf16x8_t){a[0], a[1], a[2], a[3], cq[0], cq[1], cq[2], cq[3]};
                        y[et] = __builtin_amdgcn_mfma_f32_16x16x32_bf16(vf, pf, y[et], 0, 0, 0);
                    }
                }
                if (s + 1 < nstep) {
                    *(LAS u32x4*)(l3 + RO_K + (buf ^ 1) * 8192 + krow * 256 + ((kch ^ (krow & 15)) * 16)) = kreg;
#pragma unroll
                    for (int q = 0; q < 2; ++q) { const int cx = tid + 512 * q, e = cx >> 2, ch = cx & 3; *(LAS u32x4*)(l3 + RO_V + (buf ^ 1) * 16384 + e * 64 + ((ch ^ ((e >> 1) & 3)) * 16)) = vreg[q]; }
                }
                __syncthreads();
            }
            float sum = 0.f;
#pragma unroll
            for (int et = 0; et < 16; ++et) sum += (y[et][0] + y[et][1]) + (y[et][2] + y[et][3]);
            sum += __shfl_xor(sum, 16); sum += __shfl_xor(sum, 32);
            const float mu = sum * (1.0f / 256.0f);
            float sq = 0.f;
#pragma unroll
            for (int et = 0; et < 16; ++et) { y[et] = y[et] - mu; sq += (y[et][0] * y[et][0] + y[et][1] * y[et][1]) + (y[et][2] * y[et][2] + y[et][3] * y[et][3]); }
            sq += __shfl_xor(sq, 16); sq += __shfl_xor(sq, 32);
            const float rs = 1.0f / sqrtf(sq * (1.0f / 256.0f) + LN_EPS);
            const bf16_t* gp = GR + (tok0 + c) * 1024 + h * 256 + 4 * g;
            bf16_t* yp = YR + (tok0 + c) * 1024 + h * 256 + 4 * g;
#pragma unroll
            for (int et = 0; et < 16; ++et) {
                const u32x2 gg = *(const u32x2*)(gp + 16 * et);
                u32x2 o;
                o.x = pk2(y[et][0] * rs * __uint_as_float(gg.x << 16), y[et][1] * rs * __uint_as_float(gg.x & 0xffff0000u));
                o.y = pk2(y[et][2] * rs * __uint_as_float(gg.y << 16), y[et][3] * rs * __uint_as_float(gg.y & 0xffff0000u));
                *(u32x2*)(yp + 16 * et) = o;
            }
        }
    }
}
constexpr int MB_KOFF = 0, MB_VOFF = 32768, MB_STATE = 65536, MB_SSTR = 144, MB_LIST = MB_STATE + 256 * MB_SSTR, MB_CNT = MB_LIST + 32 * 256, MB_SCR = MB_CNT + 256, MB_SCR_W = 16 * 68 * 4;
static_assert(MB_SCR + 8 * MB_SCR_W <= 147200, "moba LDS map");
__device__ __forceinline__ void top3_insert(float v, int n, float& v0, float& v1, float& v2, int& i0, int& i1, int& i2) {
    const bool b0 = (v > v0) || (v == v0 && n < i0), b1 = (v > v1) || (v == v1 && n < i1), b2 = (v > v2) || (v == v2 && n < i2);
    const float nv2 = b1 ? v1 : (b2 ? v : v2); const int ni2 = b1 ? i1 : (b2 ? n : i2);
    const float nv1 = b0 ? v0 : (b1 ? v : v1); const int ni1 = b0 ? i0 : (b1 ? n : i1);
    v0 = b0 ? v : v0; i0 = b0 ? n : i0; v1 = nv1; i1 = ni1; v2 = nv2; i2 = ni2;
}
template <int NCG, bool OWN>
__device__ __forceinline__ void moba_block(LAS unsigned char* l3, int tile0, int ntile, const bf16x8_t (&qf)[NCG][2], const int (&qrow)[NCG], f32x4 (&o)[NCG][4], float (&mrun)[NCG], float (&lrun)[NCG], int g, int li) {
    constexpr float LOG2E = 1.4426950408889634f;
    const int sw = li & 7;
#pragma unroll 1
    for (int tt = tile0; tt < ntile; ++tt) {
        const LAS unsigned char* kbase = l3 + MB_KOFF + (64 * tt + li) * 128;
        const LAS unsigned char* vbase = l3 + MB_VOFF + (64 * tt + li) * 128;
        f32x4 sa[NCG][4];
#pragma unroll
        for (int kt = 0; kt < 4; ++kt) {
            const bf16x8_t k0 = *(const LAS bf16x8_t*)(kbase + kt * 2048 + ((g ^ sw) * 16)), k1 = *(const LAS bf16x8_t*)(kbase + kt * 2048 + (((4 + g) ^ sw) * 16));
#pragma unroll
            for (int cg = 0; cg < NCG; ++cg) {
                f32x4 a = __builtin_amdgcn_mfma_f32_16x16x32_bf16(k0, qf[cg][0], (f32x4){0.f, 0.f, 0.f, 0.f}, 0, 0, 0);
                sa[cg][kt] = __builtin_amdgcn_mfma_f32_16x16x32_bf16(k1, qf[cg][1], a, 0, 0, 0);
            }
        }
        bf16x8_t pf[NCG][2];
#pragma unroll
        for (int cg = 0; cg < NCG; ++cg) {
            float tm = NEGF;
#pragma unroll
            for (int kt = 0; kt < 4; ++kt)
#pragma unroll
                for (int r = 0; r < 4; ++r) {
                    float sv = sa[cg][kt][r] * LOG2E;
                    if (OWN) { const int key = 64 * tt + 16 * kt + 4 * g + r; sv = (key <= qrow[cg]) ? sv : NEGF; }
                    sa[cg][kt][r] = sv; tm = fmaxf(tm, sv);
                }
            tm = fmaxf(tm, __shfl_xor(tm, 16)); tm = fmaxf(tm, __shfl_xor(tm, 32));
            const float mn = fmaxf(mrun[cg], tm);
            const float alpha = __builtin_amdgcn_exp2f(mrun[cg] - mn);
            mrun[cg] = mn;
            float ps = 0.f;
#pragma unroll
            for (int kt = 0; kt < 4; ++kt)
#pragma unroll
                for (int r = 0; r < 4; ++r) { const float p = __builtin_amdgcn_exp2f(sa[cg][kt][r] - mn); sa[cg][kt][r] = p; ps += p; }
            lrun[cg] = lrun[cg] * alpha + ps;
#pragma unroll
            for (int dt = 0; dt < 4; ++dt) o[cg][dt] = o[cg][dt] * alpha;
#pragma unroll
            for (int s2 = 0; s2 < 2; ++s2)
                pf[cg][s2] = __builtin_bit_cast(bf16x8_t, (u32x4){pk2(sa[cg][2 * s2][0], sa[cg][2 * s2][1]), pk2(sa[cg][2 * s2][2], sa[cg][2 * s2][3]),
                                                                   pk2(sa[cg][2 * s2 + 1][0], sa[cg][2 * s2 + 1][1]), pk2(sa[cg][2 * s2 + 1][2], sa[cg][2 * s2 + 1][3])});
        }
#pragma unroll
        for (int dt = 0; dt < 4; ++dt)
#pragma unroll
            for (int s2 = 0; s2 < 2; ++s2) {
                const int c0 = 4 * s2 + (g >> 1);
                const bf16x4_t a = *(const LAS bf16x4_t*)(vbase + dt * 2048 + ((c0 ^ sw) * 16) + 8 * (g & 1)), c = *(const LAS bf16x4_t*)(vbase + dt * 2048 + (((c0 + 2) ^ sw) * 16) + 8 * (g & 1));
                const bf16x8_t vf = (bf16x8_t){a[0], a[1], a[2], a[3], c[0], c[1], c[2], c[3]};
#pragma unroll
                for (int cg = 0; cg < NCG; ++cg) o[cg][dt] = __builtin_amdgcn_mfma_f32_16x16x32_bf16(vf, pf[cg][s2], o[cg][dt], 0, 0, 0);
            }
    }
}
__device__ __forceinline__ void moba_past_group(LAS unsigned char* l3, const bf16x8_t (&qf)[2], f32x4 (&o)[4], float& mout, float& lout, int g, int li) {
    constexpr float LOG2E = 1.4426950408889634f;
    const int sw = li & 7;
    f32x4 sa[16];
#pragma unroll
    for (int t = 0; t < 16; ++t) {
        const LAS unsigned char* kbase = l3 + MB_KOFF + (16 * t + li) * 128;
        const bf16x8_t k0 = *(const LAS bf16x8_t*)(kbase + ((g ^ sw) * 16)), k1 = *(const LAS bf16x8_t*)(kbase + (((4 + g) ^ sw) * 16));
        f32x4 a = __builtin_amdgcn_mfma_f32_16x16x32_bf16(k0, qf[0], (f32x4){0.f, 0.f, 0.f, 0.f}, 0, 0, 0);
        sa[t] = __builtin_amdgcn_mfma_f32_16x16x32_bf16(k1, qf[1], a, 0, 0, 0);
    }
    float tm = NEGF;
#pragma unroll
    for (int t = 0; t < 16; ++t) { sa[t] = sa[t] * LOG2E; tm = fmaxf(fmaxf(tm, fmaxf(sa[t][0], sa[t][1])), fmaxf(sa[t][2], sa[t][3])); }
    tm = fmaxf(tm, __shfl_xor(tm, 16)); tm = fmaxf(tm, __shfl_xor(tm, 32));
    float ps = 0.f;
    bf16x8_t pf[8];
#pragma unroll
    for (int u = 0; u < 8; ++u) {
        float p[8];
#pragma unroll
        for (int r = 0; r < 4; ++r) { p[r] = __builtin_amdgcn_exp2f(sa[2 * u][r] - tm); p[4 + r] = __builtin_amdgcn_exp2f(sa[2 * u + 1][r] - tm); }
        ps += ((p[0] + p[1]) + (p[2] + p[3])) + ((p[4] + p[5]) + (p[6] + p[7]));
        pf[u] = __builtin_bit_cast(bf16x8_t, (u32x4){pk2(p[0], p[1]), pk2(p[2], p[3]), pk2(p[4], p[5]), pk2(p[6], p[7])});
    }
#pragma unroll
    for (int dt = 0; dt < 4; ++dt) {
        f32x4 acc = (f32x4){0.f, 0.f, 0.f, 0.f};
#pragma unroll
        for (int u = 0; u < 8; ++u) {
            const LAS unsigned char* vbase = l3 + MB_VOFF + (64 * (u >> 1) + 16 * dt + li) * 128 + 8 * (g & 1);
            const int c0 = 4 * (u & 1) + (g >> 1);
            const bf16x4_t a = *(const LAS bf16x4_t*)(vbase + ((c0 ^ sw) * 16)), c = *(const LAS bf16x4_t*)(vbase + (((c0 + 2) ^ sw) * 16));
            acc = __builtin_amdgcn_mfma_f32_16x16x32_bf16((bf16x8_t){a[0], a[1], a[2], a[3], c[0], c[1], c[2], c[3]}, pf[u], acc, 0, 0, 0);
        }
        o[dt] = acc;
    }
    mout = tm; lout = ps;
}
__device__ __forceinline__ void ph_moba_own(const bf16_t* QA, const bf16_t* KA, const bf16_t* VAT, const float* KMP, LAS unsigned char* l3, unsigned* SEL, bf16_t* OWNO, float* OWNML) {
    const int tid = (int)tidx(), lane = tid & 63, g = lane >> 4, li = lane & 15;
    const int wave = __builtin_amdgcn_readfirstlane(tid >> 6);
    const int gd_ = (int)gdim(), bx0_ = (int)bidx();
    const int vcu = (gd_ % 8 == 0) ? (bx0_ % 8) * (gd_ / 8) + bx0_ / 8 : bx0_;
#pragma unroll 1
    for (int it = vcu; it < 512; it += gd_) {
        const int bh = (it & 255) >> 4, ii = it & 15, i = (it < 256) ? ii : 31 - ii;
        const int b = bh >> 3, h = bh & 7;
        const size_t tok0 = (size_t)b * S + (size_t)i * 256;
        u32x4 kreg[4], vreg[4];
        {
            const bf16_t* kg = KA + tok0 * 512 + h * 64;
            const bf16_t* vg = VAT + ((size_t)bh * 128 + (size_t)i * 4) * 4096;
#pragma unroll
            for (int q = 0; q < 4; ++q) { const int c = tid + 512 * q, row = c >> 3, ch = c & 7; kreg[q] = *(const u32x4*)((const char*)kg + (unsigned)((row * 512 + ch * 8) * 2)); vreg[q] = *(const u32x4*)((const char*)vg + (unsigned)(c * 16)); }
        }
#pragma unroll
        for (int q = 0; q < 4; ++q) {
            const int c = tid + 512 * q, row = c >> 3, ch = c & 7;
            *(LAS u32x4*)(l3 + MB_KOFF + row * 128 + ((ch ^ (row & 7)) * 16)) = kreg[q];
            *(LAS u32x4*)(l3 + MB_VOFF + row * 128 + ((ch ^ (row & 7)) * 16)) = vreg[q];
        }
        bf16x8_t qf[2][2];
#pragma unroll
        for (int cg = 0; cg < 2; ++cg)
#pragma unroll
            for (int ks = 0; ks < 2; ++ks) qf[cg][ks] = ld8(QA + (tok0 + 32 * wave + 16 * cg + li) * 512 + h * 64 + 32 * ks + 8 * g);
        __syncthreads();
        if (i == 0) { if (g == 0) { SEL[(size_t)bh * 8192 + 32 * wave + li] = 0x404040u; SEL[(size_t)bh * 8192 + 32 * wave + 16 + li] = 0x404040u; } }
        if (i > 0) {
            f32x4 ga[2][2];
#pragma unroll
            for (int cg = 0; cg < 2; ++cg)
#pragma unroll
                for (int nt = 0; nt < 2; ++nt) ga[cg][nt] = (f32x4){0.f, 0.f, 0.f, 0.f};
#pragma unroll
            for (int nt = 0; nt < 2; ++nt)
#pragma unroll
                for (int ks = 0; ks < 2; ++ks) {
                    const float* kp = KMP + ((size_t)((b * 32 + 16 * nt + li) * 2)) * 512 + h * 64 + 32 * ks + 8 * g;
                    const f32x4 a0 = *(const f32x4*)kp + *(const f32x4*)(kp + 512), a1 = *(const f32x4*)(kp + 4) + *(const f32x4*)(kp + 516);
                    const float km[8] = {a0[0], a0[1], a0[2], a0[3], a1[0], a1[1], a1[2], a1[3]};
                    unsigned hi[4], lo[4];
#pragma unroll
                    for (int e = 0; e < 4; ++e) {
                        const unsigned h0 = f2bf(km[2 * e]), h1 = f2bf(km[2 * e + 1]);
                        hi[e] = h0 | (h1 << 16);
                        lo[e] = pk2(km[2 * e] - __uint_as_float(h0 << 16), km[2 * e + 1] - __uint_as_float(h1 << 16));
                    }
                    const bf16x8_t fh = __builtin_bit_cast(bf16x8_t, (u32x4){hi[0], hi[1], hi[2], hi[3]}), fl = __builtin_bit_cast(bf16x8_t, (u32x4){lo[0], lo[1], lo[2], lo[3]});
#pragma unroll
                    for (int cg = 0; cg < 2; ++cg) {
                        ga[cg][nt] = __builtin_amdgcn_mfma_f32_16x16x32_bf16(fh, qf[cg][ks], ga[cg][nt], 0, 0, 0);
                        ga[cg][nt] = __builtin_amdgcn_mfma_f32_16x16x32_bf16(fl, qf[cg][ks], ga[cg][nt], 0, 0, 0);
                    }
                }
#pragma unroll
            for (int cg = 0; cg < 2; ++cg) {
                float v0 = NEGF, v1 = NEGF, v2 = NEGF; int i0 = 64, i1 = 64, i2 = 64;
#pragma unroll
                for (int nt = 0; nt < 2; ++nt)
#pragma unroll
                    for (int r = 0; r < 4; ++r) { const int n = 16 * nt + 4 * g + r; if (n < i) top3_insert(ga[cg][nt][r], n, v0, v1, v2, i0, i1, i2); }
#pragma unroll
                for (int o = 16; o <= 32; o <<= 1) {
                    const float w0 = __shfl_xor(v0, o), w1 = __shfl_xor(v1, o), w2 = __shfl_xor(v2, o);
                    const int j0 = __shfl_xor(i0, o), j1 = __shfl_xor(i1, o), j2 = __shfl_xor(i2, o);
                    if (j0 < 64) top3_insert(w0, j0, v0, v1, v2, i0, i1, i2);
                    if (j1 < 64) top3_insert(w1, j1, v0, v1, v2, i0, i1, i2);
                    if (j2 < 64) top3_insert(w2, j2, v0, v1, v2, i0, i1, i2);
                }
                if (g == 0) SEL[(size_t)bh * 8192 + i * 256 + 32 * wave + 16 * cg + li] = (unsigned)i0 | ((unsigned)i1 << 8) | ((unsigned)i2 << 16);
            }
        }
        {
            f32x4 o[2][4]; float mrun[2], lrun[2]; int qrow[2];
#pragma unroll
            for (int cg = 0; cg < 2; ++cg) { mrun[cg] = NEGF; lrun[cg] = 0.f; qrow[cg] = 32 * wave + 16 * cg + li;
#pragma unroll
                for (int dt = 0; dt < 4; ++dt) o[cg][dt] = (f32x4){0.f, 0.f, 0.f, 0.f}; }
            moba_block<2, true>(l3, 0, (32 * wave + 31) / 64 + 1, qf, qrow, o, mrun, lrun, g, li);
#pragma unroll
            for (int cg = 0; cg < 2; ++cg) {
                float l = lrun[cg]; l += __shfl_xor(l, 16); l += __shfl_xor(l, 32);
                const size_t qi = (size_t)bh * 8192 + i * 256 + qrow[cg];
#pragma unroll
                for (int dt = 0; dt < 4; ++dt) { u32x2 w; w.x = pk2(o[cg][dt][0], o[cg][dt][1]); w.y = pk2(o[cg][dt][2], o[cg][dt][3]); *(u32x2*)(OWNO + qi * 64 + 16 * dt + 4 * g) = w; }
                if (g == 0) *(float2*)(OWNML + qi * 2) = make_float2(mrun[cg], l);
            }
        }
        __syncthreads();
    }
}

constexpr int MBU_MAX = 3;
__device__ const unsigned MBU_TAB[16][MBU_MAX] = {
    {0x00200908u, 0x00201413u, 0xFFFFFFFFu},
    {0x00200A09u, 0x00201312u, 0x00201E1Du},
    {0x000C0403u, 0x00201211u, 0xFFFFFFFFu},
    {0x00060201u, 0x00070400u, 0xFFFFFFFFu},
    {0x00200B0Au, 0x00201110u, 0xFFFFFFFFu},
    {0x000D0504u, 0x0020100Fu, 0x00201D1Cu},
    {0x00200C03u, 0x00100807u, 0x00201F1Eu},
    {0x00200C0Bu, 0x00201007u, 0x00201A19u},
    {0x00040100u, 0x00200F0Eu, 0xFFFFFFFFu},
    {0x00070302u, 0x00200F06u, 0x00201C1Bu},
    {0x00200D01u, 0x000F0706u, 0x00201B1Au},
    {0x00200D04u, 0x00200F00u, 0x00201817u},
    {0x00200D0Cu, 0x00200F02u, 0x00201918u},
    {0x000E0605u, 0x000F0702u, 0x00201716u},
    {0x00200E05u, 0x000D0601u, 0x00201615u},
    {0x00200E0Du, 0x000F0700u, 0x00201514u}
};
constexpr int MP_LIST = 65536, MP_CNT = MP_LIST + 16384, MP_PSTR = 136;
__device__ __forceinline__ void ph_moba_past(const bf16_t* QA, const bf16_t* KA, const bf16_t* VAT, const unsigned* SEL, unsigned char* PART, LAS unsigned char* l3) {
    const int tid = (int)tidx();
    const int wave = __builtin_amdgcn_readfirstlane(tid >> 6);
    LAS unsigned short* listL = (LAS unsigned short*)(l3 + MP_LIST);
    LAS int* cntL = (LAS int*)(l3 + MP_CNT);
    const int gd_ = (int)gdim(), bx0_ = (int)bidx();
    const int vcu = (gd_ % 8 == 0) ? (bx0_ % 8) * (gd_ / 8) + bx0_ / 8 : bx0_;
#pragma unroll 1
    for (int slot = vcu; slot < 256; slot += gd_) {
        const int bh = slot >> 4, bin = slot & 15, b = bh >> 3, h = bh & 7;
#pragma unroll 1
        for (int un = 0; un < MBU_MAX; ++un) {
            const unsigned ud = MBU_TAB[bin][un];
            if (ud == 0xFFFFFFFFu) break;
            const int j = (int)(ud & 255u), ilo = (int)((ud >> 8) & 255u), ihi = (int)((ud >> 16) & 255u);
            __syncthreads();
            {
                const bf16_t* kg = KA + ((size_t)b * S + (size_t)j * 256) * 512 + h * 64;
                const bf16_t* vg = VAT + ((size_t)bh * 128 + (size_t)j * 4) * 4096;
#pragma unroll
                for (int q4 = 0; q4 < 4; ++q4) {
                    const int c = tid + 512 * q4, row = c >> 3, ch = c & 7;
                    const u32x4 kv = *(const u32x4*)((const char*)kg + (unsigned)((row * 512 + ch * 8) * 2)), vv = *(const u32x4*)((const char*)vg + (unsigned)(c * 16));
                    *(LAS u32x4*)(l3 + MB_KOFF + row * 128 + ((ch ^ (row & 7)) * 16)) = kv;
                    *(LAS u32x4*)(l3 + MB_VOFF + row * 128 + ((ch ^ (row & 7)) * 16)) = vv;
                }
            }
            if (tid == 0) cntL[0] = 0;
            __syncthreads();
            const int nq = (ihi - ilo) * 256;
#pragma unroll 1
            for (int e0 = 0; e0 < nq; e0 += 4096) {
                unsigned sw8[8];
#pragma unroll
                for (int k = 0; k < 8; ++k) { const int e = e0 + tid + 512 * k; sw8[k] = SEL[(size_t)bh * 8192 + ilo * 256 + (e < nq ? e : 0)]; }
#pragma unroll
                for (int k = 0; k < 8; ++k) {
                    const int e = e0 + tid + 512 * k, gq = ilo * 256 + e;
                    const unsigned sw_ = sw8[k];
                    const int s0 = (int)(sw_ & 255u), s1 = (int)((sw_ >> 8) & 255u), s2 = (int)((sw_ >> 16) & 255u);
                    const int r = (s0 == j) ? 0 : (s1 == j) ? 1 : (s2 == j) ? 2 : -1;
                    if (e < nq && r >= 0) { const int p = __hip_atomic_fetch_add(cntL, 1, __ATOMIC_RELAXED, __HIP_MEMORY_SCOPE_WORKGROUP); listL[p] = (unsigned short)(gq | (r << 13)); }
                }
            }
            __syncthreads();
            const int cnt = cntL[0];
            const int ng = (cnt + 15) >> 4;
#pragma unroll 1
            for (int gi = 2 * wave; gi < ng; gi += 16) {
                const int lane_ = (int)tidx() & 63, g = lane_ >> 4, li = lane_ & 15;
                if (gi + 1 < ng) {
                    bf16x8_t qf[2][2]; int gqs[2], rs[2]; bool vals[2]; int qrow[2] = {0, 0};
#pragma unroll
                    for (int cg = 0; cg < 2; ++cg) {
                        const int ei = (gi + cg) * 16 + li;
                        vals[cg] = ei < cnt;
                        const unsigned ent = listL[vals[cg] ? ei : (gi + cg) * 16];
                        gqs[cg] = (int)(ent & 8191u); rs[cg] = (int)(ent >> 13);
#pragma unroll
                        for (int ks = 0; ks < 2; ++ks) qf[cg][ks] = ld8(QA + ((size_t)b * S + gqs[cg]) * 512 + h * 64 + 32 * ks + 8 * g);
                    }
                    f32x4 o[2][4]; float mrun[2], lrun[2];
#pragma unroll
                    for (int cg = 0; cg < 2; ++cg) { mrun[cg] = NEGF; lrun[cg] = 0.f;
#pragma unroll
                        for (int dt = 0; dt < 4; ++dt) o[cg][dt] = (f32x4){0.f, 0.f, 0.f, 0.f}; }
                    moba_block<2, false>(l3, 0, 4, qf, qrow, o, mrun, lrun, g, li);
#pragma unroll
                    for (int cg = 0; cg < 2; ++cg) {
                        float l = lrun[cg]; l += __shfl_xor(l, 16); l += __shfl_xor(l, 32);
                        if (vals[cg]) {
                            unsigned char* sp = PART + (((size_t)bh * 8192 + gqs[cg]) * 3 + rs[cg]) * MP_PSTR;
#pragma unroll
                            for (int dt = 0; dt < 4; ++dt) { u32x2 w; w.x = pk2(o[cg][dt][0], o[cg][dt][1]); w.y = pk2(o[cg][dt][2], o[cg][dt][3]); *(u32x2*)(sp + (16 * dt + 4 * g) * 2) = w; }
                            if (g == 0) *(float2*)(sp + 128) = make_float2(mrun[cg], l);
                        }
                    }
                } else {
                    const int ei = gi * 16 + li;
                    const bool valid = ei < cnt;
                    const unsigned ent = listL[valid ? ei : gi * 16];
                    const int gq = (int)(ent & 8191u), r = (int)(ent >> 13);
                    bf16x8_t qg[1][2];
#pragma unroll
                    for (int ks = 0; ks < 2; ++ks) qg[0][ks] = ld8(QA + ((size_t)b * S + gq) * 512 + h * 64 + 32 * ks + 8 * g);
                    f32x4 o[1][4]; float mg[1] = {NEGF}, lg_[1] = {0.f}; int qrow1[1] = {0};
#pragma unroll
                    for (int dt = 0; dt < 4; ++dt) o[0][dt] = (f32x4){0.f, 0.f, 0.f, 0.f};
                    moba_block<1, false>(l3, 0, 4, qg, qrow1, o, mg, lg_, g, li);
                    float l = lg_[0]; l += __shfl_xor(l, 16); l += __shfl_xor(l, 32);
                    if (valid) {
                        unsigned char* sp = PART + (((size_t)bh * 8192 + gq) * 3 + r) * MP_PSTR;
#pragma unroll
                        for (int dt = 0; dt < 4; ++dt) { u32x2 w; w.x = pk2(o[0][dt][0], o[0][dt][1]); w.y = pk2(o[0][dt][2], o[0][dt][3]); *(u32x2*)(sp + (16 * dt + 4 * g) * 2) = w; }
                        if (g == 0) *(float2*)(sp + 128) = make_float2(mg[0], l);
                    }
                }
            }
        }
    }
    __syncthreads();
}
__device__ __forceinline__ void ph_moba_merge(bf16_t* YA, const bf16_t* OWNO, const float* OWNML, const unsigned* SEL, const unsigned char* PART, unsigned gtid, unsigned gthreads) {
#pragma unroll 1
    for (unsigned w = gtid; w < 16u * 8192u * 4u; w += gthreads) {
        const unsigned dt = w & 3u, idx = w >> 2;
        const unsigned bh = idx >> 13, gq = idx & 8191u, b = bh >> 3, h = bh & 7u;
        const unsigned sw_ = SEL[idx];
        const float2 oml = *(const float2*)(OWNML + 2 * (size_t)idx);
        float m[3], l[3];
#pragma unroll
        for (int r = 0; r < 3; ++r) {
            const bool val = ((sw_ >> (8 * r)) & 255u) < 64u;
            const unsigned char* sp = PART + ((size_t)idx * 3 + r) * MP_PSTR;
            m[r] = val ? *(const float*)(sp + 128) : NEGF; l[r] = val ? *(const float*)(sp + 132) : 0.f;
        }
        const float mn = fmaxf(fmaxf(oml.x, m[0]), fmaxf(m[1], m[2]));
        const float a0 = __builtin_amdgcn_exp2f(oml.x - mn);
        float ar[3];
#pragma unroll
        for (int r = 0; r < 3; ++r) ar[r] = (l[r] > 0.f) ? __builtin_amdgcn_exp2f(m[r] - mn) : 0.f;
        const float inv = 1.0f / (oml.y * a0 + l[0] * ar[0] + l[1] * ar[1] + l[2] * ar[2]);
        float acc[16];
        {
            const u32x4 x0 = *(const u32x4*)(OWNO + (size_t)idx * 64 + 16 * dt), x1 = *(const u32x4*)(OWNO + (size_t)idx * 64 + 16 * dt + 8);
            const unsigned xs[8] = {x0.x, x0.y, x0.z, x0.w, x1.x, x1.y, x1.z, x1.w};
#pragma unroll
            for (int e = 0; e < 8; ++e) { acc[2 * e] = __uint_as_float(xs[e] << 16) * a0; acc[2 * e + 1] = __uint_as_float(xs[e] & 0xffff0000u) * a0; }
        }
#pragma unroll
        for (int r = 0; r < 3; ++r) {
            if (ar[r] > 0.f) {
                const unsigned char* sp = PART + ((size_t)idx * 3 + r) * MP_PSTR + dt * 32;
#pragma unroll
                for (int e2 = 0; e2 < 4; ++e2) {
                    const u32x2 xw = *(const u32x2*)(sp + 8 * e2);
                    acc[4 * e2] += __uint_as_float(xw.x << 16) * ar[r]; acc[4 * e2 + 1] += __uint_as_float(xw.x & 0xffff0000u) * ar[r];
                    acc[4 * e2 + 2] += __uint_as_float(xw.y << 16) * ar[r]; acc[4 * e2 + 3] += __uint_as_float(xw.y & 0xffff0000u) * ar[r];
                }
            }
        }
        u32x4 y0, y1;
        y0.x = pk2(acc[0] * inv, acc[1] * inv); y0.y = pk2(acc[2] * inv, acc[3] * inv); y0.z = pk2(acc[4] * inv, acc[5] * inv); y0.w = pk2(acc[6] * inv, acc[7] * inv);
        y1.x = pk2(acc[8] * inv, acc[9] * inv); y1.y = pk2(acc[10] * inv, acc[11] * inv); y1.z = pk2(acc[12] * inv, acc[13] * inv); y1.w = pk2(acc[14] * inv, acc[15] * inv);
        bf16_t* yp = YA + ((size_t)b * S + gq) * 512 + h * 64 + 16 * dt;
        *(u32x4*)yp = y0; *(u32x4*)(yp + 8) = y1;
    }
}
#define XB_TMO      128
#define XB_XCNT(j)  (256  + 64 * (j))
#define XB_XSUB(j)  (1280 + 64 * (j))
#define XB_XGEN(j)  (2304 + 64 * (j))
#define XB_TOP      3328
#define XB_TOPGEN   3392
#define XCD_BAR_WORDS 3456
#define XB_SPIN_CAP (1u << 24)
__device__ __forceinline__ unsigned xb_ld(unsigned* p)              { return __hip_atomic_load(p, __ATOMIC_RELAXED, __HIP_MEMORY_SCOPE_AGENT); }
__device__ __forceinline__ unsigned xb_add(unsigned* p, unsigned v) { return __hip_atomic_fetch_add(p, v, __ATOMIC_RELAXED, __HIP_MEMORY_SCOPE_AGENT); }
__device__ __forceinline__ unsigned xb_xcc_id() { return (unsigned)__builtin_amdgcn_s_getreg((3 << 11) | 20) & 0xFu; }
#define XB_SPIN(cond, bar) do { unsigned _sp = 0; while (cond) { __builtin_amdgcn_s_sleep(1); \
    if ((++_sp & 255u) == 0u) { if (xb_ld(&(bar)[XB_TMO])) break; if (_sp > XB_SPIN_CAP) { atomicAdd(&(bar)[XB_TMO], 1u); break; } } } } while (0)
struct XcdBarrier { unsigned* bar; unsigned x; volatile LAS unsigned* st; };
__device__ __forceinline__ XcdBarrier xcd_barrier_post(unsigned* bar, volatile LAS unsigned* st) {
    XcdBarrier b; b.bar = bar; b.x = xb_xcc_id(); b.st = st;
    if (threadIdx.x == 0) (void)xb_add(&bar[XB_XCNT(b.x)], 1u);
    return b;
}
__device__ __forceinline__ void xcd_barrier_complete(unsigned* bar, unsigned x, unsigned& nloc, unsigned& nx) {
    const unsigned G = gridDim.x * gridDim.y * gridDim.z;
    unsigned sum, cnt, mine, sp = 0u;
    for (;;) {
        sum = 0u; cnt = 0u; mine = 0u;
#pragma unroll
        for (unsigned j = 0; j < 16; ++j) { const unsigned c = xb_ld(&bar[XB_XCNT(j)]); sum += c; cnt += (c > 0u) ? 1u : 0u; mine = (j == x) ? c : mine; }
        if (sum == G) break;
        __builtin_amdgcn_s_sleep(1);
        if ((++sp & 255u) == 0u) { if (xb_ld(&bar[XB_TMO])) break; if (sp > XB_SPIN_CAP) { atomicAdd(&bar[XB_TMO], 1u); break; } }
    }
    nloc = mine > 0u ? mine : 1u; nx = cnt > 0u ? cnt : 1u;
}
__device__ __forceinline__ void xcd_barrier(const XcdBarrier& b) {
    asm volatile("s_waitcnt vmcnt(0)" ::: "memory");
    __syncthreads();
    if (threadIdx.x == 0) {
        unsigned* bar = b.bar;
        __builtin_amdgcn_s_waitcnt(0);
        unsigned nloc = b.st[0], nx = b.st[1];
        if (nloc == 0u) { xcd_barrier_complete(bar, b.x, nloc, nx); b.st[0] = nloc; b.st[1] = nx; }
        const unsigned old = xb_add(&bar[XB_XSUB(b.x)], 1u);
        const unsigned gen = old / nloc;
        if (old + 1u == (gen + 1u) * nloc) {
            __builtin_amdgcn_fence(__ATOMIC_RELEASE, "agent");
            asm volatile("s_waitcnt vmcnt(0)" ::: "memory");
            const unsigned og = xb_add(&bar[XB_TOP], 1u);
            const unsigned tg = og / nx;
            if (og + 1u == (tg + 1u) * nx) xb_add(&bar[XB_TOPGEN], 1u);
            else XB_SPIN(xb_ld(&bar[XB_TOPGEN]) == tg, bar);
            __builtin_amdgcn_fence(__ATOMIC_ACQUIRE, "agent");
            xb_add(&bar[XB_XGEN(b.x)], 1u);
            asm volatile("s_waitcnt vmcnt(0)" ::: "memory");
        } else {
            XB_SPIN(xb_ld(&bar[XB_XGEN(b.x)]) == gen, bar);
            __builtin_amdgcn_fence(__ATOMIC_ACQUIRE, "agent");
            asm volatile("s_waitcnt vmcnt(0)" ::: "memory");
        }
    }
    __syncthreads();
}

constexpr int LDS_BYTES = 163840;
constexpr int RING_BYTES = 131072;
constexpr int MISC_OFF = 163584;
struct Params {
    const float* in[13];
    float* out;
    unsigned char* ws;
};
typedef const __attribute__((address_space(4))) unsigned char* kargp_t;
__device__ __forceinline__ unsigned char* karg(int byte_off) {
    kargp_t k = (kargp_t)__builtin_amdgcn_kernarg_segment_ptr();
    asm volatile("" : "+s"(k));
    return *(unsigned char* const __attribute__((address_space(4)))*)(k + byte_off);
}
#define WSB() (karg(112))
__device__ __forceinline__ int launder_s(int v) { asm volatile("" : "+s"(v)); return v; }
#define GRIDX() launder_s((int)gridDim.x)
#define BLKX() launder_s((int)blockIdx.x)
#define INP(i) ((const float*)karg(8 * (i)))
#define OUTP() ((float*)karg(104))
#define GSYNC() do { XcdBarrier bar_; bar_.bar = (unsigned*)WSB() + 4096; bar_.x = xb_xcc_id(); bar_.st = (volatile LAS unsigned*)((LAS unsigned char*)lds + MISC_OFF) + 8; xcd_barrier(bar_); } while (0)
extern __shared__ __attribute__((aligned(16))) unsigned char lds[];
#define L3 ((LAS unsigned char*)lds)
#define LANE ((int)(tidx() & 63))
#define WAVE (__builtin_amdgcn_readfirstlane((int)(tidx() >> 6)))
#define GTID ((size_t)bidx() * 512 + tidx())
#define GTHREADS ((size_t)gdim() * 512)
__device__ __forceinline__ void prologue_body() {
    {
        unsigned char* ws = WSB();
        const int lane = LANE, wave = WAVE;
        const int gw = bidx() * 8 + wave, NGW = gdim() * 8;
        LAS float* scr = (LAS float*)(L3 + wave * 16384);
        constexpr int I_IN = (D / 64) * (INW / 32), I_MO = (512 / 64) * (D / 32), I_RO = (D / 64) * (D / 32), I_O = I_RO, I_Q = (D / 64) * (2048 / 32);
        constexpr int PER_L = I_IN + I_MO + I_RO + I_O + I_Q;
        for (int it = gw; it < 2 * PER_L; it += NGW) {
            const int l = it / PER_L; int r = it % PER_L;
            if (r < I_IN) { p0_transpose_item<true>(INP(1) + (size_t)l * D * INW, D, INW, (bf16_t*)(ws + WS_WIN) + (size_t)l * WIN_ROWS * D, scr, r, lane); continue; } r -= I_IN;
            if (r < I_MO) { p0_transpose_item<false>(INP(2) + (size_t)l * 512 * D, 512, D, (bf16_t*)(ws + WS_WMO) + (size_t)l * D * 512, scr, r, lane); continue; } r -= I_MO;
            if (r < I_RO) { p0_transpose_item<false>(INP(3) + (size_t)l * D * D, D, D, (bf16_t*)(ws + WS_WRO) + (size_t)l * D * D, scr, r, lane); continue; } r -= I_RO;
            if (r < I_O) { p0_transpose_item<false>(INP(4) + (size_t)l * D * D, D, D, (bf16_t*)(ws + WS_WO) + (size_t)l * D * D, scr, r, lane); continue; } r -= I_O;
            p0_transpose_item<false>(INP(7) + (size_t)l * D * 2048, D, 2048, (bf16_t*)(ws + WS_WQ) + (size_t)l * 2048 * D, scr, r, lane, INP(5) + l * D);
        }
        Tables tb; tb.qdec = (float*)(ws + WS_TBL); tb.kdec = tb.qdec + 1024; tb.ropeA = (float*)(ws + WS_ROPEA); tb.ropeR = (float*)(ws + WS_ROPER); tb.ropeRT = (float*)(ws + WS_ROPERT);
        cvt_copy(INP(8), (bf16_t*)(ws + WS_KEYS), (size_t)2 * 2 * PNK * PKD, GTID, GTHREADS);
        p0_csum_part(INP(7), INP(5), INP(6), (float*)(ws + WS_TBL + TB_PARTC), (float*)(ws + WS_TBL + TB_PARTB));
        __syncthreads();
        p0_tables(tb, GTID, GTHREADS, (LAS float*)L3);
        cvt_copy(INP(0), (bf16_t*)(ws + WS_XB), (size_t)T * D, GTID, GTHREADS);
    }
}
template <int l> __device__ __forceinline__ void layer_body() {
        {
            unsigned char* ws = WSB();
            pg8::Gemm g{(bf16_t*)(ws + WS_XB), (bf16_t*)(ws + WS_WIN) + (size_t)l * WIN_ROWS * D, T, WIN_NROWS, D}; pg8::StaticOrder So; So.init(T, WIN_NROWS, GRIDX(), BLKX());
            EpiProjAll E{ws};
            pg8::gemm_phase<EpiProjAll, pg8::StaticOrder, true, true>(L3, g, So, E);
        }
        {
            unsigned char* ws = WSB();
            pg8::Gemm g{(bf16_t*)(ws + WS_WIN) + ((size_t)l * WIN_ROWS + WIN_NROWS) * D, (bf16_t*)(ws + WS_XB), WIN_SROWS, T, D}; pg8::StaticOrder So; So.init(WIN_SROWS, T, GRIDX(), BLKX());
            EpiProjS E{ws};
            pg8::gemm_phase<EpiProjS, pg8::StaticOrder, true, true>(L3, g, So, E);
        }
        GSYNC();
        {
            unsigned char* ws = WSB();
            if (l == 0) p0_csum_reduce((const float*)(ws + WS_TBL + TB_PARTC), (const float*)(ws + WS_TBL + TB_PARTB), (float*)(ws + WS_TBL + TB_CSUM), (float*)(ws + WS_TBL + TB_BQ));
            ph_moba_own((const bf16_t*)(ws + WS_QA), (const bf16_t*)(ws + WS_KA), (const bf16_t*)(ws + WS_VAT), (const float*)(ws + WS_KMP), L3, (unsigned*)(ws + WS_MSEL), (bf16_t*)(ws + WS_MOWNO), (float*)(ws + WS_MOWNML));
            ph_retkv((const bf16_t*)(ws + WS_VRT), (const bf16_t*)(ws + WS_KRT), (float*)(ws + WS_KVT), L3);
        }
        GSYNC();
        { unsigned char* ws = WSB(); ph_moba_past((const bf16_t*)(ws + WS_QA), (const bf16_t*)(ws + WS_KA), (const bf16_t*)(ws + WS_VAT), (const unsigned*)(ws + WS_MSEL), ws + WS_MPART, L3); }
        { unsigned char* ws = WSB(); ph_retscan((const float*)(ws + WS_KVT), (bf16_t*)(ws + WS_PREVT));
          ph_kc_kb(INP(8) + (size_t)l * 2 * PNK * PKD, (const float*)(ws + WS_TBL + TB_CSUM) + l * 2048, (const float*)(ws + WS_TBL + TB_BQ) + l * 2048, (float*)(ws + WS_TBL + TB_KC), (float*)(ws + WS_TBL + TB_KB)); }
        GSYNC();
        { unsigned char* ws = WSB(); ph_retout((const bf16_t*)(ws + WS_QR), (const bf16_t*)(ws + WS_KR), (const bf16_t*)(ws + WS_VRT), (const bf16_t*)(ws + WS_PREVT), (const bf16_t*)(ws + WS_GR), (bf16_t*)(ws + WS_YR), L3); }
        { unsigned char* ws = WSB(); ph_moba_merge((bf16_t*)(ws + WS_QA), (const bf16_t*)(ws + WS_MOWNO), (const float*)(ws + WS_MOWNML), (const unsigned*)(ws + WS_MSEL), ws + WS_MPART, GTID, GTHREADS); }
        GSYNC();
        {
            unsigned char* ws = WSB();
            pg8::Gemm g{(bf16_t*)(ws + WS_QA), (bf16_t*)(ws + WS_WMO) + (size_t)l * D * 512, T, D, 512}; pg8::StaticOrder So; So.init(T, D, GRIDX(), BLKX());
            EpiBranchA E{(const bf16_t*)(ws + WS_GA), (bf16_t*)(ws + WS_MERGED), L3 + EPI_XCH_OFF};
            pg8::gemm_phase<EpiBranchA, pg8::StaticOrder, true, true>(L3, g, So, E);
        }
        {
            unsigned char* ws = WSB();
            pg8::Gemm g{(bf16_t*)(ws + WS_YR), (bf16_t*)(ws + WS_WRO) + (size_t)l * D * D, T, D, D}; pg8::StaticOrder So; So.init(T, D, GRIDX(), BLKX());
            EpiBranchR E{(const bf16_t*)(ws + WS_GRT), (bf16_t*)(ws + WS_MERGED), L3 + EPI_XCH_OFF};
            pg8::gemm_phase<EpiBranchR, pg8::StaticOrder, true, true>(L3, g, So, E);
        }
        GSYNC();
        {
            unsigned char* ws = WSB();
            pg8::Gemm g{(bf16_t*)(ws + WS_MERGED), (bf16_t*)(ws + WS_WO) + (size_t)l * D * D, T, D, D}; pg8::StaticOrder So; So.init(T, D, GRIDX(), BLKX());
            EpiMix E{(l == 0) ? INP(0) : (const float*)OUTP(), (float*)(ws + WS_X1), (bf16_t*)(ws + WS_XB), (float*)(ws + WS_STAT), L3 + EPI_XCH_OFF};
            pg8::gemm_phase<EpiMix, pg8::StaticOrder, true, true>(L3, g, So, E);
        }
        GSYNC();
        {
            unsigned char* ws = WSB();
            pg8::Gemm g{(bf16_t*)(ws + WS_XB), (bf16_t*)(ws + WS_WQ) + (size_t)l * 2048 * D, T, 2048, D}; pg8::StaticOrder So; So.init(T, 2048, GRIDX(), BLKX());
            EpiPlain E{(bf16_t*)(ws + WS_PQ), 2048, L3 + EPI_XCH_OFF};
            pg8::gemm_phase<EpiPlain, pg8::StaticOrder, true, true>(L3, g, So, E);
        }
        GSYNC();
        { unsigned char* ws = WSB(); ph_peer_topk((const bf16_t*)(ws + WS_PQ), (const bf16_t*)(ws + WS_KEYS) + (size_t)l * 2 * PNK * PKD, (int*)(ws + WS_PIDX), (float*)(ws + WS_PW), L3,
                                                 (const float*)(ws + WS_STAT), (const float*)(ws + WS_TBL + TB_KC), (const float*)(ws + WS_TBL + TB_KB), (float*)(ws + WS_TBL + TB_RS),
                                                 INP(9) + (size_t)l * NEXP * D, INP(10) + (size_t)l * NEXP * D, ws + WS_TABU, ws + WS_TABV, (float*)(ws + WS_SINV)); }
        GSYNC();
        { unsigned char* ws = WSB(); ph_peer_gather((const float*)(ws + WS_X1), (const int*)(ws + WS_PIDX), (const float*)(ws + WS_PW), (const unsigned char*)(ws + WS_TABU), (const unsigned char*)(ws + WS_TABV), (const float*)(ws + WS_SINV),
                                                   INP(11) + l * D, INP(12) + l * D, (l == 1) ? OUTP() : (float*)nullptr, (bf16_t*)(ws + WS_XB), L3, (const float*)(ws + WS_TBL + TB_RS), INP(5) + l * D, INP(6) + l * D); }
        GSYNC();
}
__global__ void __launch_bounds__(512, 2) mega(Params P) {
    {
        volatile LAS unsigned* MISC = (volatile LAS unsigned*)((LAS unsigned char*)lds + MISC_OFF);
        for (int u = threadIdx.x; u < 64; u += blockDim.x) MISC[u] = 0u;
        __syncthreads();
        (void)xcd_barrier_post((unsigned*)WSB() + 4096, MISC + 8);
    }
    prologue_body();
    GSYNC();

    layer_body<0>();
    layer_body<1>();
}

extern "C" void kernel_launch(void* const* d_in, const int* in_sizes, int n_in, void* d_out, int out_size, void* d_ws, size_t ws_size,
                              hipStream_t stream) {
    static int grid = 0;
    if (grid == 0) {
        if (ws_size < WS_END) { fprintf(stderr, "kernel_launch: workspace too small: need %zu, have %zu\n", (size_t)WS_END, ws_size); grid = -1; return; }
        int dev = 0, cus = 0, per_cu = 0;
        (void)hipGetDevice(&dev);
        (void)hipDeviceGetAttribute(&cus, hipDeviceAttributeMultiprocessorCount, dev);
        (void)hipFuncSetAttribute((const void*)mega, hipFuncAttributeMaxDynamicSharedMemorySize, LDS_BYTES);
        (void)hipOccupancyMaxActiveBlocksPerMultiprocessor(&per_cu, (const void*)mega, 512, LDS_BYTES);
        if (per_cu < 1) { fprintf(stderr, "occupancy query says %d blocks per CU\n", per_cu); per_cu = 1; }
        grid = cus * per_cu;
        (void)hipGetLastError();
    }
    if (grid < 0) return;
    (void)hipMemsetAsync(d_ws, 0, CTL_BYTES, stream);
    Params p{};
    for (int i = 0; i < 13; ++i) p.in[i] = (const float*)d_in[i];
    p.out = (float*)d_out; p.ws = (unsigned char*)d_ws;
    void* args[] = {&p};
    hipError_t e = hipLaunchCooperativeKernel((const void*)mega, dim3(grid), dim3(512), args, LDS_BYTES, stream);
    if (e != hipSuccess) fprintf(stderr, "cooperative launch failed: %s (grid %d)\n", hipGetErrorString(e), grid);
}
```
